# Optimizing an MI355X kernel written in HIP

```python
import math
import jax, jax.numpy as jnp
from jax import lax
import numpy as np

D_MODEL = 1024
BATCH = 2
SEQ = 8192
DEPTH = 2

N_META = 16
BLOCK = 128
PAD = BLOCK - N_META

SSD_EXPAND = 2
SSD_D_INNER = SSD_EXPAND * D_MODEL
SSD_HEAD_DIM = 64
SSD_HEADS = SSD_D_INNER // SSD_HEAD_DIM
SSD_GROUPS = 4
SSD_HEADS_PER_GROUP = SSD_HEADS // SSD_GROUPS
SSD_STATE = 128
SSD_CONV = 4
SSD_CONV_CH = SSD_D_INNER + 2 * SSD_GROUPS * SSD_STATE

FOX_HEADS = 16
FOX_HEAD_DIM = 64
FOX_WIDTH = FOX_HEADS * FOX_HEAD_DIM

EVEN_IN = SSD_D_INNER + SSD_CONV_CH + SSD_HEADS + 3 * FOX_WIDTH + FOX_HEADS
EVEN_MIX = SSD_D_INNER + FOX_WIDTH

DIFF_HEADS = 8
DIFF_HEAD_DIM = 64
DIFF_V_DIM = 2 * DIFF_HEAD_DIM
DIFF_Q_WIDTH = DIFF_HEADS * 2 * DIFF_HEAD_DIM
DIFF_V_WIDTH = DIFF_HEADS * DIFF_V_DIM
DIFF_IN = 2 * DIFF_Q_WIDTH + DIFF_V_WIDTH

N_BUCKETS = 32
MAX_DISTANCE = 128

D_FF = 2816

ALPHA = (2 * DEPTH) ** 0.25
BETA = (8 * DEPTH) ** -0.25
N_EVEN = (DEPTH + 1) // 2
N_ODD = DEPTH // 2

LN_EPS = 1e-5
RMS_EPS = 1e-5
NEG = -1e30

kernel_name = 'hybrid_ssd_fox_diffattn_macaron_deepnorm'


def _layer_norm(x, g, b):
    xf = x.astype(jnp.float32)
    mu = jnp.mean(xf, axis=-1, keepdims=True)
    var = jnp.mean(jnp.square(xf - mu), axis=-1, keepdims=True)
    return ((xf - mu) * lax.rsqrt(var + LN_EPS) * g + b).astype(x.dtype)


def _rms_norm(x, w):
    xf = x.astype(jnp.float32)
    return (xf * lax.rsqrt(jnp.mean(jnp.square(xf), axis=-1, keepdims=True) + RMS_EPS) * w).astype(x.dtype)


def _swiglu(x, w_gate, w_up, w_down):
    return (jax.nn.silu(x @ w_gate) * (x @ w_up)) @ w_down


def _left_pad(u):
    return jnp.pad(u, [(0, 0), (PAD, 0)] + [(0, 0)] * (u.ndim - 2))


def _causal_depthwise_conv(u, w, bias):
    ch = u.shape[-1]
    out = lax.conv_general_dilated(u, w[:, None, :].astype(u.dtype), window_strides=(1,),
                                   padding=[(SSD_CONV - 1, 0)],
                                   dimension_numbers=('NWC', 'WIO', 'NWC'),
                                   feature_group_count=ch)
    return out + bias


def _ssd_chunked(X, dA, Bm, Cm):
    b, lp = X.shape[:2]
    nc = lp // BLOCK
    G, R, P, N = SSD_GROUPS, SSD_HEADS_PER_GROUP, SSD_HEAD_DIM, SSD_STATE
    X = X.reshape(b, nc, BLOCK, G, R, P)
    Bm = Bm.reshape(b, nc, BLOCK, G, N)
    Cm = Cm.reshape(b, nc, BLOCK, G, N)
    dA = dA.astype(jnp.float32).reshape(b, nc, BLOCK, G, R).transpose(0, 3, 4, 1, 2)
    a_cum = jnp.cumsum(dA, axis=-1)
    idx = jnp.arange(BLOCK)
    causal = idx[:, None] >= idx[None, :]
    decay_ls = jnp.exp(jnp.where(causal, a_cum[..., :, None] - a_cum[..., None, :], -jnp.inf))
    cb = jnp.einsum('bclgn,bcsgn->bgcls', Cm, Bm)
    y_diag = jnp.einsum('bgcls,bgrcls,bcsgrp->bclgrp', cb, decay_ls, X)
    decay_to_end = jnp.exp(a_cum[..., -1:] - a_cum)
    chunk_states = jnp.einsum('bclgn,bgrcl,bclgrp->bcgrpn', Bm, decay_to_end, X)
    chunk_decay = jnp.exp(a_cum[..., -1])

    def step(state, inp):
        s_c, d_c = inp
        return state * d_c[..., None, None] + s_c, state

    init = jnp.zeros_like(chunk_states[:, 0])
    _, prev = lax.scan(step, init, (chunk_states.transpose(1, 0, 2, 3, 4, 5),
                                    chunk_decay.transpose(3, 0, 1, 2)))
    y_off = jnp.einsum('bclgn,cbgrpn,bgrcl->bclgrp', Cm, prev, jnp.exp(a_cum))
    return (y_diag + y_off).reshape(b, lp, G * R, P)


def _fox_attention(q, k, v, log_f):
    b, lp, H, dh = q.shape
    nb = lp // BLOCK
    c = jnp.cumsum(log_f, axis=1).transpose(0, 2, 1)
    key_pos = jnp.arange(lp)
    scale = dh ** -0.5

    def block(i):
        start = i * BLOCK
        qb = lax.dynamic_slice_in_dim(q, start, BLOCK, axis=1)
        cq = lax.dynamic_slice_in_dim(c, start, BLOCK, axis=2)
        qpos = start + jnp.arange(BLOCK)
        s = jnp.einsum('bqhd,bkhd->bhqk', qb, k).astype(jnp.float32) * scale
        s = s + cq[..., :, None] - c[..., None, :]
        mask = (key_pos[None, :] <= qpos[:, None]) & (key_pos[None, :] >= PAD)
        p = jax.nn.softmax(jnp.where(mask, s, NEG), axis=-1)
        return jnp.einsum('bhqk,bkhd->bqhd', p.astype(v.dtype), v)

    out = lax.map(block, jnp.arange(nb))
    return out.transpose(1, 0, 2, 3, 4).reshape(b, lp, H, dh)


def _t5_bucket(n):
    max_exact = N_BUCKETS // 2
    nf = jnp.maximum(n, 1).astype(jnp.float32)
    large = max_exact + (jnp.log(nf / max_exact) / math.log(MAX_DISTANCE / max_exact)
                         * (N_BUCKETS - max_exact)).astype(jnp.int32)
    large = jnp.minimum(large, N_BUCKETS - 1)
    return jnp.where(n < max_exact, n, large)


def _diff_attention(q, k, v, rel_table, lam):
    b, lp = q.shape[:2]
    nb = lp // BLOCK
    key_pos = jnp.arange(lp)
    scale = DIFF_HEAD_DIM ** -0.5

    def block(i):
        start = i * BLOCK
        qb = lax.dynamic_slice_in_dim(q, start, BLOCK, axis=1)
        qpos = start + jnp.arange(BLOCK)
        dist = qpos[:, None] - key_pos[None, :]
        bias = rel_table[_t5_bucket(jnp.maximum(dist, 0))].astype(jnp.float32).transpose(2, 0, 1)
        s = jnp.einsum('bqhcd,bkhcd->bchqk', qb, k).astype(jnp.float32) * scale + bias
        mask = (dist >= 0) & (key_pos[None, :] >= PAD)
        p = jax.nn.softmax(jnp.where(mask, s, NEG), axis=-1)
        attn = p[:, 0] - lam * p[:, 1]
        return jnp.einsum('bhqk,bkhe->bqhe', attn.astype(v.dtype), v)

    out = lax.map(block, jnp.arange(nb))
    return out.transpose(1, 0, 2, 3, 4).reshape(b, lp, DIFF_HEADS, DIFF_V_DIM)


def _even_mixer(h, w_in, conv_w, conv_b, dt_bias, a_log, d_skip, norm_w, f_bias, w_out):
    b, L, _ = h.shape
    proj = h @ w_in
    splits = np.cumsum([SSD_D_INNER, SSD_CONV_CH, SSD_HEADS, FOX_WIDTH, FOX_WIDTH, FOX_WIDTH]).tolist()
    z, xbc, dt_raw, q, k, v, f_raw = jnp.split(proj, splits, axis=-1)
    xbc = jax.nn.silu(_causal_depthwise_conv(xbc, conv_w, conv_b))
    xs, Bm, Cm = jnp.split(xbc, [SSD_D_INNER, SSD_D_INNER + SSD_GROUPS * SSD_STATE], axis=-1)
    dt = jax.nn.softplus(dt_raw.astype(jnp.float32) + dt_bias)
    A = -jnp.exp(a_log.astype(jnp.float32))
    xs = xs.reshape(b, L, SSD_HEADS, SSD_HEAD_DIM)
    y = _ssd_chunked(_left_pad(xs * dt[..., None]), _left_pad(dt * A),
                     _left_pad(Bm.reshape(b, L, SSD_GROUPS, SSD_STATE)),
                     _left_pad(Cm.reshape(b, L, SSD_GROUPS, SSD_STATE)))[:, PAD:]
    y = (y + d_skip[:, None] * xs).astype(h.dtype).reshape(b, L, SSD_D_INNER) * jax.nn.silu(z)
    y = _rms_norm(y.reshape(b, L, SSD_GROUPS, SSD_D_INNER // SSD_GROUPS), 1.0).reshape(b, L, SSD_D_INNER) * norm_w
    log_f = jax.nn.log_sigmoid(f_raw.astype(jnp.float32) + f_bias)
    o = _fox_attention(_left_pad(q.reshape(b, L, FOX_HEADS, FOX_HEAD_DIM)),
                       _left_pad(k.reshape(b, L, FOX_HEADS, FOX_HEAD_DIM)),
                       _left_pad(v.reshape(b, L, FOX_HEADS, FOX_HEAD_DIM)),
                       _left_pad(log_f))[:, PAD:]
    o = o.reshape(b, L, FOX_WIDTH)
    return jnp.concatenate([y.astype(h.dtype), o], axis=-1) @ w_out


def _odd_mixer(h, w_qkv, lam_q1, lam_k1, lam_q2, lam_k2, subln_w, w_o, rel_table, lambda_init):
    b, L, _ = h.shape
    q, k, v = jnp.split(h @ w_qkv, [DIFF_Q_WIDTH, 2 * DIFF_Q_WIDTH], axis=-1)
    q = q.reshape(b, L, DIFF_HEADS, 2, DIFF_HEAD_DIM)
    k = k.reshape(b, L, DIFF_HEADS, 2, DIFF_HEAD_DIM)
    v = v.reshape(b, L, DIFF_HEADS, DIFF_V_DIM)
    lam = (jnp.exp(jnp.sum(lam_q1.astype(jnp.float32) * lam_k1))
           - jnp.exp(jnp.sum(lam_q2.astype(jnp.float32) * lam_k2)) + lambda_init)
    o = _diff_attention(_left_pad(q), _left_pad(k), _left_pad(v), rel_table, lam)[:, PAD:]
    o = _rms_norm(o, subln_w) * (1.0 - lambda_init)
    return o.reshape(b, L, DIFF_V_WIDTH) @ w_o


def setup_inputs(seed: int = 0) -> dict:
    key = jax.random.key(seed)
    ks = jax.random.split(key, 32)
    f32 = jnp.float32

    def nrm(k, shape, scale):
        return jax.random.normal(k, shape, f32) * scale

    dt0 = jnp.exp(jax.random.uniform(ks[12], (N_EVEN, SSD_HEADS), f32, math.log(1e-3), math.log(1e-1)))
    return {
        'x': nrm(ks[0], (BATCH, SEQ, D_MODEL), 1.0),
        'meta_tokens': nrm(ks[1], (N_META, D_MODEL), 1.0),
        'ln_gain': 1.0 + nrm(ks[2], (DEPTH, 3, D_MODEL), 0.02),
        'ln_bias': nrm(ks[3], (DEPTH, 3, D_MODEL), 0.02),
        'ffn1_w_gate': nrm(ks[4], (DEPTH, D_MODEL, D_FF), D_MODEL ** -0.5),
        'ffn1_w_up': nrm(ks[5], (DEPTH, D_MODEL, D_FF), D_MODEL ** -0.5),
        'ffn1_w_down': nrm(ks[6], (DEPTH, D_FF, D_MODEL), BETA * D_FF ** -0.5),
        'ffn2_w_gate': nrm(ks[7], (DEPTH, D_MODEL, D_FF), D_MODEL ** -0.5),
        'ffn2_w_up': nrm(ks[8], (DEPTH, D_MODEL, D_FF), D_MODEL ** -0.5),
        'ffn2_w_down': nrm(ks[9], (DEPTH, D_FF, D_MODEL), BETA * D_FF ** -0.5),
        'even_w_in': nrm(ks[10], (N_EVEN, D_MODEL, EVEN_IN), D_MODEL ** -0.5),
        'even_conv_w': nrm(ks[11], (N_EVEN, SSD_CONV, SSD_CONV_CH), SSD_CONV ** -0.5),
        'even_conv_b': nrm(ks[13], (N_EVEN, SSD_CONV_CH), 0.02),
        'ssd_dt_bias': dt0 + jnp.log(-jnp.expm1(-dt0)),
        'ssd_a_log': jnp.log(jax.random.uniform(ks[14], (N_EVEN, SSD_HEADS), f32, 1.0, 16.0)),
        'ssd_d_skip': 1.0 + nrm(ks[15], (N_EVEN, SSD_HEADS), 0.02),
        'ssd_norm_w': 1.0 + nrm(ks[16], (N_EVEN, SSD_D_INNER), 0.02),
        'fox_f_bias': jax.random.uniform(ks[17], (N_EVEN, FOX_HEADS), f32, 1.0, 6.0),
        'even_w_out': nrm(ks[18], (N_EVEN, EVEN_MIX, D_MODEL), BETA * EVEN_MIX ** -0.5),
        'diff_w_qkv': nrm(ks[19], (N_ODD, D_MODEL, DIFF_IN), D_MODEL ** -0.5),
        'diff_lambda_q1': nrm(ks[20], (N_ODD, DIFF_HEAD_DIM), 0.1),
        'diff_lambda_k1': nrm(ks[21], (N_ODD, DIFF_HEAD_DIM), 0.1),
        'diff_lambda_q2': nrm(ks[22], (N_ODD, DIFF_HEAD_DIM), 0.1),
        'diff_lambda_k2': nrm(ks[23], (N_ODD, DIFF_HEAD_DIM), 0.1),
        'diff_subln_w': 1.0 + nrm(ks[24], (N_ODD, DIFF_V_DIM), 0.02),
        'diff_w_o': nrm(ks[25], (N_ODD, DIFF_V_WIDTH, D_MODEL), BETA * DIFF_V_WIDTH ** -0.5),
        'rel_bias_table': nrm(ks[26], (N_BUCKETS, DIFF_HEADS), 0.2),
    }


def reference(x, meta_tokens, ln_gain, ln_bias, ffn1_w_gate, ffn1_w_up, ffn1_w_down,
              ffn2_w_gate, ffn2_w_up, ffn2_w_down, even_w_in, even_conv_w, even_conv_b,
              ssd_dt_bias, ssd_a_log, ssd_d_skip, ssd_norm_w, fox_f_bias, even_w_out,
              diff_w_qkv, diff_lambda_q1, diff_lambda_k1, diff_lambda_q2, diff_lambda_k2,
              diff_subln_w, diff_w_o, rel_bias_table):
    b = x.shape[0]
    meta = jnp.broadcast_to(meta_tokens[None].astype(x.dtype), (b, N_META, D_MODEL))
    h = jnp.concatenate([meta, x], axis=1)
    for l in range(DEPTH):
        h = _layer_norm(ALPHA * h + 0.5 * _swiglu(h, ffn1_w_gate[l], ffn1_w_up[l], ffn1_w_down[l]),
                        ln_gain[l, 0], ln_bias[l, 0])
        if l % 2 == 0:
            e = l // 2
            m = _even_mixer(h, even_w_in[e], even_conv_w[e], even_conv_b[e], ssd_dt_bias[e],
                            ssd_a_log[e], ssd_d_skip[e], ssd_norm_w[e], fox_f_bias[e], even_w_out[e])
        else:
            o = l // 2
            lambda_init = 0.8 - 0.6 * math.exp(-0.3 * l)
            m = _odd_mixer(h, diff_w_qkv[o], diff_lambda_q1[o], diff_lambda_k1[o], diff_lambda_q2[o],
                           diff_lambda_k2[o], diff_subln_w[o], diff_w_o[o], rel_bias_table, lambda_init)
        h = _layer_norm(ALPHA * h + m.astype(h.dtype), ln_gain[l, 1], ln_bias[l, 1])
        h = _layer_norm(ALPHA * h + 0.5 * _swiglu(h, ffn2_w_gate[l], ffn2_w_up[l], ffn2_w_down[l]),
                        ln_gain[l, 2], ln_bias[l, 2])
    return h[:, N_META:]
```

```cpp
#include <hip/hip_runtime.h>
#include <hip/hip_cooperative_groups.h>
#include <cstdio>
#include <cstdint>
namespace cg = cooperative_groups;
namespace pg8 {
#define PG8_LAS __attribute__((address_space(3)))
typedef unsigned short bf16_t;
typedef short bf16x8 __attribute__((ext_vector_type(8)));
typedef float f32x4 __attribute__((ext_vector_type(4)));
typedef unsigned u32x4 __attribute__((ext_vector_type(4)));
constexpr int BM = 256, BK = 64, HALF = 128, HTB = HALF * BK * 2  , STAGE_BYTES = 8 * HTB, NXCD = 8, WGM = 8;

__host__ __device__ __forceinline__ int lds_byte(int r, int c) { const int st = (r >> 4) * 2 + (c >> 5), rr = r & 15, cc = c & 31, ob = rr * 64 + cc * 2; return st * 1024 + (ob ^ (((ob >> 9) & 1) << 5)); }
__host__ __device__ __forceinline__ void stage_rc(int b, int& R, int& C) { const int st = b / 1024, sb = b % 1024, swz = sb ^ (((sb >> 9) & 1) << 5); R = (st >> 1) * 16 + swz / 64; C = (st & 1) * 32 + (swz % 64) / 2; }
__host__ __device__ __forceinline__ int perm32(int rho) { const int n = rho >> 4, i = rho & 15; return 8 * (i >> 2) + 4 * n + (i & 3); }

struct Unit { int pm, pn; };
struct Gemm { const bf16_t* A; const bf16_t* Bt; int M, N, K; };

struct StaticOrder {
    int nM, nN, nwg, G, c;
    __host__ __device__ void init(int M, int N, int G_, int c_) { nM = M / BM; nN = N / BM; nwg = nM * nN; G = G_; c = c_; }
    __host__ __device__ bool next(int i, Unit& u) const {
        const long L = (long)i * G + c; if (L >= nwg) return false;
        int wgid = (int)L; { const int q = nwg / NXCD, r = nwg % NXCD, xcd = wgid % NXCD, off = wgid / NXCD; wgid = (xcd < r ? xcd * (q + 1) : r * (q + 1) + (xcd - r) * q) + off; }
        const int nig = WGM * nN, gid = wgid / nig, fm = gid * WGM, gsz = (nM - fm) < WGM ? (nM - fm) : WGM;
        u.pm = fm + ((wgid % nig) % gsz); u.pn = (wgid % nig) / gsz; return true;
    }
    __device__ __forceinline__ void a_ready(const Unit&) const {}
    __device__ __forceinline__ void done(const Unit&) const {}
};

__device__ __forceinline__ unsigned cvt_pk_bf16(float lo, float hi) { unsigned r; asm volatile("v_cvt_pk_bf16_f32 %0, %1, %2" : "=v"(r) : "v"(lo), "v"(hi)); return r; }
typedef float f32x2 __attribute__((ext_vector_type(2)));
__device__ __forceinline__ f32x2 gelu_pk(f32x2 v) {
    const f32x2 av = __builtin_elementwise_abs(v), d = av * 0.2316418882f + 1.0f;
    f32x2 t; t.x = __builtin_amdgcn_rcpf(d.x); t.y = __builtin_amdgcn_rcpf(d.y);
    f32x2 q = t * 0.5307027145f + (-0.7265760135f); q = q * t + 0.7107068705f; q = q * t + (-0.142248368f); q = q * t + 0.127414796f; q = q * t;
    const f32x2 s = (v * v) * (-0.72134752044f);
    f32x2 e; e.x = __builtin_amdgcn_exp2f(s.x); e.y = __builtin_amdgcn_exp2f(s.y);
    const f32x2 m = v * (q * e), r = v - m;
    f32x2 o; o.x = v.x < 0.f ? m.x : r.x; o.y = v.y < 0.f ? m.y : r.y; return o;
}

template <int ACT  > struct EpiBf16 {
    static constexpr bool PERM = true, AFTER_DRAIN = false; static_assert(ACT == 0 || ACT == 1, "EpiBf16: ACT is 0 (none) or 1 (gelu_pk)");
    bf16_t* O; int ldc; const float* bias; int split_cols; size_t split_stride; float scale0;
    __device__ __forceinline__ void operator()(const f32x4 (&acc)[2][2][4][2], const Unit& u, int wr, int wc, int fr, int fq) const {
        const int row0 = u.pm * BM + wr * 64 + fr; int colt = u.pn * BM; bf16_t* base = O;
        float sc = 1.f; if (split_cols) { const int t = colt / split_cols; base += (size_t)t * split_stride; colt -= t * split_cols; if (t == 0) sc = scale0; }
        const int col0 = colt + wc * 32 + 8 * fq, bcol0 = u.pn * BM + wc * 32 + 8 * fq;
        f32x4 bv[2][2];
#pragma unroll
        for (int bj = 0; bj < 2; ++bj)
#pragma unroll
            for (int n = 0; n < 2; ++n) bv[bj][n] = bias ? *(const f32x4*)(bias + bcol0 + bj * HALF + 4 * n) : (f32x4){0.f, 0.f, 0.f, 0.f};
#pragma unroll
        for (int ai = 0; ai < 2; ++ai)
#pragma unroll
            for (int m = 0; m < 4; ++m) { bf16_t* rowp = base + (size_t)(row0 + ai * HALF + m * 16) * ldc + col0;
#pragma unroll
                for (int bj = 0; bj < 2; ++bj) { f32x4 v0 = acc[ai][bj][m][0] + bv[bj][0], v1 = acc[ai][bj][m][1] + bv[bj][1];
                    if (ACT == 1) { f32x2 a = gelu_pk((f32x2){v0[0], v0[1]}), b = gelu_pk((f32x2){v0[2], v0[3]}), c = gelu_pk((f32x2){v1[0], v1[1]}), d = gelu_pk((f32x2){v1[2], v1[3]});
                        v0 = (f32x4){a.x, a.y, b.x, b.y}; v1 = (f32x4){c.x, c.y, d.x, d.y}; }
                    v0 = v0 * sc; v1 = v1 * sc; u32x4 w; w.x = cvt_pk_bf16(v0[0], v0[1]); w.y = cvt_pk_bf16(v0[2], v0[3]); w.z = cvt_pk_bf16(v1[0], v1[1]); w.w = cvt_pk_bf16(v1[2], v1[3]);
                    *(u32x4*)(rowp + bj * HALF) = w; } }
    }
};

struct PanelStats {
    unsigned* xbuf;
    unsigned* cnt;
    unsigned* tmo;
    int ntn; float eps;
    unsigned code;
    __device__ __forceinline__ bool run(const f32x4 (&v)[2][2][4][2], const Unit& u, int wr, int wc, int fr, int fq, PG8_LAS unsigned char* lds, int wid, int lane) const {
        typedef float f32x2v __attribute__((ext_vector_type(2)));
        PG8_LAS f32x2v* P = (PG8_LAS f32x2v*)lds;
        PG8_LAS f32x2v* S = (PG8_LAS f32x2v*)(lds + 8192);
        PG8_LAS unsigned* flag = (PG8_LAS unsigned*)(lds + 8192 + 2048);
#pragma unroll
        for (int ai = 0; ai < 2; ++ai)
#pragma unroll
            for (int m = 0; m < 4; ++m) {
                float s = 0.f;
#pragma unroll
                for (int bj = 0; bj < 2; ++bj)
#pragma unroll
                    for (int n = 0; n < 2; ++n) { const f32x4 x = v[ai][bj][m][n]; s += (x[0] + x[1]) + (x[2] + x[3]); }
                s += __shfl_xor(s, 16); s += __shfl_xor(s, 32);
                const float mw = s * (1.0f / 64.0f); float q = 0.f;
#pragma unroll
                for (int bj = 0; bj < 2; ++bj)
#pragma unroll
                    for (int n = 0; n < 2; ++n) { const f32x4 d = v[ai][bj][m][n] - mw; q += (d[0] * d[0] + d[1] * d[1]) + (d[2] * d[2] + d[3] * d[3]); }
                q += __shfl_xor(q, 16); q += __shfl_xor(q, 32);
                if (fq == 0) P[(ai * HALF + wr * 64 + m * 16 + fr) * 4 + wc] = (f32x2v){mw, q};
            }
        asm volatile("s_waitcnt lgkmcnt(0)" ::: "memory"); __builtin_amdgcn_s_barrier(); asm volatile("" ::: "memory");
#if defined(BROKEN_EXCHANGE_NO_WAIT)
#warning BROKEN CONTROL BUILD: the row-statistics exchange does not wait; results are wrong by design
        if (blockIdx.x >= 64) { const long long t0_ = clock64(); while (clock64() - t0_ < 60000) __builtin_amdgcn_s_sleep(8); }
#endif
        const int row = wid * 32 + (lane & 31);
        if (lane < 32) {
            const f32x2v a = P[row * 4 + 0], b = P[row * 4 + 1], c = P[row * 4 + 2], d = P[row * 4 + 3];
            const float mt = (a.x + b.x + c.x + d.x) * 0.25f;
            const float da = a.x - mt, db = b.x - mt, dc = c.x - mt, dd = d.x - mt;
            const float m2 = (a.y + b.y) + (c.y + d.y) + 64.0f * ((da * da + db * db) + (dc * dc + dd * dd));
            unsigned long long* slot = (unsigned long long*)xbuf + ((size_t)(u.pm * BM + row) * 4 + u.pn);
            __hip_atomic_store(slot, ((unsigned long long)__float_as_uint(m2) << 32) | __float_as_uint(mt), __ATOMIC_RELAXED, __HIP_MEMORY_SCOPE_AGENT);
        }
        asm volatile("s_waitcnt vmcnt(0)" ::: "memory");
        if (lane == 0) __hip_atomic_fetch_add(cnt + 64 * u.pm, 1u, __ATOMIC_RELAXED, __HIP_MEMORY_SCOPE_AGENT);
        if (wid == 0) {
            bool dead = false; const unsigned long long t0 = __builtin_amdgcn_s_memrealtime(); const unsigned want = 8u * (unsigned)ntn;
            for (;;) {
#if defined(BROKEN_EXCHANGE_NO_WAIT)
                break;
#endif
                if ((unsigned)__builtin_amdgcn_readfirstlane(__hip_atomic_load(cnt + 64 * u.pm, __ATOMIC_RELAXED, __HIP_MEMORY_SCOPE_AGENT)) >= want) break;
                if (__builtin_amdgcn_s_memrealtime() - t0 > 2000000ull) {
                    if (lane == 0) { unsigned expect = 0u; __hip_atomic_compare_exchange_strong(tmo + 1, &expect, code | (unsigned)(u.pm & 0xff), __ATOMIC_RELAXED, __ATOMIC_RELAXED, __HIP_MEMORY_SCOPE_AGENT);
                                     __hip_atomic_store(tmo, 1u, __ATOMIC_RELAXED, __HIP_MEMORY_SCOPE_AGENT); }
                    dead = true; break; }
                __builtin_amdgcn_s_sleep(2);
            }
            __builtin_amdgcn_fence(__ATOMIC_ACQUIRE, "agent");
            if (lane == 0) flag[0] = dead ? 1u : 0u;
        }
        asm volatile("s_waitcnt vmcnt(0) lgkmcnt(0)" ::: "memory"); __builtin_amdgcn_s_barrier(); asm volatile("" ::: "memory");
        const bool bad = flag[0] != 0u;
        if (lane < 32) {
            const unsigned long long* slot = (const unsigned long long*)xbuf + (size_t)(u.pm * BM + row) * 4; float mt[4], m2[4]; float ms = 0.f;
#pragma unroll
            for (int t = 0; t < 4; ++t) { if (t < ntn) { const unsigned long long w = __hip_atomic_load(slot + t, __ATOMIC_RELAXED, __HIP_MEMORY_SCOPE_AGENT); mt[t] = __uint_as_float((unsigned)w); m2[t] = __uint_as_float((unsigned)(w >> 32)); } else { mt[t] = 0.f; m2[t] = 0.f; } ms += mt[t]; }
            const float mean = ms / (float)ntn; float q = 0.f;
#pragma unroll
            for (int t = 0; t < 4; ++t) if (t < ntn) { const float dm = mt[t] - mean; q += m2[t] + 256.0f * dm * dm; }
            S[row] = (f32x2v){mean, 1.0f / sqrtf(q / (256.0f * (float)ntn) + eps)};
        }
        asm volatile("s_waitcnt lgkmcnt(0)" ::: "memory"); __builtin_amdgcn_s_barrier(); asm volatile("" ::: "memory");
        return bad;
    }
};
struct EpiLnRes {
    static constexpr bool PERM = false, AFTER_DRAIN = true;
    const float* base; float* out; int ldc; const float* bias; PanelStats st; unsigned poison;
    __device__ __forceinline__ void fused(f32x4 (&acc)[2][2][4][2], const Unit& u, int wr, int wc, int fr, int fq, PG8_LAS unsigned char* lds, int wid, int lane) const {
        typedef float f32x2v __attribute__((ext_vector_type(2)));
        const PG8_LAS f32x2v* S = (const PG8_LAS f32x2v*)(lds + 8192);
        const int col0 = u.pn * BM + wc * 32 + 4 * fq;
#pragma unroll
        for (int bj = 0; bj < 2; ++bj)
#pragma unroll
            for (int n = 0; n < 2; ++n) { const f32x4 bv = bias ? *(const f32x4*)(bias + col0 + bj * HALF + n * 16) : (f32x4){0.f, 0.f, 0.f, 0.f};
#pragma unroll
                for (int ai = 0; ai < 2; ++ai)
#pragma unroll
                    for (int m = 0; m < 4; ++m) acc[ai][bj][m][n] += bv; }
        f32x4 pre[4][2][2];
#pragma unroll
        for (int m = 0; m < 4; ++m) { const size_t off = (size_t)(u.pm * BM + wr * 64 + m * 16 + fr) * ldc + col0;
#pragma unroll
            for (int bj = 0; bj < 2; ++bj)
#pragma unroll
                for (int n = 0; n < 2; ++n) pre[m][bj][n] = *(const f32x4*)(base + off + bj * HALF + n * 16); }
        const bool bad = st.run(acc, u, wr, wc, fr, fq, lds, wid, lane) || poison != 0u;
        const float qnan = __builtin_nanf("");
#pragma unroll
        for (int ai = 0; ai < 2; ++ai)
#pragma unroll
            for (int m = 0; m < 4; ++m) { const int r = ai * HALF + wr * 64 + m * 16 + fr; const f32x2v sr = S[r]; const size_t off = (size_t)(u.pm * BM + r) * ldc + col0;
#pragma unroll
                for (int bj = 0; bj < 2; ++bj)
#pragma unroll
                    for (int n = 0; n < 2; ++n) { const f32x4 bs = ai == 0 ? pre[m][bj][n] : *(const f32x4*)(base + off + bj * HALF + n * 16); f32x4 o = bs + (acc[ai][bj][m][n] - sr.x) * sr.y;
                        if (bad) o = (f32x4){qnan, qnan, qnan, qnan}; *(f32x4*)(out + off + bj * HALF + n * 16) = o; }
                if (m & 1) asm volatile("" ::: "memory"); }
    }
};
struct EpiLnResLn {
    static constexpr bool PERM = false, AFTER_DRAIN = true;
    const float* base; float* out; bf16_t* xn; int ldc; const float* bias; PanelStats st1, st2; unsigned poison;
    __device__ __forceinline__ void fused(f32x4 (&acc)[2][2][4][2], const Unit& u, int wr, int wc, int fr, int fq, PG8_LAS unsigned char* lds, int wid, int lane) const {
        typedef float f32x2v __attribute__((ext_vector_type(2))); typedef unsigned u32x2v __attribute__((ext_vector_type(2)));
        const PG8_LAS f32x2v* S = (const PG8_LAS f32x2v*)(lds + 8192);
        const int col0 = u.pn * BM + wc * 32 + 4 * fq;
#pragma unroll
        for (int bj = 0; bj < 2; ++bj)
#pragma unroll
            for (int n = 0; n < 2; ++n) { const f32x4 bv = bias ? *(const f32x4*)(bias + col0 + bj * HALF + n * 16) : (f32x4){0.f, 0.f, 0.f, 0.f};
#pragma unroll
                for (int ai = 0; ai < 2; ++ai)
#pragma unroll
                    for (int m = 0; m < 4; ++m) acc[ai][bj][m][n] += bv; }
        bool bad = st1.run(acc, u, wr, wc, fr, fq, lds, wid, lane) || poison != 0u;
        const float qnan = __builtin_nanf("");
#pragma unroll
        for (int ai = 0; ai < 2; ++ai)
#pragma unroll
            for (int m = 0; m < 4; ++m) { const int r = ai * HALF + wr * 64 + m * 16 + fr; const f32x2v sr = S[r]; const size_t off = (size_t)(u.pm * BM + r) * ldc + col0;
#pragma unroll
                for (int bj = 0; bj < 2; ++bj)
#pragma unroll
                    for (int n = 0; n < 2; ++n) { const f32x4 bs = *(const f32x4*)(base + off + bj * HALF + n * 16); acc[ai][bj][m][n] = bs + (acc[ai][bj][m][n] - sr.x) * sr.y; }
                asm volatile("" : "+v"(acc[ai][0][m][0]), "+v"(acc[ai][0][m][1]), "+v"(acc[ai][1][m][0]), "+v"(acc[ai][1][m][1]));
                if (m & 1) asm volatile("" ::: "memory"); }
        const bool bad1 = bad;
        bad = st2.run(acc, u, wr, wc, fr, fq, lds, wid, lane) || bad;
#pragma unroll
        for (int ai = 0; ai < 2; ++ai)
#pragma unroll
            for (int m = 0; m < 4; ++m) { const int r = ai * HALF + wr * 64 + m * 16 + fr; const f32x2v sr = S[r]; const size_t off = (size_t)(u.pm * BM + r) * ldc + col0;
#pragma unroll
                for (int bj = 0; bj < 2; ++bj)
#pragma unroll
                    for (int n = 0; n < 2; ++n) { const f32x4 x1 = acc[ai][bj][m][n]; *(f32x4*)(out + off + bj * HALF + n * 16) = bad1 ? (f32x4){qnan, qnan, qnan, qnan} : x1;
                        const f32x4 o = (x1 - sr.x) * sr.y; u32x2v w; w.x = cvt_pk_bf16(o[0], o[1]); w.y = cvt_pk_bf16(o[2], o[3]);
                        if (bad) { w.x = 0x7fc07fc0u; w.y = 0x7fc07fc0u; } *(u32x2v*)(xn + off + bj * HALF + n * 16) = w; }
                asm volatile("" ::: "memory"); }
    }
};

template <class Epi, class Sched, bool ALIGN_EPI = false, bool SP2 = false>
__device__ __forceinline__ void gemm_phase(PG8_LAS unsigned char* lds, const Gemm g, const Sched& S, const Epi& E) {
    int tid_raw_ = threadIdx.x; asm volatile("" : "+v"(tid_raw_));
    const int tid = tid_raw_, wid = __builtin_amdgcn_readfirstlane(tid >> 6), lane = tid & 63, wr = wid >> 2, wc = wid & 3, fr = lane & 15, fq = lane >> 4;
    const int K = g.K, nt = K / BK;
    unsigned voffA[2], voffB[2];
#pragma unroll
    for (int i = 0; i < 2; ++i) { int R, C; stage_rc(tid * 16 + i * 8192, R, C); const int Rb = Epi::PERM ? ((R & ~31) + perm32(R & 31)) : R;
        voffA[i] = (unsigned)(R * K + C) * 2u; voffB[i] = (unsigned)(Rb * K + C) * 2u; }
    const size_t kstep = (size_t)(BK * 2);
    const size_t hstep = (size_t)HALF * K * 2;
    const size_t tstep = 2 * hstep;
    const unsigned ldsw = (unsigned)wid * 1024u;
    const int aoff = lds_byte(wr * 64 + fr, fq * 8), boff = lds_byte(wc * 32 + fr, fq * 8);
#define PG8_SA(b, h) (((b) * 2 + (h)) * HTB)
#define PG8_SB(b, h) ((4 + (b) * 2 + (h)) * HTB)
#define PG8_STAGE(bufoff, gbase, voff) do { _Pragma("unroll") for (int _i = 0; _i < 2; ++_i) \
        __builtin_amdgcn_global_load_lds((const unsigned*)((const char*)(gbase) + (voff)[_i]), (PG8_LAS unsigned*)(lds + (bufoff) + ldsw + _i * 8192), 16, 0, 0); } while (0)
#define PG8_LDA(dst, b, h) do { _Pragma("unroll") for (int m = 0; m < 4; ++m) _Pragma("unroll") for (int k = 0; k < 2; ++k) dst[m][k] = *(const PG8_LAS bf16x8*)(lds + PG8_SA(b, h) + aoff + m * 2048 + k * 1024); } while (0)
#define PG8_LDB(dst, b, h) do { _Pragma("unroll") for (int n = 0; n < 2; ++n) _Pragma("unroll") for (int k = 0; k < 2; ++k) dst[n][k] = *(const PG8_LAS bf16x8*)(lds + PG8_SB(b, h) + boff + n * 2048 + k * 1024); } while (0)
#define PG8_MMA(ai, bj, At, Bt) do { __builtin_amdgcn_s_setprio(1); _Pragma("unroll") for (int m = 0; m < 4; ++m) _Pragma("unroll") for (int n = 0; n < 2; ++n) _Pragma("unroll") for (int k = 0; k < 2; ++k) \
        acc[ai][bj][m][n] = __builtin_amdgcn_mfma_f32_16x16x32_bf16(Bt[n][k], At[m][k], acc[ai][bj][m][n], 0, 0, 0); __builtin_amdgcn_s_setprio(0); } while (0)
#define PG8_WAIT_V(n) asm volatile("s_waitcnt vmcnt(" #n ")" ::: "memory")
#define PG8_WAIT_L(n) asm volatile("s_waitcnt lgkmcnt(" #n ")" ::: "memory")
#define PG8_BAR __builtin_amdgcn_s_barrier()
#define PG8_SCHED __builtin_amdgcn_sched_barrier(0)
    Unit cur, nxt; int ui = 0;
    if (!S.next(0, cur)) return;
    f32x4 acc[2][2][4][2];
#pragma unroll
    for (int a = 0; a < 2; ++a)
#pragma unroll
        for (int b = 0; b < 2; ++b)
#pragma unroll
            for (int m = 0; m < 4; ++m)
#pragma unroll
                for (int n = 0; n < 2; ++n) acc[a][b][m][n] = (f32x4){0.f, 0.f, 0.f, 0.f};
    bf16x8 At[4][2], B0[2][2], B1[2][2];
    const char* cA = (const char*)g.A + (size_t)cur.pm * tstep; const char* cB = (const char*)g.Bt + (size_t)cur.pn * tstep;
    S.a_ready(cur);
    if constexpr (SP2) {
        PG8_STAGE(PG8_SB(0, 0), cB, voffB); PG8_STAGE(PG8_SB(0, 1), cB + hstep, voffB); PG8_STAGE(PG8_SA(0, 0), cA, voffA); PG8_STAGE(PG8_SA(0, 1), cA + hstep, voffA);
        if (wr == 1) PG8_BAR;
        PG8_WAIT_V(2); PG8_BAR;
        PG8_STAGE(PG8_SB(1, 0), cB + kstep, voffB); PG8_STAGE(PG8_SA(1, 0), cA + kstep, voffA); PG8_STAGE(PG8_SB(1, 1), cB + hstep + kstep, voffB);
        PG8_WAIT_V(6); PG8_BAR;
    } else {
        PG8_STAGE(PG8_SB(0, 0), cB, voffB); PG8_STAGE(PG8_SA(0, 0), cA, voffA); PG8_STAGE(PG8_SB(0, 1), cB + hstep, voffB); PG8_STAGE(PG8_SA(0, 1), cA + hstep, voffA);
        if (wr == 1) PG8_BAR;
        PG8_WAIT_V(4); PG8_BAR;
        PG8_STAGE(PG8_SB(1, 0), cB + kstep, voffB); PG8_STAGE(PG8_SA(1, 0), cA + kstep, voffA); PG8_STAGE(PG8_SB(1, 1), cB + hstep + kstep, voffB);
        PG8_WAIT_V(6); PG8_BAR;
    }
    for (;;) {
        const bool has_next = S.next(ui + 1, nxt);
        const char* nA = has_next ? (const char*)g.A + (size_t)nxt.pm * tstep : cA; const char* nB = has_next ? (const char*)g.Bt + (size_t)nxt.pn * tstep : cB;
        for (int t = 0; t < nt; t += 2) {
            const bool last = (t == nt - 2);
            const char* a1 = cA + (size_t)(t + 1) * kstep;
            const char* a2 = last ? nA : cA + (size_t)(t + 2) * kstep; const char* b2 = last ? nB : cB + (size_t)(t + 2) * kstep;
            const char* a3 = a2 + kstep; const char* b3 = b2 + kstep;
            if (last && has_next) S.a_ready(nxt);
            if constexpr (SP2) {
            PG8_LDB(B0, 0, 0); PG8_LDB(B1, 0, 1); PG8_SCHED; PG8_LDA(At, 0, 0); PG8_STAGE(PG8_SA(1, 1), a1 + hstep, voffA);
            PG8_WAIT_V(8); PG8_WAIT_L(0); PG8_BAR; PG8_MMA(0, 0, At, B0); PG8_MMA(0, 1, At, B1); PG8_BAR; PG8_SCHED;
            PG8_LDA(At, 0, 1); PG8_STAGE(PG8_SB(0, 0), b2, voffB); PG8_STAGE(PG8_SB(0, 1), b2 + hstep, voffB); PG8_STAGE(PG8_SA(0, 0), a2, voffA);
            PG8_WAIT_V(8); PG8_WAIT_L(0); PG8_BAR; PG8_MMA(1, 0, At, B0); PG8_MMA(1, 1, At, B1); PG8_BAR; PG8_SCHED;
            PG8_LDB(B0, 1, 0); PG8_LDB(B1, 1, 1); PG8_SCHED; PG8_LDA(At, 1, 0); PG8_STAGE(PG8_SA(0, 1), a2 + hstep, voffA);
            PG8_WAIT_V(8); PG8_WAIT_L(0); PG8_BAR; PG8_MMA(0, 0, At, B0); PG8_MMA(0, 1, At, B1); PG8_BAR; PG8_SCHED;
            PG8_LDA(At, 1, 1); PG8_STAGE(PG8_SB(1, 0), b3, voffB); PG8_STAGE(PG8_SB(1, 1), b3 + hstep, voffB); PG8_STAGE(PG8_SA(1, 0), a3, voffA);
            PG8_WAIT_V(8); PG8_WAIT_L(0); PG8_BAR; PG8_MMA(1, 0, At, B0); PG8_MMA(1, 1, At, B1); PG8_BAR; PG8_SCHED;
            } else {
            PG8_LDB(B0, 0, 0); PG8_SCHED; PG8_LDA(At, 0, 0); PG8_STAGE(PG8_SA(1, 1), a1 + hstep, voffA);
            PG8_WAIT_L(8); PG8_BAR; PG8_WAIT_L(0); PG8_MMA(0, 0, At, B0); PG8_BAR; PG8_SCHED;
            PG8_LDB(B1, 0, 1); PG8_STAGE(PG8_SB(0, 0), b2, voffB);
            PG8_BAR; PG8_WAIT_L(0); PG8_MMA(0, 1, At, B1); PG8_BAR;
            PG8_LDA(At, 0, 1); PG8_STAGE(PG8_SA(0, 0), a2, voffA);
            PG8_BAR; PG8_WAIT_L(0); PG8_MMA(1, 0, At, B0); PG8_BAR; PG8_SCHED;
            PG8_STAGE(PG8_SB(0, 1), b2 + hstep, voffB);
            PG8_WAIT_V(6); PG8_BAR; PG8_MMA(1, 1, At, B1); PG8_BAR;
            PG8_LDB(B0, 1, 0); PG8_SCHED; PG8_LDA(At, 1, 0); PG8_STAGE(PG8_SA(0, 1), a2 + hstep, voffA);
            PG8_WAIT_L(8); PG8_BAR; PG8_WAIT_L(0); PG8_MMA(0, 0, At, B0); PG8_BAR; PG8_SCHED;
            PG8_LDB(B1, 1, 1); PG8_STAGE(PG8_SB(1, 0), b3, voffB);
            PG8_BAR; PG8_WAIT_L(0); PG8_MMA(0, 1, At, B1); PG8_BAR;
            PG8_LDA(At, 1, 1); PG8_STAGE(PG8_SA(1, 0), a3, voffA);
            PG8_BAR; PG8_WAIT_L(0); PG8_MMA(1, 0, At, B0); PG8_BAR; PG8_SCHED;
            PG8_STAGE(PG8_SB(1, 1), b3 + hstep, voffB);
            PG8_WAIT_V(6); PG8_BAR; PG8_MMA(1, 1, At, B1); PG8_BAR;
            }
        }
        if constexpr (ALIGN_EPI) { if (wr == 0) PG8_BAR; }
        if constexpr (!Epi::AFTER_DRAIN) { E(acc, cur, wr, wc, fr, fq); S.done(cur); }
        if (!has_next) break;
#pragma unroll
        for (int a = 0; a < 2; ++a)
#pragma unroll
            for (int b = 0; b < 2; ++b)
#pragma unroll
                for (int m = 0; m < 4; ++m)
#pragma unroll
                    for (int n = 0; n < 2; ++n) acc[a][b][m][n] = (f32x4){0.f, 0.f, 0.f, 0.f};
        cur = nxt; cA = nA; cB = nB; ++ui;
        if constexpr (ALIGN_EPI) { if (wr == 1) PG8_BAR; }
    }
    PG8_WAIT_V(0);
    if constexpr (!ALIGN_EPI) { if (wr == 0) PG8_BAR; }
    PG8_BAR;
    if constexpr (Epi::AFTER_DRAIN) { E.fused(acc, cur, wr, wc, fr, fq, lds, wid, lane); S.done(cur); }
#undef PG8_SA
#undef PG8_SB
#undef PG8_STAGE
#undef PG8_LDA
#undef PG8_LDB
#undef PG8_MMA
#undef PG8_WAIT_V
#undef PG8_WAIT_L
#undef PG8_BAR
#undef PG8_SCHED
}
}

#ifndef MK_MULTI
#define MK_MULTI 0
#endif
namespace mk {
typedef unsigned short bf16;
typedef short bf16x8 __attribute__((ext_vector_type(8)));
typedef float f32x4 __attribute__((ext_vector_type(4)));
typedef unsigned u32x4 __attribute__((ext_vector_type(4)));
typedef unsigned u32x2 __attribute__((ext_vector_type(2)));
#define LAS __attribute__((address_space(3)))

constexpr int NBATCH = 2, SEQ = 8192, PADL = 112, LP = 8320, M = NBATCH * LP, MA = 17024, D = 1024, DFF = 2816;
constexpr int NCH = 65, NCB = NBATCH * NCH;
constexpr int EVEN_IN = 8240, NIN_PAD = 8448, LPC = 8448;
constexpr float ALPHA = 1.4142135623730951f;
constexpr float LOG2E = 1.4426950408889634f;
constexpr float LAM_INIT = 0.35550906759f;
constexpr float QSCALE = 0.125f * LOG2E;
constexpr int NPH = 26;
constexpr int LDS_BYTES = 132096;

constexpr size_t MiB = 1048576;
constexpr size_t SZ_GU = (size_t)5632 * 1024 * 2, SZ_DN = (size_t)1024 * 2816 * 2;
constexpr size_t WS_GU = 1 * MiB;
constexpr size_t WS_DN = 45 * MiB;
constexpr size_t WS_WIN = 67 * MiB;
constexpr size_t WS_WOUT = WS_WIN + (size_t)NIN_PAD * 1024 * 2;
constexpr size_t WS_WQKV = WS_WOUT + 6 * MiB;
constexpr size_t WS_WO = WS_WQKV + 6 * MiB;
constexpr size_t WS_HS = WS_WO + 2 * MiB;
constexpr size_t WS_HB = WS_HS + 1 * MiB;
constexpr size_t SZ_R1024 = (size_t)MA * 1024 * 2;
constexpr size_t WS_ACT = WS_HB + SZ_R1024;
constexpr size_t WS_K = WS_ACT, WS_VT = WS_ACT + SZ_R1024;
constexpr size_t WS_XT = WS_ACT, WS_BT = WS_ACT + (size_t)MA * 2048 * 2;
constexpr size_t WS_DTF = WS_ACT + (size_t)MA * DFF * 2 + 65536;
constexpr size_t SZ_PERL = (size_t)NCB * 32 * 128 * 4;
constexpr size_t WS_ACUM = WS_DTF + (size_t)MA * 64 * 4;
constexpr size_t WS_SCV = WS_ACUM + SZ_PERL;
constexpr size_t WS_DTV = WS_SCV + SZ_PERL;
constexpr size_t WS_C2 = WS_DTV + SZ_PERL;
constexpr size_t WS_CNAT = WS_C2 + (size_t)32 * LPC * 4;
constexpr size_t WS_END = WS_CNAT + (size_t)MA * 512 * 2;
static_assert(WS_BT + (size_t)NCB * 4 * 128 * 128 * 2 <= WS_DTF, "XT/BT fit in the act region");
static_assert(WS_END <= 256 * MiB, "d_ws map");
constexpr size_t G_YMIX = 0;
constexpr size_t G_XBC = (size_t)MA * 3072 * 2;
constexpr size_t G_ST = G_XBC;
constexpr size_t G_BNAT = G_XBC + (size_t)MA * 3072 * 2;
constexpr size_t G_END = G_BNAT + (size_t)MA * 512 * 2;
constexpr size_t G_DQ = 0, G_DK = SZ_R1024, G_DVT = 2 * SZ_R1024;
static_assert((size_t)NCB * 32 * 64 * 128 * 2 <= (size_t)MA * 3072 * 2, "states fit");
__device__ unsigned char g_scratch[G_END];

__device__ __forceinline__ unsigned f2bf(float f) { unsigned u = __float_as_uint(f); return (u + 0x7fffu + ((u >> 16) & 1u)) >> 16; }
__device__ __forceinline__ float bf2f(unsigned h) { return __uint_as_float(h << 16); }
typedef float f32x2_t __attribute__((ext_vector_type(2))); typedef __bf16 bf16x2_t __attribute__((ext_vector_type(2)));
__device__ __forceinline__ unsigned pk2(float lo, float hi) { f32x2_t v = {lo, hi}; bf16x2_t b = __builtin_convertvector(v, bf16x2_t); return __builtin_bit_cast(unsigned, b); }
__device__ __forceinline__ float bflo(unsigned w) { return __uint_as_float(w << 16); }
__device__ __forceinline__ float bfhi(unsigned w) { return __uint_as_float(w & 0xffff0000u); }
__device__ __forceinline__ float ex2(float x) { return __builtin_amdgcn_exp2f(x); }
__device__ __forceinline__ float siluf(float x) { return x * __builtin_amdgcn_rcpf(1.0f + ex2(-x * LOG2E)); }
__device__ __forceinline__ float wave_sum(float v) {
#pragma unroll
    for (int o = 1; o < 64; o <<= 1) v += __shfl_xor(v, o);
    return v;
}
__device__ __forceinline__ bf16x8 mk8(u32x4 v) { return __builtin_bit_cast(bf16x8, v); }
__device__ __forceinline__ f32x4 mfma16(bf16x8 a, bf16x8 b, f32x4 c) { return __builtin_amdgcn_mfma_f32_16x16x32_bf16(a, b, c, 0, 0, 0); }

struct P {
    const float* in[27]; float* out; unsigned char* ws; int ph_lo, ph_hi;
};
__device__ __forceinline__ float* hptr(float* dout, float* hs, int row) {
    const int b = row >= LP ? 1 : 0, p = row - b * LP;
    return p >= 128 ? dout + ((size_t)(b * SEQ + p - 128) << 10) : hs + ((size_t)(b * 128 + p) << 10);
}

struct EpiSwiGLU {
    static constexpr bool PERM = true, AFTER_DRAIN = false;
    bf16* O;
    __device__ __forceinline__ void operator()(const f32x4 (&acc)[2][2][4][2], const pg8::Unit& u, int wr, int wc, int fr, int fq) const {
        const int row0 = u.pm * 256 + wr * 64 + fr, col0 = u.pn * 128 + wc * 32 + 8 * fq;
#pragma unroll
        for (int ai = 0; ai < 2; ++ai)
#pragma unroll
            for (int m = 0; m < 4; ++m) {
                bf16* rowp = O + (size_t)(row0 + ai * 128 + m * 16) * DFF + col0;
                const f32x4 g0 = acc[ai][0][m][0], g1 = acc[ai][0][m][1], u0 = acc[ai][1][m][0], u1 = acc[ai][1][m][1];
                u32x4 w;
                w.x = pk2(siluf(g0[0]) * u0[0], siluf(g0[1]) * u0[1]); w.y = pk2(siluf(g0[2]) * u0[2], siluf(g0[3]) * u0[3]);
                w.z = pk2(siluf(g1[0]) * u1[0], siluf(g1[1]) * u1[1]); w.w = pk2(siluf(g1[2]) * u1[2], siluf(g1[3]) * u1[3]);
                *(u32x4*)rowp = w;
                asm volatile("" ::: "memory");
            }
    }
};
struct EpiResid {
    static constexpr bool PERM = false, AFTER_DRAIN = false;
    float* dout; float* hs; float scale;
    __device__ __forceinline__ void operator()(const f32x4 (&acc)[2][2][4][2], const pg8::Unit& u, int wr, int wc, int fr, int fq) const {
        const int col0 = u.pn * 256 + wc * 32 + 4 * fq;
#pragma unroll
        for (int ai = 0; ai < 2; ++ai)
#pragma unroll
            for (int m = 0; m < 4; ++m) {
                const int row = u.pm * 256 + ai * 128 + wr * 64 + m * 16 + fr;
                float* base = hptr(dout, hs, row) + col0;
#pragma unroll
                for (int bj = 0; bj < 2; ++bj)
#pragma unroll
                    for (int n = 0; n < 2; ++n) { f32x4* p = (f32x4*)(base + bj * 128 + n * 16); const f32x4 h = *p; *p = h * ALPHA + acc[ai][bj][m][n] * scale; }
                asm volatile("" ::: "memory");
            }
    }
};
__device__ __forceinline__ u32x4 pack8(const f32x4 a, const f32x4 b, float sc) {
    u32x4 w; w.x = pk2(a[0] * sc, a[1] * sc); w.y = pk2(a[2] * sc, a[3] * sc); w.z = pk2(b[0] * sc, b[1] * sc); w.w = pk2(b[2] * sc, b[3] * sc); return w;
}
struct EpiSplit {
    static constexpr bool PERM = true, AFTER_DRAIN = false;
    bf16 *A, *B, *C, *Dd, *VT; float* dtf;
    int t_a, t_b, t_c, t_d, t_e; int lda, ldb, ldc, ldd; int ca, cb, cc, cd; int hd_shift, nheads; float qs;
    __device__ __forceinline__ void operator()(const f32x4 (&acc)[2][2][4][2], const pg8::Unit& u, int wr, int wc, int fr, int fq) const {
        const int pn = u.pn, row0 = u.pm * 256 + wr * 64 + fr, cl = wc * 32 + 8 * fq;
        if (pn < t_d) {
            bf16* base; int ld, colt; float sc = 1.f;
            if (pn < t_a) { base = A; ld = lda; colt = ca + pn * 256; }
            else if (pn < t_b) { base = B; ld = ldb; colt = cb + (pn - t_a) * 256; }
            else if (pn < t_c) { base = C; ld = ldc; colt = cc + (pn - t_b) * 256; sc = qs; }
            else { base = Dd; ld = ldd; colt = cd + (pn - t_c) * 256; }
#pragma unroll
            for (int ai = 0; ai < 2; ++ai)
#pragma unroll
                for (int m = 0; m < 4; ++m) {
                    bf16* rowp = base + (size_t)(row0 + ai * 128 + m * 16) * ld + colt + cl;
#pragma unroll
                    for (int bj = 0; bj < 2; ++bj) *(u32x4*)(rowp + bj * 128) = pack8(acc[ai][bj][m][0], acc[ai][bj][m][1], sc);
                    asm volatile("" ::: "memory");
                }
        } else if (pn < t_e) {
            const int hd = 1 << hd_shift;
#pragma unroll
            for (int ai = 0; ai < 2; ++ai)
#pragma unroll
                for (int m = 0; m < 4; ++m) {
                    const int row = row0 + ai * 128 + m * 16, b = row >= LP ? 1 : 0, p = row - b * LP;
#pragma unroll
                    for (int bj = 0; bj < 2; ++bj) {
                        const int c0 = (pn - t_d) * 256 + bj * 128 + cl;
                        bf16* vp = VT + ((size_t)((b * nheads + (c0 >> hd_shift)) * hd + (c0 & (hd - 1)))) * LP + p;
                        const f32x4 v0 = acc[ai][bj][m][0], v1 = acc[ai][bj][m][1];
#pragma unroll
                        for (int i = 0; i < 4; ++i) { vp[(size_t)i * LP] = (bf16)f2bf(v0[i]); vp[(size_t)(i + 4) * LP] = (bf16)f2bf(v1[i]); }
                    }
                }
        } else {
            if (wc < 2) {
#pragma unroll
                for (int ai = 0; ai < 2; ++ai)
#pragma unroll
                    for (int m = 0; m < 4; ++m) {
                        float* dp = dtf + (size_t)(row0 + ai * 128 + m * 16) * 64 + cl;
                        *(f32x4*)dp = acc[ai][0][m][0]; *(f32x4*)(dp + 4) = acc[ai][0][m][1];
                    }
            }
        }
    }
};

__device__ __forceinline__ void transpose_item(const float* W, int K, int N, int n0, int k0, bf16* dst, int drow0, int nvalid, LAS float* scr, int lane) {
#pragma unroll 8
    for (int i = 0; i < 32; ++i) { const int kk = 2 * i + (lane >> 5), col = n0 + (lane & 31); scr[kk * 33 + (lane & 31)] = col < N ? W[(size_t)(k0 + kk) * N + col] : 0.f; }
    asm volatile("s_waitcnt lgkmcnt(0)" ::: "memory");
    const int c = lane & 7;
#pragma unroll
    for (int j = 0; j < 4; ++j) { const int n = (lane >> 3) + 8 * j; const LAS float* s = scr + (8 * c) * 33 + n;
        u32x4 o; o.x = pk2(s[0 * 33], s[1 * 33]); o.y = pk2(s[2 * 33], s[3 * 33]); o.z = pk2(s[4 * 33], s[5 * 33]); o.w = pk2(s[6 * 33], s[7 * 33]);
        if (n < nvalid) *(u32x4*)(dst + (size_t)(drow0 + n) * K + k0 + 8 * c) = o; }
    asm volatile("s_waitcnt lgkmcnt(0)" ::: "memory");
}
__device__ __forceinline__ void prologue_phase(const P& a, LAS unsigned char* lds, int wave, int lane) {
    LAS float* scr = (LAS float*)(lds + wave * 16384);
    const int gw = blockIdx.x * 8 + wave, NGW = gridDim.x * 8;
    unsigned char* ws = a.ws;
    constexpr int I_FF = 16 * 88;
    constexpr int I_IN = 16 * 258, I_OUT = 48 * 32, I_QKV = 16 * 96, I_O = 16 * 32;
    constexpr int NIT = 12 * I_FF + I_IN + I_OUT + I_QKV + I_O;
    for (int it = gw; it < NIT; it += NGW) {
        int r = it;
        if (r < 12 * I_FF) {
            const int f = r / (3 * I_FF); r -= f * 3 * I_FF; const int which = r / I_FF; r -= which * I_FF;
            const int layer = f >> 1, ffn = f & 1;
            const float* src = a.in[4 + ffn * 3 + which] + (size_t)layer * 1024 * DFF;
            if (which < 2) { const int kb = r / 88, nb = r % 88, c = 32 * nb;
                transpose_item(src, 1024, DFF, c, 64 * kb, (bf16*)(ws + WS_GU + f * SZ_GU), (c >> 7) * 256 + (c & 127) + which * 128, 32, scr, lane); }
            else { const int kb = r / 32, nb = r % 32;
                transpose_item(src, DFF, 1024, 32 * nb, 64 * kb, (bf16*)(ws + WS_DN + f * SZ_DN), 32 * nb, 32, scr, lane); }
            continue;
        }
        r -= 12 * I_FF;
        if (r < I_IN) { const int kb = r / 258, nb = r % 258, n0 = 32 * nb; int dr, nv = 32;
            if (n0 < 5120) dr = n0; else if (n0 == 5120) dr = 8192; else if (n0 < 8224) dr = n0 - 32; else { dr = 8224; nv = 16; }
            transpose_item(a.in[10], 1024, EVEN_IN, n0, 64 * kb, (bf16*)(ws + WS_WIN), dr, nv, scr, lane); continue; }
        r -= I_IN;
        if (r < I_OUT) { const int kb = r / 32, nb = r % 32; transpose_item(a.in[18], 3072, 1024, 32 * nb, 64 * kb, (bf16*)(ws + WS_WOUT), 32 * nb, 32, scr, lane); continue; }
        r -= I_OUT;
        if (r < I_QKV) { const int kb = r / 96, nb = r % 96; transpose_item(a.in[19], 1024, 3072, 32 * nb, 64 * kb, (bf16*)(ws + WS_WQKV), 32 * nb, 32, scr, lane); continue; }
        r -= I_QKV;
        { const int kb = r / 32, nb = r % 32; transpose_item(a.in[25], 1024, 1024, 32 * nb, 64 * kb, (bf16*)(ws + WS_WO), 32 * nb, 32, scr, lane); }
    }
    { u32x4* z = (u32x4*)(ws + WS_WIN + (size_t)EVEN_IN * 1024 * 2); const int n16 = (NIN_PAD - EVEN_IN) * 1024 * 2 / 16;
      for (int i = gw * 64 + lane; i < n16; i += NGW * 64) z[i] = (u32x4){0u, 0u, 0u, 0u}; }
    float* hs = (float*)(ws + WS_HS); bf16* hb = (bf16*)(ws + WS_HB);
    for (int row = gw; row < M; row += NGW) {
        const int b = row >= LP ? 1 : 0, p = row - b * LP;
        float* hp = hptr(a.out, hs, row); unsigned long long* o8 = (unsigned long long*)(hb + (size_t)row * 1024) + lane;
        if (p < PADL) {
#pragma unroll
            for (int j = 0; j < 4; ++j) { ((f32x4*)hp)[lane + 64 * j] = (f32x4){0.f, 0.f, 0.f, 0.f}; o8[64 * j] = 0ull; }
        } else {
            const float* src = p < 128 ? a.in[1] + (size_t)(p - PADL) * 1024 : a.in[0] + ((size_t)(b * SEQ + p - 128) << 10);
#pragma unroll
            for (int j = 0; j < 4; ++j) { const f32x4 v = ((const f32x4*)src)[lane + 64 * j]; ((f32x4*)hp)[lane + 64 * j] = v;
                o8[64 * j] = (unsigned long long)pk2(v[0], v[1]) | ((unsigned long long)pk2(v[2], v[3]) << 32); }
        }
    }
}

__device__ __forceinline__ void ln_phase(const P& a, const float* gain, const float* bias, bool final_, int wave, int lane) {
    const int gw = blockIdx.x * 8 + wave, NGW = gridDim.x * 8;
    float* hs = (float*)(a.ws + WS_HS); bf16* hb = (bf16*)(a.ws + WS_HB);
    f32x4 g[4], bb[4];
#pragma unroll
    for (int j = 0; j < 4; ++j) { g[j] = ((const f32x4*)gain)[lane + 64 * j]; bb[j] = ((const f32x4*)bias)[lane + 64 * j]; }
    for (int row = gw; row < M; row += NGW) {
        const int b = row >= LP ? 1 : 0, p = row - b * LP;
        if (final_ && p < 128) continue;
        float* hp = hptr(a.out, hs, row); unsigned long long* o8 = (unsigned long long*)(hb + (size_t)row * 1024) + lane;
        if (p < PADL) {
#pragma unroll
            for (int j = 0; j < 4; ++j) { ((f32x4*)hp)[lane + 64 * j] = (f32x4){0.f, 0.f, 0.f, 0.f}; o8[64 * j] = 0ull; }
            continue;
        }
        f32x4 v[4]; float s = 0.f;
#pragma unroll
        for (int j = 0; j < 4; ++j) { v[j] = ((const f32x4*)hp)[lane + 64 * j]; s += (v[j][0] + v[j][1]) + (v[j][2] + v[j][3]); }
        const float mean = wave_sum(s) * (1.f / 1024.f); float s2 = 0.f;
#pragma unroll
        for (int j = 0; j < 4; ++j) { v[j] = v[j] - mean; s2 += (v[j][0] * v[j][0] + v[j][1] * v[j][1]) + (v[j][2] * v[j][2] + v[j][3] * v[j][3]); }
        const float rstd = 1.0f / sqrtf(wave_sum(s2) * (1.f / 1024.f) + 1e-5f);
#pragma unroll
        for (int j = 0; j < 4; ++j) { const f32x4 o = v[j] * rstd * g[j] + bb[j]; ((f32x4*)hp)[lane + 64 * j] = o;
            if (!final_) o8[64 * j] = (unsigned long long)pk2(o[0], o[1]) | ((unsigned long long)pk2(o[2], o[3]) << 32); }
    }
}

__device__ __forceinline__ float logsig(float x) { return fminf(x, 0.f) - log1pf(expf(-fabsf(x))); }
__device__ __forceinline__ void c2_phase(const P& a, LAS unsigned char* lds, int tid, int wave, int lane) {
    if (blockIdx.x >= 32) return;
    LAS float* wtot = (LAS float*)lds;
    const int b = blockIdx.x >> 4, h = blockIdx.x & 15; const float fb = a.in[17][h];
    const float* dtf = (const float*)(a.ws + WS_DTF) + (size_t)b * LP * 64 + 32 + h; float* c2 = (float*)(a.ws + WS_C2) + (size_t)blockIdx.x * LPC;
    const int p0 = tid * 17; float s = 0.f;
    for (int i = 0; i < 17; ++i) { const int p = p0 + i; if (p >= PADL && p < LP) s += logsig(dtf[(size_t)p * 64] + fb); }
    float v = s;
#pragma unroll
    for (int o = 1; o < 64; o <<= 1) { const float t = __shfl_up(v, o); if (lane >= o) v += t; }
    if (lane == 63) wtot[wave] = v;
    __syncthreads();
    float run = v - s; for (int w = 0; w < wave; ++w) run += wtot[w];
    for (int i = 0; i < 17; ++i) { const int p = p0 + i; if (p < LP) { if (p >= PADL) run += logsig(dtf[(size_t)p * 64] + fb); c2[p] = run * LOG2E; } }
}

__device__ __forceinline__ void fox_unit(const P& a, int b, int h, int j, int wave, int lane) {
    const int q0 = 256 * j + 32 * wave;
    if (q0 >= LP || q0 + 31 < PADL) return;
    const int li = lane & 15, gq = lane >> 4;
    bf16* Y = (bf16*)(g_scratch + G_YMIX); const bf16* Kp = (const bf16*)(a.ws + WS_K); const bf16* Vt = (const bf16*)(a.ws + WS_VT);
    const float* C2 = (const float*)(a.ws + WS_C2) + (size_t)(b * 16 + h) * LPC + 4 * gq;
    const size_t rb = (size_t)b * LP;
    bf16x8 bq[2][2];
#pragma unroll
    for (int qt = 0; qt < 2; ++qt)
#pragma unroll
        for (int ks = 0; ks < 2; ++ks) bq[qt][ks] = *(const bf16x8*)(Y + (rb + q0 + 16 * qt + li) * 3072 + 2048 + h * 64 + 32 * ks + 8 * gq);
    f32x4 O[4][2];
#pragma unroll
    for (int dt = 0; dt < 4; ++dt) { O[dt][0] = (f32x4){0.f, 0.f, 0.f, 0.f}; O[dt][1] = (f32x4){0.f, 0.f, 0.f, 0.f}; }
    float mrun[2] = {-1e30f, -1e30f}, ls[2] = {0.f, 0.f};
    const bf16* Kh = Kp + (rb + li) * 1024 + h * 64 + 8 * gq;
    const bf16* Vh = Vt + ((size_t)(b * 16 + h) * 64 + li) * LP + 4 * gq;
    const int kt_last = (q0 + 31) >> 5;
    for (int kt = 3; kt <= kt_last; ++kt) {
        const int key0 = kt * 32;
        bf16x8 ak[2][2]; f32x4 cb[2]; u32x2 v0[4], v1[4];
#pragma unroll
        for (int k2 = 0; k2 < 2; ++k2) {
#pragma unroll
            for (int ks = 0; ks < 2; ++ks) ak[k2][ks] = *(const bf16x8*)(Kh + (size_t)(key0 + 16 * k2) * 1024 + 32 * ks);
            cb[k2] = *(const f32x4*)(C2 + key0 + 16 * k2);
        }
#pragma unroll
        for (int dt = 0; dt < 4; ++dt) { v0[dt] = *(const u32x2*)(Vh + (size_t)(16 * dt) * LP + key0); v1[dt] = *(const u32x2*)(Vh + (size_t)(16 * dt) * LP + key0 + 16); }
        f32x4 S[2][2];
#pragma unroll
        for (int k2 = 0; k2 < 2; ++k2)
#pragma unroll
            for (int qt = 0; qt < 2; ++qt) { f32x4 t = mfma16(ak[k2][0], bq[qt][0], (f32x4){0.f, 0.f, 0.f, 0.f}); S[k2][qt] = mfma16(ak[k2][1], bq[qt][1], t); }
        const bool edge = (kt == 3) || (kt == kt_last);
#pragma unroll
        for (int k2 = 0; k2 < 2; ++k2)
#pragma unroll
            for (int qt = 0; qt < 2; ++qt)
#pragma unroll
                for (int r = 0; r < 4; ++r) {
                    float s = S[k2][qt][r] - cb[k2][r];
                    if (edge) { const int key = key0 + 16 * k2 + 4 * gq + r, q = q0 + 16 * qt + li; if (key < PADL || key > q) s = -1e30f; }
                    S[k2][qt][r] = s;
                }
        u32x4 bp[2];
#pragma unroll
        for (int qt = 0; qt < 2; ++qt) {
            float mx = fmaxf(fmaxf(fmaxf(S[0][qt][0], S[0][qt][1]), fmaxf(S[0][qt][2], S[0][qt][3])), fmaxf(fmaxf(S[1][qt][0], S[1][qt][1]), fmaxf(S[1][qt][2], S[1][qt][3])));
            mx = fmaxf(mx, __shfl_xor(mx, 16)); mx = fmaxf(mx, __shfl_xor(mx, 32));
            const float mn = fmaxf(mrun[qt], mx), al = ex2(mrun[qt] - mn); mrun[qt] = mn;
            float pe[8]; float ps = 0.f;
#pragma unroll
            for (int r = 0; r < 4; ++r) { pe[r] = ex2(S[0][qt][r] - mn); pe[4 + r] = ex2(S[1][qt][r] - mn); ps += pe[r] + pe[4 + r]; }
            ls[qt] = ls[qt] * al + ps;
#pragma unroll
            for (int dt = 0; dt < 4; ++dt) O[dt][qt] = O[dt][qt] * al;
            bp[qt].x = pk2(pe[0], pe[1]); bp[qt].y = pk2(pe[2], pe[3]); bp[qt].z = pk2(pe[4], pe[5]); bp[qt].w = pk2(pe[6], pe[7]);
        }
#pragma unroll
        for (int dt = 0; dt < 4; ++dt) { const bf16x8 av = mk8((u32x4){v0[dt].x, v0[dt].y, v1[dt].x, v1[dt].y});
#pragma unroll
            for (int qt = 0; qt < 2; ++qt) O[dt][qt] = mfma16(av, mk8(bp[qt]), O[dt][qt]); }
    }
#pragma unroll
    for (int qt = 0; qt < 2; ++qt) {
        float l = ls[qt]; l += __shfl_xor(l, 16); l += __shfl_xor(l, 32); const float inv = 1.0f / l;
        const int q = q0 + 16 * qt + li;
        if (q >= PADL) {
            bf16* op = Y + (rb + q) * 3072 + 2048 + h * 64 + 4 * gq;
#pragma unroll
            for (int dt = 0; dt < 4; ++dt) { u32x2 w; w.x = pk2(O[dt][qt][0] * inv, O[dt][qt][1] * inv); w.y = pk2(O[dt][qt][2] * inv, O[dt][qt][3] * inv); *(u32x2*)(op + 16 * dt) = w; }
        }
    }
}
__device__ __forceinline__ void fox_phase(const P& a, int wave, int lane) {
    const int G = gridDim.x, c = blockIdx.x; constexpr int NU = 33 * 32;
    for (int r = 0;; ++r) {
        const int u = (r & 1) ? r * G + (G - 1 - c) : r * G + c;
        if (r * G >= NU) break;
        if (u >= NU) continue;
        const int j = 32 - u / 32, bh = u % 32;
        fox_unit(a, bh >> 4, bh & 15, j, wave, lane);
    }
}

__device__ __forceinline__ void diff_unit(const P& a, int b, int h, int j, int wave, int lane, float lam, const LAS float* tab) {
    const int q0 = 128 * j + 16 * wave;
    if (q0 + 15 < PADL) return;
    const int li = lane & 15, gq = lane >> 4;
    bf16* Q = (bf16*)(g_scratch + G_DQ); const bf16* Kp = (const bf16*)(g_scratch + G_DK); const bf16* Vt = (const bf16*)(g_scratch + G_DVT);
    const size_t rb = (size_t)b * LP; const int q = q0 + li;
    bf16x8 bq[2][2];
#pragma unroll
    for (int cp = 0; cp < 2; ++cp)
#pragma unroll
        for (int ks = 0; ks < 2; ++ks) bq[cp][ks] = *(const bf16x8*)(Q + (rb + q) * 1024 + h * 128 + cp * 64 + 32 * ks + 8 * gq);
    f32x4 O[2][8];
#pragma unroll
    for (int dt = 0; dt < 8; ++dt) { O[0][dt] = (f32x4){0.f, 0.f, 0.f, 0.f}; O[1][dt] = (f32x4){0.f, 0.f, 0.f, 0.f}; }
    float mrun[2] = {-1e30f, -1e30f}, ls[2] = {0.f, 0.f};
    const bf16* Kh = Kp + (rb + li) * 1024 + h * 128 + 8 * gq;
    const bf16* Vh = Vt + ((size_t)(b * 8 + h) * 128 + li) * LP + 4 * gq;
    const int kt_last = (q0 + 15) >> 5;
    for (int kt = 3; kt <= kt_last; ++kt) {
        const int key0 = kt * 32;
        bf16x8 ak[2][2][2]; u32x2 v0[8], v1[8];
#pragma unroll
        for (int cp = 0; cp < 2; ++cp)
#pragma unroll
            for (int k2 = 0; k2 < 2; ++k2)
#pragma unroll
                for (int ks = 0; ks < 2; ++ks) ak[cp][k2][ks] = *(const bf16x8*)(Kh + (size_t)(key0 + 16 * k2) * 1024 + cp * 64 + 32 * ks);
#pragma unroll
        for (int dt = 0; dt < 8; ++dt) { v0[dt] = *(const u32x2*)(Vh + (size_t)(16 * dt) * LP + key0); v1[dt] = *(const u32x2*)(Vh + (size_t)(16 * dt) * LP + key0 + 16); }
        f32x4 S[2][2];
#pragma unroll
        for (int cp = 0; cp < 2; ++cp)
#pragma unroll
            for (int k2 = 0; k2 < 2; ++k2) { f32x4 t = mfma16(ak[cp][k2][0], bq[cp][0], (f32x4){0.f, 0.f, 0.f, 0.f}); S[cp][k2] = mfma16(ak[cp][k2][1], bq[cp][1], t); }
        const bool edge = (kt == 3) || (key0 + 144 > q0);
        if (edge) {
#pragma unroll
            for (int k2 = 0; k2 < 2; ++k2)
#pragma unroll
                for (int r = 0; r < 4; ++r) {
                    const int key = key0 + 16 * k2 + 4 * gq + r, n = q - key;
                    if (n < 0 || key < PADL) { S[0][k2][r] = -1e30f; S[1][k2][r] = -1e30f; }
                    else { const float bv = tab[n < 127 ? n : 127]; S[0][k2][r] += bv; S[1][k2][r] += bv; }
                }
        }
        u32x4 bp[2];
#pragma unroll
        for (int cp = 0; cp < 2; ++cp) {
            float mx = fmaxf(fmaxf(fmaxf(S[cp][0][0], S[cp][0][1]), fmaxf(S[cp][0][2], S[cp][0][3])), fmaxf(fmaxf(S[cp][1][0], S[cp][1][1]), fmaxf(S[cp][1][2], S[cp][1][3])));
            mx = fmaxf(mx, __shfl_xor(mx, 16)); mx = fmaxf(mx, __shfl_xor(mx, 32));
            const float mn = fmaxf(mrun[cp], mx), al = ex2(mrun[cp] - mn); mrun[cp] = mn;
            float pe[8]; float ps = 0.f;
#pragma unroll
            for (int r = 0; r < 4; ++r) { pe[r] = ex2(S[cp][0][r] - mn); pe[4 + r] = ex2(S[cp][1][r] - mn); ps += pe[r] + pe[4 + r]; }
            ls[cp] = ls[cp] * al + ps;
#pragma unroll
            for (int dt = 0; dt < 8; ++dt) O[cp][dt] = O[cp][dt] * al;
            bp[cp].x = pk2(pe[0], pe[1]); bp[cp].y = pk2(pe[2], pe[3]); bp[cp].z = pk2(pe[4], pe[5]); bp[cp].w = pk2(pe[6], pe[7]);
        }
#pragma unroll
        for (int dt = 0; dt < 8; ++dt) { const bf16x8 av = mk8((u32x4){v0[dt].x, v0[dt].y, v1[dt].x, v1[dt].y});
            O[0][dt] = mfma16(av, mk8(bp[0]), O[0][dt]); O[1][dt] = mfma16(av, mk8(bp[1]), O[1][dt]); }
    }
    float l0 = ls[0], l1 = ls[1];
    l0 += __shfl_xor(l0, 16); l0 += __shfl_xor(l0, 32); l1 += __shfl_xor(l1, 16); l1 += __shfl_xor(l1, 32);
    const float i0 = 1.0f / l0, i1 = lam / l1; float ss = 0.f;
#pragma unroll
    for (int dt = 0; dt < 8; ++dt) { O[0][dt] = O[0][dt] * i0 - O[1][dt] * i1; ss += (O[0][dt][0] * O[0][dt][0] + O[0][dt][1] * O[0][dt][1]) + (O[0][dt][2] * O[0][dt][2] + O[0][dt][3] * O[0][dt][3]); }
    ss += __shfl_xor(ss, 16); ss += __shfl_xor(ss, 32);
    const float rstd = (1.0f - LAM_INIT) / sqrtf(ss * (1.f / 128.f) + 1e-5f);
    if (q >= PADL) {
        bf16* op = Q + (rb + q) * 1024 + h * 128 + 4 * gq; const float* sw = a.in[24] + 4 * gq;
#pragma unroll
        for (int dt = 0; dt < 8; ++dt) { const f32x4 w4 = *(const f32x4*)(sw + 16 * dt); u32x2 w;
            w.x = pk2(O[0][dt][0] * rstd * w4[0], O[0][dt][1] * rstd * w4[1]); w.y = pk2(O[0][dt][2] * rstd * w4[2], O[0][dt][3] * rstd * w4[3]); *(u32x2*)(op + 16 * dt) = w; }
    }
}
__device__ __forceinline__ void diff_phase(const P& a, LAS unsigned char* lds, int tid, int wave, int lane) {
    LAS float* tab = (LAS float*)lds;
    const float s1 = wave_sum(a.in[20][lane] * a.in[21][lane]), s2 = wave_sum(a.in[22][lane] * a.in[23][lane]);
    const float lam = expf(s1) - expf(s2) + LAM_INIT;
    const int G = gridDim.x, c = blockIdx.x; constexpr int NU = 65 * 16;
    for (int r = 0;; ++r) {
        const int u = (r & 1) ? r * G + (G - 1 - c) : r * G + c;
        if (r * G >= NU) break;
        if (u >= NU) continue;
        const int j = 64 - u / 16, bh = u % 16, h = bh & 7;
        __syncthreads();
        if (tid < 128) { const int n = tid; int bk = n; if (n >= 16) { bk = 16 + (int)(logf((float)n / 16.0f) / 2.0794415416798357f * 16.0f); bk = bk > 31 ? 31 : bk; }
            tab[n] = (a.in[26][bk * 8 + h] - a.in[26][31 * 8 + h]) * LOG2E; }
        __syncthreads();
        diff_unit(a, bh >> 3, h, j, wave, lane, lam, tab);
    }
}

__device__ __forceinline__ void ssd_prep_phase(const P& a, LAS unsigned char* lds, int tid, int wave, int lane) {
    LAS unsigned short* tin = (LAS unsigned short*)lds;
    LAS float* sdt = (LAS float*)(lds + 20480); LAS float* sac = sdt + 128;
    const bf16* xbc = (const bf16*)(g_scratch + G_XBC);
    bf16* XT = (bf16*)(a.ws + WS_XT); bf16* BT = (bf16*)(a.ws + WS_BT); bf16* Bn = (bf16*)(g_scratch + G_BNAT); bf16* Cn = (bf16*)(a.ws + WS_CNAT);
    const float* dtf = (const float*)(a.ws + WS_DTF);
    float* acum = (float*)(a.ws + WS_ACUM); float* scv = (float*)(a.ws + WS_SCV); float* dtv = (float*)(a.ws + WS_DTV);
    const float* cw = a.in[11]; const float* cbias = a.in[12];
    for (int it = blockIdx.x; it < NCB * 48; it += gridDim.x) {
        const int cbi = it / 48, hb = it % 48, b = cbi / NCH, c = cbi % NCH, row0 = b * LP + c * 128;
        for (int i = tid; i < 131 * 8; i += 512) { const int r = i >> 3, pc = i & 7, prow = c * 128 - 3 + r;
            u32x4 v = (u32x4){0u, 0u, 0u, 0u}; if (prow >= 0) v = *(const u32x4*)(xbc + (size_t)(b * LP + prow) * 3072 + hb * 64 + pc * 8);
            LAS unsigned* d = (LAS unsigned*)(tin + r * 66 + pc * 8); d[0] = v.x; d[1] = v.y; d[2] = v.z; d[3] = v.w; }
        if (hb < 32 && tid < 128) {
            const float raw = dtf[(size_t)(row0 + tid) * 64 + hb] + a.in[13][hb];
            float dt = raw > 20.f ? raw : log1pf(expf(raw));
            if (c == 0 && tid < PADL) dt = 0.f;
            sdt[tid] = dt; sac[tid] = -expf(a.in[14][hb]) * dt;
        }
        __syncthreads();
        if (hb < 32 && wave == 0) {
            const float v0 = sac[2 * lane], v1 = sac[2 * lane + 1], s = v0 + v1; float v = s;
#pragma unroll
            for (int o = 1; o < 64; o <<= 1) { const float t = __shfl_up(v, o); if (lane >= o) v += t; }
            sac[2 * lane] = v - s + v0; sac[2 * lane + 1] = v;
        }
        __syncthreads();
        if (hb < 32 && tid < 128) { const size_t idx = ((size_t)cbi * 32 + hb) * 128 + tid; const float ac = sac[tid], dt = sdt[tid];
            acum[idx] = ac; dtv[idx] = dt; scv[idx] = dt * expf(sac[127] - ac); }
        const int l = tid & 127, cg_ = tid >> 7;
        unsigned pk[8];
#pragma unroll
        for (int cc = 0; cc < 16; cc += 2) {
            float vv[2];
#pragma unroll
            for (int e = 0; e < 2; ++e) { const int ch = cg_ * 16 + cc + e, gch = hb * 64 + ch;
                float acc = cbias[gch];
#pragma unroll
                for (int k = 0; k < 4; ++k) acc += cw[k * 3072 + gch] * bf2f(tin[(l + k) * 66 + ch]);
                vv[e] = siluf(acc); }
            pk[cc >> 1] = pk2(vv[0], vv[1]);
        }
        if (hb < 32) {
            bf16* xt = XT + (((size_t)cbi * 32 + hb) * 64 + cg_ * 16) * 128 + l;
#pragma unroll
            for (int cc = 0; cc < 16; ++cc) xt[(size_t)cc * 128] = (bf16)((cc & 1) ? (pk[cc >> 1] >> 16) : (pk[cc >> 1] & 0xffffu));
        } else {
            const int g = ((hb - 32) & 7) >> 1, n0 = ((hb - 32) & 1) * 64 + cg_ * 16;
            bf16* nat = (hb < 40 ? Bn : Cn) + (size_t)(row0 + l) * 512 + g * 128 + n0;
            *(u32x4*)nat = (u32x4){pk[0], pk[1], pk[2], pk[3]}; *(u32x4*)(nat + 8) = (u32x4){pk[4], pk[5], pk[6], pk[7]};
            if (hb < 40) { bf16* bt = BT + (((size_t)cbi * 4 + g) * 128 + n0) * 128 + l;
#pragma unroll
                for (int cc = 0; cc < 16; ++cc) bt[(size_t)cc * 128] = (bf16)((cc & 1) ? (pk[cc >> 1] >> 16) : (pk[cc >> 1] & 0xffffu)); }
        }
        __syncthreads();
    }
}

__device__ __forceinline__ void ssd_s1_phase(const P& a, int wave, int lane) {
    const int li = lane & 15, gq = lane >> 4;
    const bf16* XT = (const bf16*)(a.ws + WS_XT); const bf16* BT = (const bf16*)(a.ws + WS_BT); const float* scv = (const float*)(a.ws + WS_SCV);
    bf16* ST = (bf16*)(g_scratch + G_ST);
    for (int it = blockIdx.x; it < NCB * 4; it += gridDim.x) {
        const int cbi = it >> 2, g = it & 3, h = 8 * g + wave;
        const bf16* xth = XT + ((size_t)cbi * 32 + h) * 8192 + li * 128 + 8 * gq; const bf16* btg = BT + ((size_t)cbi * 4 + g) * 16384 + li * 128 + 8 * gq;
        const float* sc = scv + ((size_t)cbi * 32 + h) * 128 + 8 * gq;
        f32x4 acc[4][8];
#pragma unroll
        for (int pt = 0; pt < 4; ++pt)
#pragma unroll
            for (int nt = 0; nt < 8; ++nt) acc[pt][nt] = (f32x4){0.f, 0.f, 0.f, 0.f};
#pragma unroll 1
        for (int ks = 0; ks < 4; ++ks) {
            const f32x4 s0 = *(const f32x4*)(sc + 32 * ks), s1 = *(const f32x4*)(sc + 32 * ks + 4);
            bf16x8 af[4];
#pragma unroll
            for (int pt = 0; pt < 4; ++pt) { const u32x4 w = *(const u32x4*)(xth + pt * 2048 + 32 * ks); u32x4 o;
                o.x = pk2(bflo(w.x) * s0[0], bfhi(w.x) * s0[1]); o.y = pk2(bflo(w.y) * s0[2], bfhi(w.y) * s0[3]);
                o.z = pk2(bflo(w.z) * s1[0], bfhi(w.z) * s1[1]); o.w = pk2(bflo(w.w) * s1[2], bfhi(w.w) * s1[3]); af[pt] = mk8(o); }
#pragma unroll
            for (int nt = 0; nt < 8; ++nt) { const bf16x8 bf = *(const bf16x8*)(btg + nt * 2048 + 32 * ks);
#pragma unroll
                for (int pt = 0; pt < 4; ++pt) acc[pt][nt] = mfma16(af[pt], bf, acc[pt][nt]); }
        }
        bf16* st = ST + ((size_t)cbi * 32 + h) * 8192 + (4 * gq) * 128 + li;
#pragma unroll
        for (int pt = 0; pt < 4; ++pt)
#pragma unroll
            for (int nt = 0; nt < 8; ++nt)
#pragma unroll
                for (int r = 0; r < 4; ++r) st[(16 * pt + r) * 128 + 16 * nt] = (bf16)f2bf(acc[pt][nt][r]);
    }
}
__device__ __forceinline__ void ssd_scan_phase(const P& a, int tid) {
    bf16* ST = (bf16*)(g_scratch + G_ST); const float* acum = (const float*)(a.ws + WS_ACUM);
    for (int e = blockIdx.x * 512 + tid; e < 131072; e += gridDim.x * 512) {
        const int b = e >> 16, r = e & 65535, h = r >> 11, off = (r & 2047) * 4;
        float r0 = 0.f, r1 = 0.f, r2 = 0.f, r3 = 0.f;
        u32x2 nx = *(const u32x2*)(ST + ((size_t)(b * NCH) * 32 + h) * 8192 + off);
        for (int c = 0; c < NCH; ++c) {
            const size_t cbh = (size_t)(b * NCH + c) * 32 + h; u32x2* p = (u32x2*)(ST + cbh * 8192 + off);
            const u32x2 v = nx; if (c + 1 < NCH) nx = *(const u32x2*)(ST + (cbh + 32) * 8192 + off);
            const float dec = expf(acum[cbh * 128 + 127]);
            u32x2 o; o.x = pk2(r0, r1); o.y = pk2(r2, r3); *p = o;
            r0 = r0 * dec + bflo(v.x); r1 = r1 * dec + bfhi(v.x); r2 = r2 * dec + bflo(v.y); r3 = r3 * dec + bfhi(v.y);
        }
    }
}
__device__ __forceinline__ void ssd_s3_phase(const P& a, LAS unsigned char* lds, int wave, int lane) {
    LAS float* ssum = (LAS float*)lds;
    const int li = lane & 15, gq = lane >> 4;
    const bf16* XT = (const bf16*)(a.ws + WS_XT); const bf16* Bn = (const bf16*)(g_scratch + G_BNAT); const bf16* Cn = (const bf16*)(a.ws + WS_CNAT);
    const bf16* ST = (const bf16*)(g_scratch + G_ST); bf16* Y = (bf16*)(g_scratch + G_YMIX);
    const float* acum = (const float*)(a.ws + WS_ACUM); const float* dtv = (const float*)(a.ws + WS_DTV);
    for (int it = blockIdx.x; it < NCB * 4; it += gridDim.x) {
        const int cbi = it >> 2, g = it & 3, h = 8 * g + wave, b = cbi / NCH, c = cbi % NCH, row0 = b * LP + c * 128;
        const bf16* xth = XT + ((size_t)cbi * 32 + h) * 8192; const bf16* pv = ST + ((size_t)cbi * 32 + h) * 8192 + li * 128 + 8 * gq;
        const bf16* bn = Bn + (size_t)row0 * 512 + g * 128 + 8 * gq; const bf16* cn = Cn + (size_t)row0 * 512 + g * 128 + 8 * gq;
        const float* ac = acum + ((size_t)cbi * 32 + h) * 128; const float* dtp = dtv + ((size_t)cbi * 32 + h) * 128;
        const float Dh = a.in[15][h];
#pragma unroll 1
        for (int lt = 0; lt < 8; ++lt) {
            const int lcol = 16 * lt + li; const float al = ac[lcol];
            bf16x8 cf[4];
#pragma unroll
            for (int ks = 0; ks < 4; ++ks) cf[ks] = *(const bf16x8*)(cn + (size_t)lcol * 512 + 32 * ks);
            f32x4 yo[4], yd[4];
#pragma unroll
            for (int pt = 0; pt < 4; ++pt) { yo[pt] = (f32x4){0.f, 0.f, 0.f, 0.f}; yd[pt] = (f32x4){0.f, 0.f, 0.f, 0.f};
#pragma unroll
                for (int ks = 0; ks < 4; ++ks) yo[pt] = mfma16(*(const bf16x8*)(pv + pt * 2048 + 32 * ks), cf[ks], yo[pt]); }
#pragma unroll 1
            for (int sp = 0; sp <= (lt >> 1); ++sp) {
                u32x4 bp;
#pragma unroll
                for (int s2 = 0; s2 < 2; ++s2) {
                    const int stile = 2 * sp + s2; f32x4 cbt = (f32x4){0.f, 0.f, 0.f, 0.f};
                    if (stile <= lt) {
#pragma unroll
                        for (int ks = 0; ks < 4; ++ks) cbt = mfma16(*(const bf16x8*)(bn + (size_t)(16 * stile + li) * 512 + 32 * ks), cf[ks], cbt);
                    }
                    const f32x4 as4 = *(const f32x4*)(ac + 16 * stile + 4 * gq), dt4 = *(const f32x4*)(dtp + 16 * stile + 4 * gq);
                    float mv[4];
#pragma unroll
                    for (int r = 0; r < 4; ++r) { const int s = 16 * stile + 4 * gq + r; mv[r] = (s <= lcol) ? cbt[r] * ex2((al - as4[r]) * LOG2E) * dt4[r] : 0.f; }
                    if (s2 == 0) { bp.x = pk2(mv[0], mv[1]); bp.y = pk2(mv[2], mv[3]); } else { bp.z = pk2(mv[0], mv[1]); bp.w = pk2(mv[2], mv[3]); }
                }
#pragma unroll
                for (int pt = 0; pt < 4; ++pt) { const bf16* xp = xth + (size_t)(16 * pt + li) * 128 + 32 * sp + 4 * gq;
                    const u32x2 x0 = *(const u32x2*)xp, x1 = *(const u32x2*)(xp + 16);
                    yd[pt] = mfma16(mk8((u32x4){x0.x, x0.y, x1.x, x1.y}), mk8(bp), yd[pt]); }
            }
            const float eal = ex2(al * LOG2E); float ss = 0.f;
            bf16* yrow = Y + (size_t)(row0 + lcol) * 3072 + h * 64 + 4 * gq;
#pragma unroll
            for (int pt = 0; pt < 4; ++pt) {
                const u32x2 zw = *(const u32x2*)(yrow + 16 * pt); const float z[4] = {bflo(zw.x), bfhi(zw.x), bflo(zw.y), bfhi(zw.y)}; float yg[4];
#pragma unroll
                for (int r = 0; r < 4; ++r) { const float xs = bf2f(xth[(size_t)(16 * pt + 4 * gq + r) * 128 + lcol]);
                    yg[r] = (yd[pt][r] + eal * yo[pt][r] + Dh * xs) * siluf(z[r]); ss += yg[r] * yg[r]; }
                u32x2 w; w.x = pk2(yg[0], yg[1]); w.y = pk2(yg[2], yg[3]); *(u32x2*)(yrow + 16 * pt) = w;
            }
            ss += __shfl_xor(ss, 16); ss += __shfl_xor(ss, 32);
            if (gq == 0) ssum[wave * 128 + lcol] = ss;
        }
        __syncthreads();
#pragma unroll 1
        for (int lt = 0; lt < 8; ++lt) {
            const int lcol = 16 * lt + li; float tot = 0.f;
#pragma unroll
            for (int w = 0; w < 8; ++w) tot += ssum[w * 128 + lcol];
            const float rstd = 1.0f / sqrtf(tot * (1.f / 512.f) + 1e-5f);
            bf16* yrow = Y + (size_t)(row0 + lcol) * 3072 + h * 64 + 4 * gq; const float* nw = a.in[16] + h * 64 + 4 * gq;
#pragma unroll
            for (int pt = 0; pt < 4; ++pt) { const u32x2 yw = *(const u32x2*)(yrow + 16 * pt); const f32x4 w4 = *(const f32x4*)(nw + 16 * pt); u32x2 w;
                w.x = pk2(bflo(yw.x) * rstd * w4[0], bfhi(yw.x) * rstd * w4[1]); w.y = pk2(bflo(yw.y) * rstd * w4[2], bfhi(yw.y) * rstd * w4[3]); *(u32x2*)(yrow + 16 * pt) = w; }
        }
        __syncthreads();
    }
}

template <class Epi> __device__ __forceinline__ void run_gemm(LAS unsigned char* lds, const bf16* A, const bf16* Bt, int N, int K, const Epi& E) {
    pg8::Gemm g{A, Bt, M, N, K}; pg8::StaticOrder S; S.init(M, N, (int)gridDim.x, (int)blockIdx.x);
    pg8::gemm_phase<Epi, pg8::StaticOrder, true, true>(lds, g, S, E);
}
__global__ void __launch_bounds__(512, 2) mk_fwd(P a) {
    extern __shared__ __attribute__((aligned(16))) unsigned char lds_raw[];
    LAS unsigned char* lds = (LAS unsigned char*)lds_raw;
    for (int ph = a.ph_lo; ph < a.ph_hi; ++ph) {
        int tid = threadIdx.x; asm volatile("" : "+v"(tid));
        const int lane = tid & 63, wave = __builtin_amdgcn_readfirstlane(tid >> 6);
        unsigned char* ws = a.ws; asm volatile("" : "+s"(ws));
        bf16* hb = (bf16*)(ws + WS_HB); bf16* act = (bf16*)(ws + WS_ACT); float* hs = (float*)(ws + WS_HS);
        unsigned char* gs = g_scratch; asm volatile("" : "+s"(gs));
        bf16* ymix = (bf16*)(gs + G_YMIX);
        if (ph == 0) prologue_phase(a, lds, wave, lane);
        else if (ph <= 3 || (ph >= 13 && ph <= 18) || ph >= 23) {
            const int base = ph <= 3 ? 1 : ph <= 15 ? 13 : ph <= 18 ? 16 : 23, f = ph <= 3 ? 0 : ph <= 15 ? 1 : ph <= 18 ? 2 : 3, sub = ph - base;
            if (sub == 0) { EpiSwiGLU E{act}; run_gemm(lds, hb, (const bf16*)(ws + WS_GU + f * SZ_GU), 5632, 1024, E); }
            else if (sub == 1) { EpiResid E{a.out, hs, 0.5f}; run_gemm(lds, act, (const bf16*)(ws + WS_DN + f * SZ_DN), 1024, DFF, E); }
            else { const int li_ = (f >> 1) * 3 + ((f & 1) ? 2 : 0); ln_phase(a, a.in[2] + li_ * 1024, a.in[3] + li_ * 1024, ph == 25, wave, lane); }
        }
        else if (ph == 4) {
            EpiSplit E{}; E.A = ymix; E.lda = 3072; E.ca = 0; E.t_a = 8; E.B = (bf16*)(g_scratch + G_XBC); E.ldb = 3072; E.cb = 0; E.t_b = 20;
            E.C = ymix; E.ldc = 3072; E.cc = 2048; E.t_c = 24; E.qs = QSCALE; E.Dd = (bf16*)(ws + WS_K); E.ldd = 1024; E.cd = 0; E.t_d = 28;
            E.VT = (bf16*)(ws + WS_VT); E.t_e = 32; E.hd_shift = 6; E.nheads = 16; E.dtf = (float*)(ws + WS_DTF);
            run_gemm(lds, hb, (const bf16*)(ws + WS_WIN), NIN_PAD, 1024, E);
        }
        else if (ph == 5) c2_phase(a, lds, tid, wave, lane);
        else if (ph == 6) fox_phase(a, wave, lane);
        else if (ph == 7) ssd_prep_phase(a, lds, tid, wave, lane);
        else if (ph == 8) ssd_s1_phase(a, wave, lane);
        else if (ph == 9) ssd_scan_phase(a, tid);
        else if (ph == 10) ssd_s3_phase(a, lds, wave, lane);
        else if (ph == 11) { EpiResid E{a.out, hs, 1.0f}; run_gemm(lds, ymix, (const bf16*)(ws + WS_WOUT), 1024, 3072, E); }
        else if (ph == 12) ln_phase(a, a.in[2] + 1 * 1024, a.in[3] + 1 * 1024, false, wave, lane);
        else if (ph == 19) {
            EpiSplit E{}; E.t_a = 0; E.t_b = 0; E.A = E.B = nullptr; E.lda = E.ldb = 0; E.ca = E.cb = 0;
            E.C = (bf16*)(g_scratch + G_DQ); E.ldc = 1024; E.cc = 0; E.t_c = 4; E.qs = QSCALE; E.Dd = (bf16*)(g_scratch + G_DK); E.ldd = 1024; E.cd = 0; E.t_d = 8;
            E.VT = (bf16*)(g_scratch + G_DVT); E.t_e = 12; E.hd_shift = 7; E.nheads = 8; E.dtf = nullptr;
            run_gemm(lds, hb, (const bf16*)(ws + WS_WQKV), 3072, 1024, E);
        }
        else if (ph == 20) diff_phase(a, lds, tid, wave, lane);
        else if (ph == 21) { EpiResid E{a.out, hs, 1.0f}; run_gemm(lds, (const bf16*)(g_scratch + G_DQ), (const bf16*)(ws + WS_WO), 1024, 1024, E); }
        else if (ph == 22) ln_phase(a, a.in[2] + 4 * 1024, a.in[3] + 4 * 1024, false, wave, lane);
        if (ph + 1 < a.ph_hi) { __threadfence(); cg::this_grid().sync(); }
    }
}
}

extern "C" void kernel_launch(void* const* d_in, const int* in_sizes, int n_in, void* d_out, int out_size, void* d_ws, size_t ws_size, hipStream_t stream) {
    static int grid = 0;
    if (grid == 0) {
        if (n_in != 27 || ws_size < mk::WS_END) { fprintf(stderr, "kernel_launch: unexpected n_in %d / ws_size %zu (need %zu)\n", n_in, ws_size, (size_t)mk::WS_END); grid = -1; return; }
        int dev = 0, cus = 0, per_cu = 0;
        hipGetDevice(&dev); hipDeviceGetAttribute(&cus, hipDeviceAttributeMultiprocessorCount, dev);
        if (hipFuncSetAttribute((const void*)mk::mk_fwd, hipFuncAttributeMaxDynamicSharedMemorySize, mk::LDS_BYTES) != hipSuccess) { fprintf(stderr, "kernel_launch: hipFuncSetAttribute failed\n"); grid = -1; return; }
        hipOccupancyMaxActiveBlocksPerMultiprocessor(&per_cu, (const void*)mk::mk_fwd, 512, mk::LDS_BYTES);
        (void)hipGetLastError();
        if (per_cu < 1) fprintf(stderr, "kernel_launch: occupancy query says %d blocks/CU\n", per_cu);
        grid = cus > 0 ? cus : 256;
    }
    if (grid < 0) return;
    mk::P a{};
    for (int i = 0; i < 27; ++i) a.in[i] = (const float*)d_in[i];
    a.out = (float*)d_out; a.ws = (unsigned char*)d_ws;
#if MK_MULTI
    for (int ph = 0; ph < mk::NPH; ++ph) { a.ph_lo = ph; a.ph_hi = ph + 1; hipLaunchKernelGGL(mk::mk_fwd, dim3(grid), dim3(512), mk::LDS_BYTES, stream, a); }
#else
    a.ph_lo = 0; a.ph_hi = mk::NPH;
    void* args[] = {&a};
    hipError_t e = hipLaunchCooperativeKernel((const void*)mk::mk_fwd, dim3(grid), dim3(512), args, mk::LDS_BYTES, stream);
    if (e != hipSuccess) fprintf(stderr, "cooperative launch failed: %s (grid %d)\n", hipGetErrorString(e), grid);
#endif
}
```

```cpp
#include <hip/hip_runtime.h>
#include <hip/hip_cooperative_groups.h>
#include <cstdio>
#include <cstdint>
namespace cg = cooperative_groups;
namespace pg8 {
#define PG8_LAS __attribute__((address_space(3)))
typedef unsigned short bf16_t;
typedef short bf16x8 __attribute__((ext_vector_type(8)));
typedef float f32x4 __attribute__((ext_vector_type(4)));
typedef unsigned u32x4 __attribute__((ext_vector_type(4)));
constexpr int BM = 256, BK = 64, HALF = 128, HTB = HALF * BK * 2  , STAGE_BYTES = 8 * HTB, NXCD = 8, WGM = 8;

__host__ __device__ __forceinline__ int lds_byte(int r, int c) { const int st = (r >> 4) * 2 + (c >> 5), rr = r & 15, cc = c & 31, ob = rr * 64 + cc * 2; return st * 1024 + (ob ^ (((ob >> 9) & 1) << 5)); }
__host__ __device__ __forceinline__ void stage_rc(int b, int& R, int& C) { const int st = b / 1024, sb = b % 1024, swz = sb ^ (((sb >> 9) & 1) << 5); R = (st >> 1) * 16 + swz / 64; C = (st & 1) * 32 + (swz % 64) / 2; }
__host__ __device__ __forceinline__ int perm32(int rho) { const int n = rho >> 4, i = rho & 15; return 8 * (i >> 2) + 4 * n + (i & 3); }

struct Unit { int pm, pn; };
struct Gemm { const bf16_t* A; const bf16_t* Bt; int M, N, K, ld; };

struct StaticOrder {
    int nM, nN, nwg, G, c;
    __host__ __device__ void init(int M, int N, int G_, int c_) { nM = M / BM; nN = N / BM; nwg = nM * nN; G = G_; c = c_; }
    __host__ __device__ bool next(int i, Unit& u) const {
        const long L = (long)i * G + c; if (L >= nwg) return false;
        int wgid = (int)L; { const int q = nwg / NXCD, r = nwg % NXCD, xcd = wgid % NXCD, off = wgid / NXCD; wgid = (xcd < r ? xcd * (q + 1) : r * (q + 1) + (xcd - r) * q) + off; }
        const int nig = WGM * nN, gid = wgid / nig, fm = gid * WGM, gsz = (nM - fm) < WGM ? (nM - fm) : WGM;
        u.pm = fm + ((wgid % nig) % gsz); u.pn = (wgid % nig) / gsz; return true;
    }
    __device__ __forceinline__ void a_ready(const Unit&) const {}
    __device__ __forceinline__ void done(const Unit&) const {}
};

__device__ __forceinline__ unsigned cvt_pk_bf16(float lo, float hi) { unsigned r; asm volatile("v_cvt_pk_bf16_f32 %0, %1, %2" : "=v"(r) : "v"(lo), "v"(hi)); return r; }
typedef float f32x2 __attribute__((ext_vector_type(2)));
__device__ __forceinline__ f32x2 gelu_pk(f32x2 v) {
    const f32x2 av = __builtin_elementwise_abs(v), d = av * 0.2316418882f + 1.0f;
    f32x2 t; t.x = __builtin_amdgcn_rcpf(d.x); t.y = __builtin_amdgcn_rcpf(d.y);
    f32x2 q = t * 0.5307027145f + (-0.7265760135f); q = q * t + 0.7107068705f; q = q * t + (-0.142248368f); q = q * t + 0.127414796f; q = q * t;
    const f32x2 s = (v * v) * (-0.72134752044f);
    f32x2 e; e.x = __builtin_amdgcn_exp2f(s.x); e.y = __builtin_amdgcn_exp2f(s.y);
    const f32x2 m = v * (q * e), r = v - m;
    f32x2 o; o.x = v.x < 0.f ? m.x : r.x; o.y = v.y < 0.f ? m.y : r.y; return o;
}

template <int ACT  > struct EpiBf16 {
    static constexpr bool PERM = true, AFTER_DRAIN = false; static_assert(ACT == 0 || ACT == 1, "EpiBf16: ACT is 0 (none) or 1 (gelu_pk)");
    bf16_t* O; int ldc; const float* bias; int split_cols; size_t split_stride; float scale0;
    __device__ __forceinline__ void operator()(const f32x4 (&acc)[2][2][4][2], const Unit& u, int wr, int wc, int fr, int fq) const {
        const int row0 = u.pm * BM + wr * 64 + fr; int colt = u.pn * BM; bf16_t* base = O;
        float sc = 1.f; if (split_cols) { const int t = colt / split_cols; base += (size_t)t * split_stride; colt -= t * split_cols; if (t == 0) sc = scale0; }
        const int col0 = colt + wc * 32 + 8 * fq, bcol0 = u.pn * BM + wc * 32 + 8 * fq;
        f32x4 bv[2][2];
#pragma unroll
        for (int bj = 0; bj < 2; ++bj)
#pragma unroll
            for (int n = 0; n < 2; ++n) bv[bj][n] = bias ? *(const f32x4*)(bias + bcol0 + bj * HALF + 4 * n) : (f32x4){0.f, 0.f, 0.f, 0.f};
#pragma unroll
        for (int ai = 0; ai < 2; ++ai)
#pragma unroll
            for (int m = 0; m < 4; ++m) { bf16_t* rowp = base + (size_t)(row0 + ai * HALF + m * 16) * ldc + col0;
#pragma unroll
                for (int bj = 0; bj < 2; ++bj) { f32x4 v0 = acc[ai][bj][m][0] + bv[bj][0], v1 = acc[ai][bj][m][1] + bv[bj][1];
                    if (ACT == 1) { f32x2 a = gelu_pk((f32x2){v0[0], v0[1]}), b = gelu_pk((f32x2){v0[2], v0[3]}), c = gelu_pk((f32x2){v1[0], v1[1]}), d = gelu_pk((f32x2){v1[2], v1[3]});
                        v0 = (f32x4){a.x, a.y, b.x, b.y}; v1 = (f32x4){c.x, c.y, d.x, d.y}; }
                    v0 = v0 * sc; v1 = v1 * sc; u32x4 w; w.x = cvt_pk_bf16(v0[0], v0[1]); w.y = cvt_pk_bf16(v0[2], v0[3]); w.z = cvt_pk_bf16(v1[0], v1[1]); w.w = cvt_pk_bf16(v1[2], v1[3]);
                    *(u32x4*)(rowp + bj * HALF) = w; } }
    }
};

struct PanelStats {
    unsigned* xbuf;
    unsigned* cnt;
    unsigned* tmo;
    int ntn; float eps;
    unsigned code;
    __device__ __forceinline__ bool run(const f32x4 (&v)[2][2][4][2], const Unit& u, int wr, int wc, int fr, int fq, PG8_LAS unsigned char* lds, int wid, int lane) const {
        typedef float f32x2v __attribute__((ext_vector_type(2)));
        PG8_LAS f32x2v* P = (PG8_LAS f32x2v*)lds;
        PG8_LAS f32x2v* S = (PG8_LAS f32x2v*)(lds + 8192);
        PG8_LAS unsigned* flag = (PG8_LAS unsigned*)(lds + 8192 + 2048);
#pragma unroll
        for (int ai = 0; ai < 2; ++ai)
#pragma unroll
            for (int m = 0; m < 4; ++m) {
                float s = 0.f;
#pragma unroll
                for (int bj = 0; bj < 2; ++bj)
#pragma unroll
                    for (int n = 0; n < 2; ++n) { const f32x4 x = v[ai][bj][m][n]; s += (x[0] + x[1]) + (x[2] + x[3]); }
                s += __shfl_xor(s, 16); s += __shfl_xor(s, 32);
                const float mw = s * (1.0f / 64.0f); float q = 0.f;
#pragma unroll
                for (int bj = 0; bj < 2; ++bj)
#pragma unroll
                    for (int n = 0; n < 2; ++n) { const f32x4 d = v[ai][bj][m][n] - mw; q += (d[0] * d[0] + d[1] * d[1]) + (d[2] * d[2] + d[3] * d[3]); }
                q += __shfl_xor(q, 16); q += __shfl_xor(q, 32);
                if (fq == 0) P[(ai * HALF + wr * 64 + m * 16 + fr) * 4 + wc] = (f32x2v){mw, q};
            }
        asm volatile("s_waitcnt lgkmcnt(0)" ::: "memory"); __builtin_amdgcn_s_barrier(); asm volatile("" ::: "memory");
#if defined(BROKEN_EXCHANGE_NO_WAIT)
#warning BROKEN CONTROL BUILD: the row-statistics exchange does not wait; results are wrong by design
        if (blockIdx.x >= 64) { const long long t0_ = clock64(); while (clock64() - t0_ < 60000) __builtin_amdgcn_s_sleep(8); }
#endif
        const int row = wid * 32 + (lane & 31);
        if (lane < 32) {
            const f32x2v a = P[row * 4 + 0], b = P[row * 4 + 1], c = P[row * 4 + 2], d = P[row * 4 + 3];
            const float mt = (a.x + b.x + c.x + d.x) * 0.25f;
            const float da = a.x - mt, db = b.x - mt, dc = c.x - mt, dd = d.x - mt;
            const float m2 = (a.y + b.y) + (c.y + d.y) + 64.0f * ((da * da + db * db) + (dc * dc + dd * dd));
            unsigned long long* slot = (unsigned long long*)xbuf + ((size_t)(u.pm * BM + row) * 4 + u.pn);
            __hip_atomic_store(slot, ((unsigned long long)__float_as_uint(m2) << 32) | __float_as_uint(mt), __ATOMIC_RELAXED, __HIP_MEMORY_SCOPE_AGENT);
        }
        asm volatile("s_waitcnt vmcnt(0)" ::: "memory");
        if (lane == 0) __hip_atomic_fetch_add(cnt + 64 * u.pm, 1u, __ATOMIC_RELAXED, __HIP_MEMORY_SCOPE_AGENT);
        if (wid == 0) {
            bool dead = false; const unsigned long long t0 = __builtin_amdgcn_s_memrealtime(); const unsigned want = 8u * (unsigned)ntn;
            for (;;) {
#if defined(BROKEN_EXCHANGE_NO_WAIT)
                break;
#endif
                if ((unsigned)__builtin_amdgcn_readfirstlane(__hip_atomic_load(cnt + 64 * u.pm, __ATOMIC_RELAXED, __HIP_MEMORY_SCOPE_AGENT)) >= want) break;
                if (__builtin_amdgcn_s_memrealtime() - t0 > 2000000ull) {
                    if (lane == 0) { unsigned expect = 0u; __hip_atomic_compare_exchange_strong(tmo + 1, &expect, code | (unsigned)(u.pm & 0xff), __ATOMIC_RELAXED, __ATOMIC_RELAXED, __HIP_MEMORY_SCOPE_AGENT);
                                     __hip_atomic_store(tmo, 1u, __ATOMIC_RELAXED, __HIP_MEMORY_SCOPE_AGENT); }
                    dead = true; break; }
                __builtin_amdgcn_s_sleep(2);
            }
            __builtin_amdgcn_fence(__ATOMIC_ACQUIRE, "agent");
            if (lane == 0) flag[0] = dead ? 1u : 0u;
        }
        asm volatile("s_waitcnt vmcnt(0) lgkmcnt(0)" ::: "memory"); __builtin_amdgcn_s_barrier(); asm volatile("" ::: "memory");
        const bool bad = flag[0] != 0u;
        if (lane < 32) {
            const unsigned long long* slot = (const unsigned long long*)xbuf + (size_t)(u.pm * BM + row) * 4; float mt[4], m2[4]; float ms = 0.f;
#pragma unroll
            for (int t = 0; t < 4; ++t) { if (t < ntn) { const unsigned long long w = __hip_atomic_load(slot + t, __ATOMIC_RELAXED, __HIP_MEMORY_SCOPE_AGENT); mt[t] = __uint_as_float((unsigned)w); m2[t] = __uint_as_float((unsigned)(w >> 32)); } else { mt[t] = 0.f; m2[t] = 0.f; } ms += mt[t]; }
            const float mean = ms / (float)ntn; float q = 0.f;
#pragma unroll
            for (int t = 0; t < 4; ++t) if (t < ntn) { const float dm = mt[t] - mean; q += m2[t] + 256.0f * dm * dm; }
            S[row] = (f32x2v){mean, 1.0f / sqrtf(q / (256.0f * (float)ntn) + eps)};
        }
        asm volatile("s_waitcnt lgkmcnt(0)" ::: "memory"); __builtin_amdgcn_s_barrier(); asm volatile("" ::: "memory");
        return bad;
    }
};
struct EpiLnRes {
    static constexpr bool PERM = false, AFTER_DRAIN = true;
    const float* base; float* out; int ldc; const float* bias; PanelStats st; unsigned poison;
    __device__ __forceinline__ void fused(f32x4 (&acc)[2][2][4][2], const Unit& u, int wr, int wc, int fr, int fq, PG8_LAS unsigned char* lds, int wid, int lane) const {
        typedef float f32x2v __attribute__((ext_vector_type(2)));
        const PG8_LAS f32x2v* S = (const PG8_LAS f32x2v*)(lds + 8192);
        const int col0 = u.pn * BM + wc * 32 + 4 * fq;
#pragma unroll
        for (int bj = 0; bj < 2; ++bj)
#pragma unroll
            for (int n = 0; n < 2; ++n) { const f32x4 bv = bias ? *(const f32x4*)(bias + col0 + bj * HALF + n * 16) : (f32x4){0.f, 0.f, 0.f, 0.f};
#pragma unroll
                for (int ai = 0; ai < 2; ++ai)
#pragma unroll
                    for (int m = 0; m < 4; ++m) acc[ai][bj][m][n] += bv; }
        f32x4 pre[4][2][2];
#pragma unroll
        for (int m = 0; m < 4; ++m) { const size_t off = (size_t)(u.pm * BM + wr * 64 + m * 16 + fr) * ldc + col0;
#pragma unroll
            for (int bj = 0; bj < 2; ++bj)
#pragma unroll
                for (int n = 0; n < 2; ++n) pre[m][bj][n] = *(const f32x4*)(base + off + bj * HALF + n * 16); }
        const bool bad = st.run(acc, u, wr, wc, fr, fq, lds, wid, lane) || poison != 0u;
        const float qnan = __builtin_nanf("");
#pragma unroll
        for (int ai = 0; ai < 2; ++ai)
#pragma unroll
            for (int m = 0; m < 4; ++m) { const int r = ai * HALF + wr * 64 + m * 16 + fr; const f32x2v sr = S[r]; const size_t off = (size_t)(u.pm * BM + r) * ldc + col0;
#pragma unroll
                for (int bj = 0; bj < 2; ++bj)
#pragma unroll
                    for (int n = 0; n < 2; ++n) { const f32x4 bs = ai == 0 ? pre[m][bj][n] : *(const f32x4*)(base + off + bj * HALF + n * 16); f32x4 o = bs + (acc[ai][bj][m][n] - sr.x) * sr.y;
                        if (bad) o = (f32x4){qnan, qnan, qnan, qnan}; *(f32x4*)(out + off + bj * HALF + n * 16) = o; }
                if (m & 1) asm volatile("" ::: "memory"); }
    }
};
struct EpiLnResLn {
    static constexpr bool PERM = false, AFTER_DRAIN = true;
    const float* base; float* out; bf16_t* xn; int ldc; const float* bias; PanelStats st1, st2; unsigned poison;
    __device__ __forceinline__ void fused(f32x4 (&acc)[2][2][4][2], const Unit& u, int wr, int wc, int fr, int fq, PG8_LAS unsigned char* lds, int wid, int lane) const {
        typedef float f32x2v __attribute__((ext_vector_type(2))); typedef unsigned u32x2v __attribute__((ext_vector_type(2)));
        const PG8_LAS f32x2v* S = (const PG8_LAS f32x2v*)(lds + 8192);
        const int col0 = u.pn * BM + wc * 32 + 4 * fq;
#pragma unroll
        for (int bj = 0; bj < 2; ++bj)
#pragma unroll
            for (int n = 0; n < 2; ++n) { const f32x4 bv = bias ? *(const f32x4*)(bias + col0 + bj * HALF + n * 16) : (f32x4){0.f, 0.f, 0.f, 0.f};
#pragma unroll
                for (int ai = 0; ai < 2; ++ai)
#pragma unroll
                    for (int m = 0; m < 4; ++m) acc[ai][bj][m][n] += bv; }
        bool bad = st1.run(acc, u, wr, wc, fr, fq, lds, wid, lane) || poison != 0u;
        const float qnan = __builtin_nanf("");
#pragma unroll
        for (int ai = 0; ai < 2; ++ai)
#pragma unroll
            for (int m = 0; m < 4; ++m) { const int r = ai * HALF + wr * 64 + m * 16 + fr; const f32x2v sr = S[r]; const size_t off = (size_t)(u.pm * BM + r) * ldc + col0;
#pragma unroll
                for (int bj = 0; bj < 2; ++bj)
#pragma unroll
                    for (int n = 0; n < 2; ++n) { const f32x4 bs = *(const f32x4*)(base + off + bj * HALF + n * 16); acc[ai][bj][m][n] = bs + (acc[ai][bj][m][n] - sr.x) * sr.y; }
                asm volatile("" : "+v"(acc[ai][0][m][0]), "+v"(acc[ai][0][m][1]), "+v"(acc[ai][1][m][0]), "+v"(acc[ai][1][m][1]));
                if (m & 1) asm volatile("" ::: "memory"); }
        const bool bad1 = bad;
        bad = st2.run(acc, u, wr, wc, fr, fq, lds, wid, lane) || bad;
#pragma unroll
        for (int ai = 0; ai < 2; ++ai)
#pragma unroll
            for (int m = 0; m < 4; ++m) { const int r = ai * HALF + wr * 64 + m * 16 + fr; const f32x2v sr = S[r]; const size_t off = (size_t)(u.pm * BM + r) * ldc + col0;
#pragma unroll
                for (int bj = 0; bj < 2; ++bj)
#pragma unroll
                    for (int n = 0; n < 2; ++n) { const f32x4 x1 = acc[ai][bj][m][n]; *(f32x4*)(out + off + bj * HALF + n * 16) = bad1 ? (f32x4){qnan, qnan, qnan, qnan} : x1;
                        const f32x4 o = (x1 - sr.x) * sr.y; u32x2v w; w.x = cvt_pk_bf16(o[0], o[1]); w.y = cvt_pk_bf16(o[2], o[3]);
                        if (bad) { w.x = 0x7fc07fc0u; w.y = 0x7fc07fc0u; } *(u32x2v*)(xn + off + bj * HALF + n * 16) = w; }
                asm volatile("" ::: "memory"); }
    }
};

template <class Epi, class Sched, bool ALIGN_EPI = false, bool SP2 = false>
__device__ __forceinline__ void gemm_phase(PG8_LAS unsigned char* lds, const Gemm g, const Sched& S, const Epi& E) {
    int tid_raw_ = threadIdx.x; asm volatile("" : "+v"(tid_raw_));
    const int tid = tid_raw_, wid = __builtin_amdgcn_readfirstlane(tid >> 6), lane = tid & 63, wr = wid >> 2, wc = wid & 3, fr = lane & 15, fq = lane >> 4;
    const int K = g.K, nt = K / BK, LD = g.ld;
    unsigned voffA[2], voffB[2];
#pragma unroll
    for (int i = 0; i < 2; ++i) { int R, C; stage_rc(tid * 16 + i * 8192, R, C); const int Rb = Epi::PERM ? ((R & ~31) + perm32(R & 31)) : R;
        voffA[i] = (unsigned)(R * LD + C) * 2u; voffB[i] = (unsigned)(Rb * LD + C) * 2u; }
    const size_t kstep = (size_t)(BK * 2);
    const size_t hstep = (size_t)HALF * LD * 2;
    const size_t tstep = 2 * hstep;
    const unsigned ldsw = (unsigned)wid * 1024u;
    const int aoff = lds_byte(wr * 64 + fr, fq * 8), boff = lds_byte(wc * 32 + fr, fq * 8);
#define PG8_SA(b, h) (((b) * 2 + (h)) * HTB)
#define PG8_SB(b, h) ((4 + (b) * 2 + (h)) * HTB)
#define PG8_STAGE(bufoff, gbase, voff) do { _Pragma("unroll") for (int _i = 0; _i < 2; ++_i) \
        __builtin_amdgcn_global_load_lds((const unsigned*)((const char*)(gbase) + (voff)[_i]), (PG8_LAS unsigned*)(lds + (bufoff) + ldsw + _i * 8192), 16, 0, 0); } while (0)
#define PG8_LDA(dst, b, h) do { _Pragma("unroll") for (int m = 0; m < 4; ++m) _Pragma("unroll") for (int k = 0; k < 2; ++k) dst[m][k] = *(const PG8_LAS bf16x8*)(lds + PG8_SA(b, h) + aoff + m * 2048 + k * 1024); } while (0)
#define PG8_LDB(dst, b, h) do { _Pragma("unroll") for (int n = 0; n < 2; ++n) _Pragma("unroll") for (int k = 0; k < 2; ++k) dst[n][k] = *(const PG8_LAS bf16x8*)(lds + PG8_SB(b, h) + boff + n * 2048 + k * 1024); } while (0)
#define PG8_MMA(ai, bj, At, Bt) do { __builtin_amdgcn_s_setprio(1); _Pragma("unroll") for (int m = 0; m < 4; ++m) _Pragma("unroll") for (int n = 0; n < 2; ++n) _Pragma("unroll") for (int k = 0; k < 2; ++k) \
        acc[ai][bj][m][n] = __builtin_amdgcn_mfma_f32_16x16x32_bf16(Bt[n][k], At[m][k], acc[ai][bj][m][n], 0, 0, 0); __builtin_amdgcn_s_setprio(0); } while (0)
#define PG8_WAIT_V(n) asm volatile("s_waitcnt vmcnt(" #n ")" ::: "memory")
#define PG8_WAIT_L(n) asm volatile("s_waitcnt lgkmcnt(" #n ")" ::: "memory")
#define PG8_BAR __builtin_amdgcn_s_barrier()
#define PG8_SCHED __builtin_amdgcn_sched_barrier(0)
    Unit cur, nxt; int ui = 0;
    if (!S.next(0, cur)) return;
    f32x4 acc[2][2][4][2];
#pragma unroll
    for (int a = 0; a < 2; ++a)
#pragma unroll
        for (int b = 0; b < 2; ++b)
#pragma unroll
            for (int m = 0; m < 4; ++m)
#pragma unroll
                for (int n = 0; n < 2; ++n) acc[a][b][m][n] = (f32x4){0.f, 0.f, 0.f, 0.f};
    bf16x8 At[4][2], B0[2][2], B1[2][2];
    const char* cA = (const char*)g.A + (size_t)cur.pm * tstep; const char* cB = (const char*)g.Bt + (size_t)cur.pn * tstep;
    S.a_ready(cur);
    if constexpr (SP2) {
        PG8_STAGE(PG8_SB(0, 0), cB, voffB); PG8_STAGE(PG8_SB(0, 1), cB + hstep, voffB); PG8_STAGE(PG8_SA(0, 0), cA, voffA); PG8_STAGE(PG8_SA(0, 1), cA + hstep, voffA);
        if (wr == 1) PG8_BAR;
        PG8_WAIT_V(2); PG8_BAR;
        PG8_STAGE(PG8_SB(1, 0), cB + kstep, voffB); PG8_STAGE(PG8_SA(1, 0), cA + kstep, voffA); PG8_STAGE(PG8_SB(1, 1), cB + hstep + kstep, voffB);
        PG8_WAIT_V(6); PG8_BAR;
    } else {
        PG8_STAGE(PG8_SB(0, 0), cB, voffB); PG8_STAGE(PG8_SA(0, 0), cA, voffA); PG8_STAGE(PG8_SB(0, 1), cB + hstep, voffB); PG8_STAGE(PG8_SA(0, 1), cA + hstep, voffA);
        if (wr == 1) PG8_BAR;
        PG8_WAIT_V(4); PG8_BAR;
        PG8_STAGE(PG8_SB(1, 0), cB + kstep, voffB); PG8_STAGE(PG8_SA(1, 0), cA + kstep, voffA); PG8_STAGE(PG8_SB(1, 1), cB + hstep + kstep, voffB);
        PG8_WAIT_V(6); PG8_BAR;
    }
    for (;;) {
        const bool has_next = S.next(ui + 1, nxt);
        const char* nA = has_next ? (const char*)g.A + (size_t)nxt.pm * tstep : cA; const char* nB = has_next ? (const char*)g.Bt + (size_t)nxt.pn * tstep : cB;
        for (int t = 0; t < nt; t += 2) {
            const bool last = (t == nt - 2);
            const char* a1 = cA + (size_t)(t + 1) * kstep;
            const char* a2 = last ? nA : cA + (size_t)(t + 2) * kstep; const char* b2 = last ? nB : cB + (size_t)(t + 2) * kstep;
            const char* a3 = a2 + kstep; const char* b3 = b2 + kstep;
            if (last && has_next) S.a_ready(nxt);
            if constexpr (SP2) {
            PG8_LDB(B0, 0, 0); PG8_LDB(B1, 0, 1); PG8_SCHED; PG8_LDA(At, 0, 0); PG8_STAGE(PG8_SA(1, 1), a1 + hstep, voffA);
            PG8_WAIT_V(8); PG8_WAIT_L(0); PG8_BAR; PG8_MMA(0, 0, At, B0); PG8_MMA(0, 1, At, B1); PG8_BAR; PG8_SCHED;
            PG8_LDA(At, 0, 1); PG8_STAGE(PG8_SB(0, 0), b2, voffB); PG8_STAGE(PG8_SB(0, 1), b2 + hstep, voffB); PG8_STAGE(PG8_SA(0, 0), a2, voffA);
            PG8_WAIT_V(8); PG8_WAIT_L(0); PG8_BAR; PG8_MMA(1, 0, At, B0); PG8_MMA(1, 1, At, B1); PG8_BAR; PG8_SCHED;
            PG8_LDB(B0, 1, 0); PG8_LDB(B1, 1, 1); PG8_SCHED; PG8_LDA(At, 1, 0); PG8_STAGE(PG8_SA(0, 1), a2 + hstep, voffA);
            PG8_WAIT_V(8); PG8_WAIT_L(0); PG8_BAR; PG8_MMA(0, 0, At, B0); PG8_MMA(0, 1, At, B1); PG8_BAR; PG8_SCHED;
            PG8_LDA(At, 1, 1); PG8_STAGE(PG8_SB(1, 0), b3, voffB); PG8_STAGE(PG8_SB(1, 1), b3 + hstep, voffB); PG8_STAGE(PG8_SA(1, 0), a3, voffA);
            PG8_WAIT_V(8); PG8_WAIT_L(0); PG8_BAR; PG8_MMA(1, 0, At, B0); PG8_MMA(1, 1, At, B1); PG8_BAR; PG8_SCHED;
            } else {
            PG8_LDB(B0, 0, 0); PG8_SCHED; PG8_LDA(At, 0, 0); PG8_STAGE(PG8_SA(1, 1), a1 + hstep, voffA);
            PG8_WAIT_L(8); PG8_BAR; PG8_WAIT_L(0); PG8_MMA(0, 0, At, B0); PG8_BAR; PG8_SCHED;
            PG8_LDB(B1, 0, 1); PG8_STAGE(PG8_SB(0, 0), b2, voffB);
            PG8_BAR; PG8_WAIT_L(0); PG8_MMA(0, 1, At, B1); PG8_BAR;
            PG8_LDA(At, 0, 1); PG8_STAGE(PG8_SA(0, 0), a2, voffA);
            PG8_BAR; PG8_WAIT_L(0); PG8_MMA(1, 0, At, B0); PG8_BAR; PG8_SCHED;
            PG8_STAGE(PG8_SB(0, 1), b2 + hstep, voffB);
            PG8_WAIT_V(6); PG8_BAR; PG8_MMA(1, 1, At, B1); PG8_BAR;
            PG8_LDB(B0, 1, 0); PG8_SCHED; PG8_LDA(At, 1, 0); PG8_STAGE(PG8_SA(0, 1), a2 + hstep, voffA);
            PG8_WAIT_L(8); PG8_BAR; PG8_WAIT_L(0); PG8_MMA(0, 0, At, B0); PG8_BAR; PG8_SCHED;
            PG8_LDB(B1, 1, 1); PG8_STAGE(PG8_SB(1, 0), b3, voffB);
            PG8_BAR; PG8_WAIT_L(0); PG8_MMA(0, 1, At, B1); PG8_BAR;
            PG8_LDA(At, 1, 1); PG8_STAGE(PG8_SA(1, 0), a3, voffA);
            PG8_BAR; PG8_WAIT_L(0); PG8_MMA(1, 0, At, B0); PG8_BAR; PG8_SCHED;
            PG8_STAGE(PG8_SB(1, 1), b3 + hstep, voffB);
            PG8_WAIT_V(6); PG8_BAR; PG8_MMA(1, 1, At, B1); PG8_BAR;
            }
        }
        if constexpr (ALIGN_EPI) { if (wr == 0) PG8_BAR; }
        if constexpr (!Epi::AFTER_DRAIN) { E(acc, cur, wr, wc, fr, fq); S.done(cur); }
        if (!has_next) break;
#pragma unroll
        for (int a = 0; a < 2; ++a)
#pragma unroll
            for (int b = 0; b < 2; ++b)
#pragma unroll
                for (int m = 0; m < 4; ++m)
#pragma unroll
                    for (int n = 0; n < 2; ++n) acc[a][b][m][n] = (f32x4){0.f, 0.f, 0.f, 0.f};
        cur = nxt; cA = nA; cB = nB; ++ui;
        if constexpr (ALIGN_EPI) { if (wr == 1) PG8_BAR; }
    }
    PG8_WAIT_V(0);
    if constexpr (!ALIGN_EPI) { if (wr == 0) PG8_BAR; }
    PG8_BAR;
    if constexpr (Epi::AFTER_DRAIN) { E.fused(acc, cur, wr, wc, fr, fq, lds, wid, lane); S.done(cur); }
#undef PG8_SA
#undef PG8_SB
#undef PG8_STAGE
#undef PG8_LDA
#undef PG8_LDB
#undef PG8_MMA
#undef PG8_WAIT_V
#undef PG8_WAIT_L
#undef PG8_BAR
#undef PG8_SCHED
}
}

#ifndef USE_XB
#define USE_XB 1
#endif
#ifndef MK_MULTI
#define MK_MULTI 0
#endif
namespace mk {
typedef unsigned short bf16;
typedef short bf16x8 __attribute__((ext_vector_type(8)));
typedef float f32x4 __attribute__((ext_vector_type(4)));
typedef unsigned u32x4 __attribute__((ext_vector_type(4)));
typedef unsigned u32x2 __attribute__((ext_vector_type(2)));
#define LAS __attribute__((address_space(3)))
#define XB_TMO      128
#define XB_XCNT(j)  (256  + 64 * (j))
#define XB_XSUB(j)  (1280 + 64 * (j))
#define XB_XGEN(j)  (2304 + 64 * (j))
#define XB_TOP      3328
#define XB_TOPGEN   3392
#define XCD_BAR_WORDS 3456
#define XB_SPIN_CAP (1u << 18)

__device__ __forceinline__ unsigned xb_ld(unsigned* p)              { return __hip_atomic_load(p, __ATOMIC_RELAXED, __HIP_MEMORY_SCOPE_AGENT); }
__device__ __forceinline__ unsigned xb_add(unsigned* p, unsigned v) { return __hip_atomic_fetch_add(p, v, __ATOMIC_RELAXED, __HIP_MEMORY_SCOPE_AGENT); }
__device__ __forceinline__ unsigned xb_xcc_id() { return (unsigned)__builtin_amdgcn_s_getreg((3 << 11) | 20) & 0xFu; }
#define XB_SPIN(cond, bar) do { unsigned _sp = 0; while (cond) { __builtin_amdgcn_s_sleep(1); \
    if ((++_sp & 255u) == 0u) { if (xb_ld(&(bar)[XB_TMO])) break; if (_sp > XB_SPIN_CAP) { atomicAdd(&(bar)[XB_TMO], 1u); break; } } } } while (0)

struct XcdBarrier {
    unsigned* bar; unsigned x;
    volatile LAS unsigned* st;
};

__device__ __forceinline__ XcdBarrier xcd_barrier_post(unsigned* bar, volatile LAS unsigned* st) {
    XcdBarrier b; b.bar = bar; b.x = xb_xcc_id(); b.st = st;
    if (threadIdx.x == 0) (void)xb_add(&bar[XB_XCNT(b.x)], 1u);
    return b;
}
__device__ __forceinline__ void xcd_barrier_complete(unsigned* bar, unsigned x, unsigned& nloc, unsigned& nx) {
    const unsigned G = gridDim.x * gridDim.y * gridDim.z;
    unsigned sum, cnt, mine, sp = 0u;
    for (;;) {
        sum = 0u; cnt = 0u; mine = 0u;
#pragma unroll
        for (unsigned j = 0; j < 16; ++j) { const unsigned c = xb_ld(&bar[XB_XCNT(j)]); sum += c; cnt += (c > 0u) ? 1u : 0u; mine = (j == x) ? c : mine; }
        if (sum == G) break;
        __builtin_amdgcn_s_sleep(1);
        if ((++sp & 255u) == 0u) { if (xb_ld(&bar[XB_TMO])) break; if (sp > XB_SPIN_CAP) { atomicAdd(&bar[XB_TMO], 1u); break; } }
    }
    nloc = mine > 0u ? mine : 1u; nx = cnt > 0u ? cnt : 1u;
}

__device__ __forceinline__ void xcd_barrier(const XcdBarrier& b) {
    asm volatile("s_waitcnt vmcnt(0)" ::: "memory");
    __syncthreads();
    if (threadIdx.x == 0) {
        unsigned* bar = b.bar;
        __builtin_amdgcn_s_waitcnt(0);
        unsigned nloc = b.st[0], nx = b.st[1];
        if (nloc == 0u) { xcd_barrier_complete(bar, b.x, nloc, nx); b.st[0] = nloc; b.st[1] = nx; }
        const unsigned old = xb_add(&bar[XB_XSUB(b.x)], 1u);
        const unsigned gen = old / nloc;
        if (old + 1u == (gen + 1u) * nloc) {
            __builtin_amdgcn_fence(__ATOMIC_RELEASE, "agent");
            asm volatile("s_waitcnt vmcnt(0)" ::: "memory");
            const unsigned og = xb_add(&bar[XB_TOP], 1u);
            const unsigned tg = og / nx;
            if (og + 1u == (tg + 1u) * nx) xb_add(&bar[XB_TOPGEN], 1u);
            else XB_SPIN(xb_ld(&bar[XB_TOPGEN]) == tg, bar);
            __builtin_amdgcn_fence(__ATOMIC_ACQUIRE, "agent");
            xb_add(&bar[XB_XGEN(b.x)], 1u);
            asm volatile("s_waitcnt vmcnt(0)" ::: "memory");
        } else {
            XB_SPIN(xb_ld(&bar[XB_XGEN(b.x)]) == gen, bar);
            __builtin_amdgcn_fence(__ATOMIC_ACQUIRE, "agent");
            asm volatile("s_waitcnt vmcnt(0)" ::: "memory");
        }
    }
    __syncthreads();
}


constexpr int NBATCH = 2, SEQ = 8192, PADL = 112, LP = 8320, M = NBATCH * LP, MA = 17024, D = 1024, DFF = 2816;
constexpr int NCH = 65, NCB = NBATCH * NCH;
constexpr int EVEN_IN = 8240, NIN_PAD = 8448, LPC = 8448;
constexpr float ALPHA = 1.4142135623730951f;
constexpr float LOG2E = 1.4426950408889634f;
constexpr float LAM_INIT = 0.35550906759f;
constexpr float QSCALE = 0.125f * LOG2E;
constexpr int NPH = 26;
constexpr int LDS_BYTES = 132096;

constexpr size_t MiB = 1048576;
constexpr size_t SZ_GU = (size_t)5632 * 1024 * 2, SZ_DN = (size_t)1024 * 2816 * 2;
constexpr size_t WS_GU = 1 * MiB;
constexpr size_t WS_DN = 45 * MiB;
constexpr size_t WS_WIN = 67 * MiB;
constexpr size_t WS_WOUT = WS_WIN + (size_t)NIN_PAD * 1024 * 2;
constexpr size_t WS_WQKV = WS_WOUT + 6 * MiB;
constexpr size_t WS_WO = WS_WQKV + 6 * MiB;
constexpr size_t WS_HS = WS_WO + 2 * MiB;
constexpr size_t WS_HB = WS_HS + 1 * MiB;
constexpr size_t SZ_R1024 = (size_t)MA * 1024 * 2;
constexpr size_t WS_ACT = WS_HB + SZ_R1024;
constexpr size_t WS_K = WS_ACT, WS_VT = WS_ACT + SZ_R1024;
constexpr size_t WS_XT = WS_ACT, WS_BT = WS_ACT + (size_t)MA * 2048 * 2;
constexpr size_t WS_DTF = WS_ACT + (size_t)MA * DFF * 2 + 65536;
constexpr size_t SZ_PERL = (size_t)NCB * 32 * 128 * 4;
constexpr size_t WS_ACUM = WS_DTF + (size_t)MA * 64 * 4;
constexpr size_t WS_SCV = WS_ACUM + SZ_PERL;
constexpr size_t WS_DTV = WS_SCV + SZ_PERL;
constexpr size_t WS_C2 = WS_DTV + SZ_PERL;
constexpr size_t WS_CNAT = WS_C2 + (size_t)32 * LPC * 4;
constexpr size_t WS_END = WS_CNAT + (size_t)MA * 512 * 2;
static_assert(WS_BT + (size_t)NCB * 4 * 128 * 128 * 2 <= WS_DTF, "XT/BT fit in the act region");
constexpr size_t WS_NRM = WS_END;
constexpr size_t WS_END2 = WS_NRM + 4096;
static_assert(WS_END2 <= 256 * MiB, "d_ws map");
constexpr size_t G_YMIX = 0;
constexpr size_t G_XBC = (size_t)MA * 3072 * 2;
constexpr size_t G_ST = G_XBC;
constexpr size_t G_BNAT = G_XBC + (size_t)MA * 3072 * 2;
constexpr size_t G_END = G_BNAT + (size_t)MA * 512 * 2;
constexpr size_t G_DQ = 0, G_DK = SZ_R1024, G_DVT = 2 * SZ_R1024;
static_assert((size_t)NCB * 32 * 64 * 128 * 2 <= (size_t)MA * 3072 * 2, "states fit");
__device__ unsigned char g_scratch[G_END];

__device__ __forceinline__ unsigned f2bf(float f) { unsigned u = __float_as_uint(f); return (u + 0x7fffu + ((u >> 16) & 1u)) >> 16; }
__device__ __forceinline__ float bf2f(unsigned h) { return __uint_as_float(h << 16); }
typedef float f32x2_t __attribute__((ext_vector_type(2))); typedef __bf16 bf16x2_t __attribute__((ext_vector_type(2)));
__device__ __forceinline__ unsigned pk2(float lo, float hi) { f32x2_t v = {lo, hi}; bf16x2_t b = __builtin_convertvector(v, bf16x2_t); return __builtin_bit_cast(unsigned, b); }
__device__ __forceinline__ float bflo(unsigned w) { return __uint_as_float(w << 16); }
__device__ __forceinline__ float bfhi(unsigned w) { return __uint_as_float(w & 0xffff0000u); }
__device__ __forceinline__ float ex2(float x) { return __builtin_amdgcn_exp2f(x); }
__device__ __forceinline__ float siluf(float x) { return x * __builtin_amdgcn_rcpf(1.0f + ex2(-x * LOG2E)); }
__device__ __forceinline__ float wave_sum(float v) {
#pragma unroll
    for (int o = 1; o < 64; o <<= 1) v += __shfl_xor(v, o);
    return v;
}
__device__ __forceinline__ int bidx() { int b = __builtin_amdgcn_workgroup_id_x(); asm volatile("" : "+s"(b)); return b; }
__device__ __forceinline__ int gdim() { int g = (int)__ockl_get_num_groups(0); asm volatile("" : "+s"(g)); return g; }
constexpr float FOX_SKIP_T = 44.0f;
constexpr float ATT_THR = 12.0f;
__device__ __forceinline__ float rowmax4(float m) {
    auto a = __builtin_amdgcn_permlane16_swap(__float_as_uint(m), __float_as_uint(m), false, false);
    m = fmaxf(__uint_as_float(a[0]), __uint_as_float(a[1]));
    auto b = __builtin_amdgcn_permlane32_swap(__float_as_uint(m), __float_as_uint(m), false, false);
    return fmaxf(__uint_as_float(b[0]), __uint_as_float(b[1]));
}
__device__ __forceinline__ bf16x8 mk8(u32x4 v) { return __builtin_bit_cast(bf16x8, v); }
__device__ __forceinline__ f32x4 mfma16(bf16x8 a, bf16x8 b, f32x4 c) { return __builtin_amdgcn_mfma_f32_16x16x32_bf16(a, b, c, 0, 0, 0); }

struct P {
    const float* in[27]; float* out; unsigned char* ws; int ph_lo, ph_hi;
};
__device__ __forceinline__ float* hptr(float* dout, float* hs, int row) {
    const int b = row >= LP ? 1 : 0, p = row - b * LP;
    return p >= 128 ? dout + ((size_t)(b * SEQ + p - 128) << 10) : hs + ((size_t)(b * 128 + p) << 10);
}

struct EpiSwiGLU {
    static constexpr bool PERM = true, AFTER_DRAIN = false;
    bf16* O;
    __device__ __forceinline__ void operator()(const f32x4 (&acc)[2][2][4][2], const pg8::Unit& u, int wr, int wc, int fr, int fq) const {
        const int row0 = u.pm * 256 + wr * 64 + fr, col0 = u.pn * 128 + wc * 32 + 8 * fq;
#pragma unroll
        for (int ai = 0; ai < 2; ++ai)
#pragma unroll
            for (int m = 0; m < 4; ++m) {
                bf16* rowp = O + (size_t)(row0 + ai * 128 + m * 16) * DFF + col0;
                const f32x4 g0 = acc[ai][0][m][0], g1 = acc[ai][0][m][1], u0 = acc[ai][1][m][0], u1 = acc[ai][1][m][1];
                u32x4 w;
                w.x = pk2(siluf(g0[0]) * u0[0], siluf(g0[1]) * u0[1]); w.y = pk2(siluf(g0[2]) * u0[2], siluf(g0[3]) * u0[3]);
                w.z = pk2(siluf(g1[0]) * u1[0], siluf(g1[1]) * u1[1]); w.w = pk2(siluf(g1[2]) * u1[2], siluf(g1[3]) * u1[3]);
                *(u32x4*)rowp = w;
                asm volatile("" ::: "memory");
            }
    }
};
__device__ __forceinline__ u32x4 pack8(const f32x4 a, const f32x4 b, float sc) {
    u32x4 w; w.x = pk2(a[0] * sc, a[1] * sc); w.y = pk2(a[2] * sc, a[3] * sc); w.z = pk2(b[0] * sc, b[1] * sc); w.w = pk2(b[2] * sc, b[3] * sc); return w;
}

struct EpiBranch {
    static constexpr bool PERM = true, AFTER_DRAIN = false;
    bf16* O; float scale;
    __device__ __forceinline__ void operator()(const f32x4 (&acc)[2][2][4][2], const pg8::Unit& u, int wr, int wc, int fr, int fq) const {
        const int row0 = u.pm * 256 + wr * 64 + fr, col0 = u.pn * 256 + wc * 32 + 8 * fq;
#pragma unroll
        for (int ai = 0; ai < 2; ++ai)
#pragma unroll
            for (int m = 0; m < 4; ++m) {
                bf16* rowp = O + (size_t)(row0 + ai * 128 + m * 16) * 1024 + col0;
#pragma unroll
                for (int bj = 0; bj < 2; ++bj) *(u32x4*)(rowp + bj * 128) = pack8(acc[ai][bj][m][0], acc[ai][bj][m][1], scale);
                asm volatile("" ::: "memory");
            }
    }
};
struct EpiSplit {
    static constexpr bool PERM = true, AFTER_DRAIN = false;
    bf16 *A, *B, *C, *Dd, *VT; float* dtf;
    int t_a, t_b, t_c, t_d, t_e; int lda, ldb, ldc, ldd; int ca, cb, cc, cd; int hd_shift, nheads; float qs;
    __device__ __forceinline__ void operator()(const f32x4 (&acc)[2][2][4][2], const pg8::Unit& u, int wr, int wc, int fr, int fq) const {
        const int pn = u.pn, row0 = u.pm * 256 + wr * 64 + fr, cl = wc * 32 + 8 * fq;
        if (pn < t_d) {
            bf16* base; int ld, colt; float sc = 1.f;
            if (pn < t_a) { base = A; ld = lda; colt = ca + pn * 256; }
            else if (pn < t_b) { base = B; ld = ldb; colt = cb + (pn - t_a) * 256; }
            else if (pn < t_c) { base = C; ld = ldc; colt = cc + (pn - t_b) * 256; sc = qs; }
            else { base = Dd; ld = ldd; colt = cd + (pn - t_c) * 256; }
#pragma unroll
            for (int ai = 0; ai < 2; ++ai)
#pragma unroll
                for (int m = 0; m < 4; ++m) {
                    bf16* rowp = base + (size_t)(row0 + ai * 128 + m * 16) * ld + colt + cl;
#pragma unroll
                    for (int bj = 0; bj < 2; ++bj) *(u32x4*)(rowp + bj * 128) = pack8(acc[ai][bj][m][0], acc[ai][bj][m][1], sc);
                    asm volatile("" ::: "memory");
                }
        } else if (pn < t_e) {
            const int hd = 1 << hd_shift;
#pragma unroll
            for (int ai = 0; ai < 2; ++ai)
#pragma unroll
                for (int m = 0; m < 4; ++m) {
                    const int row = row0 + ai * 128 + m * 16, b = row >= LP ? 1 : 0, p = row - b * LP;
#pragma unroll
                    for (int bj = 0; bj < 2; ++bj) {
                        const int c0 = (pn - t_d) * 256 + bj * 128 + cl;
                        bf16* vp = VT + ((size_t)((b * nheads + (c0 >> hd_shift)) * hd + (c0 & (hd - 1)))) * LP + p;
                        const f32x4 v0 = acc[ai][bj][m][0], v1 = acc[ai][bj][m][1];
#pragma unroll
                        for (int i = 0; i < 8; i += 2) {
                            const unsigned ha = f2bf(i < 4 ? v0[i] : v1[i - 4]), hb2 = f2bf(i < 4 ? v0[i + 1] : v1[i - 3]);
                            const bool odd = (fr & 1) != 0;
                            const unsigned recv = (unsigned)__builtin_amdgcn_update_dpp(0, (int)(odd ? ha : hb2), 0xB1, 0xF, 0xF, true);
                            unsigned* dst = (unsigned*)(odd ? vp + (size_t)(i + 1) * LP - 1 : vp + (size_t)i * LP);
                            *dst = odd ? (recv | (hb2 << 16)) : (ha | (recv << 16));
                        }
                    }
                }
        } else {
            if (wc < 2) {
#pragma unroll
                for (int ai = 0; ai < 2; ++ai)
#pragma unroll
                    for (int m = 0; m < 4; ++m) {
                        float* dp = dtf + (size_t)(row0 + ai * 128 + m * 16) * 64 + cl;
                        *(f32x4*)dp = acc[ai][0][m][0]; *(f32x4*)(dp + 4) = acc[ai][0][m][1];
                    }
            }
        }
    }
};

struct TItem { const float* src; bf16* dst; int K, N, n0, k0, drow0, nvalid; };
__device__ __forceinline__ void t_decode(const P& a, unsigned char* ws, int it, TItem& d) {
    constexpr int I_FF = 16 * 88, I_IN = 16 * 258, I_OUT = 48 * 32, I_QKV = 16 * 96;
    int r = it; d.nvalid = 32;
    if (r < 12 * I_FF) {
        const int f = r / (3 * I_FF); r -= f * 3 * I_FF; const int which = r / I_FF; r -= which * I_FF;
        const int layer = f >> 1, ffn = f & 1;
        d.src = a.in[4 + ffn * 3 + which] + (size_t)layer * 1024 * DFF;
        if (which < 2) { const int kb = r / 88, nb = r % 88, c = 32 * nb; d.K = 1024; d.N = DFF; d.n0 = c; d.k0 = 64 * kb; d.dst = (bf16*)(ws + WS_GU + f * SZ_GU); d.drow0 = (c >> 7) * 256 + (c & 127) + which * 128; }
        else { const int kb = r / 32, nb = r % 32; d.K = DFF; d.N = 1024; d.n0 = 32 * nb; d.k0 = 64 * kb; d.dst = (bf16*)(ws + WS_DN + f * SZ_DN); d.drow0 = 32 * nb; }
        return;
    }
    r -= 12 * I_FF;
    if (r < I_IN) { const int kb = r / 258, nb = r % 258, n0 = 32 * nb; int dr;
        if (n0 < 5120) dr = n0; else if (n0 == 5120) dr = 8192; else if (n0 < 8224) dr = n0 - 32; else { dr = 8224; d.nvalid = 16; }
        d.src = a.in[10]; d.K = 1024; d.N = EVEN_IN; d.n0 = n0; d.k0 = 64 * kb; d.dst = (bf16*)(ws + WS_WIN); d.drow0 = dr; return; }
    r -= I_IN;
    if (r < I_OUT) { const int kb = r / 32, nb = r % 32; d.src = a.in[18]; d.K = 3072; d.N = 1024; d.n0 = 32 * nb; d.k0 = 64 * kb; d.dst = (bf16*)(ws + WS_WOUT); d.drow0 = 32 * nb; return; }
    r -= I_OUT;
    if (r < I_QKV) { const int kb = r / 96, nb = r % 96; d.src = a.in[19]; d.K = 1024; d.N = 3072; d.n0 = 32 * nb; d.k0 = 64 * kb; d.dst = (bf16*)(ws + WS_WQKV); d.drow0 = 32 * nb; return; }
    r -= I_QKV;
    { const int kb = r / 32, nb = r % 32; d.src = a.in[25]; d.K = 1024; d.N = 1024; d.n0 = 32 * nb; d.k0 = 64 * kb; d.dst = (bf16*)(ws + WS_WO); d.drow0 = 32 * nb; }
}
__device__ __forceinline__ void t_load(const TItem& d, int lane, float (&v)[32]) {
    const int col = d.n0 + (lane & 31); const bool ok = col < d.N; const float* p = d.src + (size_t)(d.k0 + (lane >> 5)) * d.N + (ok ? col : 0);
#pragma unroll
    for (int i = 0; i < 32; ++i) { const float x = p[(size_t)(2 * i) * d.N]; v[i] = ok ? x : 0.f; }
}
__device__ __forceinline__ void t_store(const TItem& d, int lane, LAS float* scr, const float (&v)[32]) {
#pragma unroll
    for (int i = 0; i < 32; ++i) scr[(2 * i + (lane >> 5)) * 33 + (lane & 31)] = v[i];
    asm volatile("s_waitcnt lgkmcnt(0)" ::: "memory");
    const int c = lane & 7;
#pragma unroll
    for (int j = 0; j < 4; ++j) { const int n = (lane >> 3) + 8 * j; const LAS float* s = scr + (8 * c) * 33 + n;
        u32x4 o; o.x = pk2(s[0 * 33], s[1 * 33]); o.y = pk2(s[2 * 33], s[3 * 33]); o.z = pk2(s[4 * 33], s[5 * 33]); o.w = pk2(s[6 * 33], s[7 * 33]);
        if (n < d.nvalid) *(u32x4*)(d.dst + (size_t)(d.drow0 + n) * d.K + d.k0 + 8 * c) = o; }
    asm volatile("s_waitcnt lgkmcnt(0)" ::: "memory");
}
__device__ __forceinline__ void prologue_phase(const P& a, LAS unsigned char* lds, int wave, int lane) {
    LAS float* scr = (LAS float*)(lds + wave * 16384);
    const int gw = bidx() * 8 + wave, NGW = gdim() * 8;
    unsigned char* ws = a.ws;
    constexpr int NIT = 12 * (16 * 88) + 16 * 258 + 48 * 32 + 16 * 96 + 16 * 32;
    {
        TItem da, db; float va[32], vb[32]; int it = gw;
        if (it < NIT) { t_decode(a, ws, it, da); t_load(da, lane, va); }
        while (it < NIT) {
            if (it + NGW < NIT) { t_decode(a, ws, it + NGW, db); t_load(db, lane, vb); }
            t_store(da, lane, scr, va); it += NGW; if (it >= NIT) break;
            if (it + NGW < NIT) { t_decode(a, ws, it + NGW, da); t_load(da, lane, va); }
            t_store(db, lane, scr, vb); it += NGW;
        }
    }
    { u32x4* z = (u32x4*)(ws + WS_WIN + (size_t)EVEN_IN * 1024 * 2); const int n16 = (NIN_PAD - EVEN_IN) * 1024 * 2 / 16;
      for (int i = gw * 64 + lane; i < n16; i += NGW * 64) z[i] = (u32x4){0u, 0u, 0u, 0u}; }
    float* hs = (float*)(ws + WS_HS); bf16* hb = (bf16*)(ws + WS_HB);
    for (int row = gw; row < M; row += NGW) {
        const int b = row >= LP ? 1 : 0, p = row - b * LP;
        float* hp = hptr(a.out, hs, row); unsigned long long* o8 = (unsigned long long*)(hb + (size_t)row * 1024) + lane;
        if (p < PADL) {
#pragma unroll
            for (int j = 0; j < 4; ++j) { ((f32x4*)hp)[lane + 64 * j] = (f32x4){0.f, 0.f, 0.f, 0.f}; o8[64 * j] = 0ull; }
        } else {
            const float* src = p < 128 ? a.in[1] + (size_t)(p - PADL) * 1024 : a.in[0] + ((size_t)(b * SEQ + p - 128) << 10);
#pragma unroll
            for (int j = 0; j < 4; ++j) { const f32x4 v = ((const f32x4*)src)[lane + 64 * j]; ((f32x4*)hp)[lane + 64 * j] = v * ALPHA;
                o8[64 * j] = (unsigned long long)pk2(v[0], v[1]) | ((unsigned long long)pk2(v[2], v[3]) << 32); }
        }
    }
}

__device__ __forceinline__ void ln_phase(const P& a, const float* gain, const float* bias, bool final_, int wave, int lane, bool dry) {
    const int gw = bidx() * 8 + wave, NGW = gdim() * 8;
    float* hs = (float*)(a.ws + WS_HS); bf16* hb = (bf16*)(a.ws + WS_HB);
    f32x4 g[4], bb[4];
#pragma unroll
    for (int j = 0; j < 4; ++j) { g[j] = ((const f32x4*)gain)[lane + 64 * j]; bb[j] = ((const f32x4*)bias)[lane + 64 * j]; }
    (void)dry;
    for (int r0 = gw; r0 < M; r0 += 2 * NGW) {
        f32x4 v[2][4]; float* hp[2]; bool ok[2];
#pragma unroll
        for (int t = 0; t < 2; ++t) {
            const int row = r0 + t * NGW; const bool in = row < M; const int rr = in ? row : r0;
            const int b = rr >= LP ? 1 : 0, p = rr - b * LP;
            hp[t] = hptr(a.out, hs, rr); ok[t] = in && p >= PADL && !(final_ && p < 128);
            if (in && p < PADL && !final_) {
                unsigned long long* o8 = (unsigned long long*)(hb + (size_t)rr * 1024) + lane;
#pragma unroll
                for (int j = 0; j < 4; ++j) { ((f32x4*)hp[t])[lane + 64 * j] = (f32x4){0.f, 0.f, 0.f, 0.f}; o8[64 * j] = 0ull; }
            }
            { const unsigned long long* m8 = (const unsigned long long*)(hb + (size_t)rr * 1024) + lane;
#pragma unroll
              for (int j = 0; j < 4; ++j) { const unsigned long long mw = m8[64 * j]; const unsigned lo = (unsigned)mw, hi = (unsigned)(mw >> 32);
                  v[t][j] = ((const f32x4*)hp[t])[lane + 64 * j] + (f32x4){bflo(lo), bfhi(lo), bflo(hi), bfhi(hi)}; } }
        }
#pragma unroll
        for (int t = 0; t < 2; ++t) {
            float s = 0.f;
#pragma unroll
            for (int j = 0; j < 4; ++j) s += (v[t][j][0] + v[t][j][1]) + (v[t][j][2] + v[t][j][3]);
            const float mean = wave_sum(s) * (1.f / 1024.f); float s2 = 0.f;
#pragma unroll
            for (int j = 0; j < 4; ++j) { v[t][j] = v[t][j] - mean; s2 += (v[t][j][0] * v[t][j][0] + v[t][j][1] * v[t][j][1]) + (v[t][j][2] * v[t][j][2] + v[t][j][3] * v[t][j][3]); }
            const float rstd = 1.0f / sqrtf(wave_sum(s2) * (1.f / 1024.f) + 1e-5f);
            if (ok[t]) {
                const int row = r0 + t * NGW; unsigned long long* o8 = (unsigned long long*)(hb + (size_t)row * 1024) + lane;
#pragma unroll
                for (int j = 0; j < 4; ++j) { const f32x4 o = v[t][j] * rstd * g[j] + bb[j]; ((f32x4*)hp[t])[lane + 64 * j] = final_ ? o : o * ALPHA;
                    if (!final_) o8[64 * j] = (unsigned long long)pk2(o[0], o[1]) | ((unsigned long long)pk2(o[2], o[3]) << 32); }
            }
        }
    }
}

__device__ __forceinline__ float logsig(float x) { return fminf(x, 0.f) - log1pf(expf(-fabsf(x))); }
__device__ __forceinline__ void c2_phase(const P& a, LAS unsigned char* lds, int tid, int wave, int lane) {
    LAS float* wtot = (LAS float*)lds;
    for (int blk = bidx(); blk < 256; blk += gdim()) {
        const int bh = blk & 31, part = blk >> 5, b = bh >> 4, h = bh & 15;
        const bf16* Yq = (const bf16*)(g_scratch + G_YMIX); const bf16* Kk = (const bf16*)(a.ws + WS_K);
        float mq = 0.f, mkk = 0.f;
        for (int p = part * 1040 + tid; p < (part + 1) * 1040 && p < LP; p += 512) {
            const size_t row = (size_t)b * LP + p;
            const u32x4* qp = (const u32x4*)(Yq + row * 3072 + 2048 + h * 64); const u32x4* kp = (const u32x4*)(Kk + row * 1024 + h * 64);
            float sq = 0.f, sk = 0.f;
#pragma unroll
            for (int i = 0; i < 8; ++i) { const u32x4 v = qp[i], w = kp[i];
                sq += (bflo(v.x) * bflo(v.x) + bfhi(v.x) * bfhi(v.x)) + (bflo(v.y) * bflo(v.y) + bfhi(v.y) * bfhi(v.y)) + (bflo(v.z) * bflo(v.z) + bfhi(v.z) * bfhi(v.z)) + (bflo(v.w) * bflo(v.w) + bfhi(v.w) * bfhi(v.w));
                sk += (bflo(w.x) * bflo(w.x) + bfhi(w.x) * bfhi(w.x)) + (bflo(w.y) * bflo(w.y) + bfhi(w.y) * bfhi(w.y)) + (bflo(w.z) * bflo(w.z) + bfhi(w.z) * bfhi(w.z)) + (bflo(w.w) * bflo(w.w) + bfhi(w.w) * bfhi(w.w)); }
            mq = fmaxf(mq, sq); mkk = fmaxf(mkk, sk);
        }
#pragma unroll
        for (int o = 1; o < 64; o <<= 1) { mq = fmaxf(mq, __shfl_xor(mq, o)); mkk = fmaxf(mkk, __shfl_xor(mkk, o)); }
        __syncthreads();
        if (lane == 0) { wtot[16 + wave] = mq; wtot[32 + wave] = mkk; }
        __syncthreads();
        if (tid == 0) { float x = 0.f, y = 0.f; for (int w = 0; w < 8; ++w) { x = fmaxf(x, wtot[16 + w]); y = fmaxf(y, wtot[32 + w]); }
            float* nr = (float*)(a.ws + WS_NRM) + (bh * 8 + part) * 2; nr[0] = sqrtf(x) * 1.0001f; nr[1] = sqrtf(y) * 1.0001f; }
    }
    __syncthreads();
    if (bidx() >= 32) return;
    const int b = bidx() >> 4, h = bidx() & 15; const float fb = a.in[17][h];
    const float* dtf = (const float*)(a.ws + WS_DTF) + (size_t)b * LP * 64 + 32 + h; float* c2 = (float*)(a.ws + WS_C2) + (size_t)bidx() * LPC;
    const int p0 = tid * 17; float s = 0.f;
    for (int i = 0; i < 17; ++i) { const int p = p0 + i; if (p >= PADL && p < LP) s += logsig(dtf[(size_t)p * 64] + fb); }
    float v = s;
#pragma unroll
    for (int o = 1; o < 64; o <<= 1) { const float t = __shfl_up(v, o); if (lane >= o) v += t; }
    if (lane == 63) wtot[wave] = v;
    __syncthreads();
    float run = v - s; for (int w = 0; w < wave; ++w) run += wtot[w];
    for (int i = 0; i < 17; ++i) { const int p = p0 + i; if (p < LP) { if (p >= PADL) run += logsig(dtf[(size_t)p * 64] + fb); c2[p] = run * LOG2E; } }
}

constexpr int FOX_BUF = 8192 + 8192 + 256;
__device__ __forceinline__ void fox_unit(const P& a, LAS unsigned char* lds, int b, int h, int j, int tid, int wave, int lane, bool dry) {
    const int q0 = 256 * j + 32 * wave;
    const bool active = (q0 < LP) && (q0 + 31 >= PADL);
    const int li = lane & 15, gq = lane >> 4, xr = (li >> 1) & 7;
    bf16* Y = (bf16*)(g_scratch + G_YMIX); const bf16* Kp = (const bf16*)(a.ws + WS_K); const bf16* Vt = (const bf16*)(a.ws + WS_VT);
    const size_t rb = (size_t)b * LP;
    const int srow = tid >> 3, sch = tid & 7;
    const bf16* kg = Kp + (rb + srow) * 1024 + h * 64 + 8 * sch;
    const bf16* vg = Vt + ((size_t)(b * 16 + h) * 64 + srow) * LP + 8 * sch;
    const float* cg = (const float*)(a.ws + WS_C2) + (size_t)(b * 16 + h) * LPC + 4 * (tid & 15);
    const int sof = srow * 128 + ((sch ^ ((srow >> 1) & 7)) << 4);
    bf16x8 bq[2][2];
    if (active) {
#pragma unroll
        for (int qt = 0; qt < 2; ++qt)
#pragma unroll
            for (int ks = 0; ks < 2; ++ks) bq[qt][ks] = *(const bf16x8*)(Y + (rb + q0 + 16 * qt + li) * 3072 + 2048 + h * 64 + 32 * ks + 8 * gq);
    }
    f32x4 O[5][2];
#pragma unroll
    for (int dt = 0; dt < 5; ++dt) { O[dt][0] = (f32x4){0.f, 0.f, 0.f, 0.f}; O[dt][1] = (f32x4){0.f, 0.f, 0.f, 0.f}; }
    float mref[2] = {-1e30f, -1e30f};
    const bf16x8 ones8 = mk8((u32x4){0x3f803f80u, 0x3f803f80u, 0x3f803f80u, 0x3f803f80u});
    int kt_last = 4 * j + 3; kt_last = kt_last > 129 ? 129 : kt_last;
    int kt_first;
    {
        const float* nr = (const float*)(a.ws + WS_NRM) + (b * 16 + h) * 16; float mq = 0.f, mkk = 0.f;
#pragma unroll
        for (int i = 0; i < 8; ++i) { mq = fmaxf(mq, nr[2 * i]); mkk = fmaxf(mkk, nr[2 * i + 1]); }
        const float lim = -(FOX_SKIP_T + 2.0f * mq * mkk);
        const float* c2p = (const float*)(a.ws + WS_C2) + (size_t)(b * 16 + h) * LPC;
        const int q0v = 256 * j > PADL ? 256 * j : PADL; const float cq = c2p[q0v];
        int first = kt_last;
        for (int base = 0; base < 192; base += 64) {
            const int t = base + lane; const int idx = 64 * t + 63 < LP ? 64 * t + 63 : LP - 1;
            const bool okk = (t >= 1) && (t <= kt_last) && (cq - c2p[idx] >= lim);
            const unsigned long long m = __ballot(okk);
            if (m) { first = base + (int)__ffsll((long long)m) - 1; break; }
        }
        kt_first = __builtin_amdgcn_readfirstlane(first);
    }
    u32x4 rk0, rk1, rk2, rv0, rv1, rv2; f32x4 rc0, rc1, rc2;
    const float* cgl = (const float*)(a.ws + WS_C2) + (size_t)(b * 16 + h) * LPC + 4 * (tid & 15);
#define FOX_LOAD(T, RK, RV, RC) do { const int t_ = (T) < kt_last ? (T) : kt_last; RK = *(const u32x4*)(kg + (size_t)(t_ * 64) * 1024); RV = *(const u32x4*)(vg + t_ * 64); RC = *(const f32x4*)(cgl + t_ * 64); } while (0)
#define FOX_WRITE(BUF, RK, RV, RC) do { *(LAS u32x4*)((BUF) + sof) = RK; *(LAS u32x4*)((BUF) + 8192 + sof) = (srow & 1) ? (u32x4){RV.z, RV.w, RV.x, RV.y} : RV; *(LAS f32x4*)((BUF) + 16384 + (tid & 15) * 16) = -(RC); } while (0)
#define FOX_COMPUTE(kt, B) do { \
        const int key0 = kt * 64; \
        if (active && key0 <= q0 + 31) { \
            f32x4 S[4][2]; __builtin_amdgcn_s_setprio(1); \
_Pragma("unroll") \
            for (int k2 = 0; k2 < 4; ++k2) { \
                const LAS unsigned char* kr = B + (16 * k2 + li) * 128; \
                const bf16x8 a0 = *(const LAS bf16x8*)(kr + (((gq) ^ xr) << 4)), a1 = *(const LAS bf16x8*)(kr + (((4 + gq) ^ xr) << 4)); \
                const f32x4 cbn = *(const LAS f32x4*)(B + 16384 + (16 * k2 + 4 * gq) * 4); \
_Pragma("unroll") \
                for (int qt = 0; qt < 2; ++qt) { f32x4 t = mfma16(a0, bq[qt][0], cbn); S[k2][qt] = mfma16(a1, bq[qt][1], t); } \
            } \
            if (kt == 1 || key0 + 63 > q0) { \
_Pragma("unroll") \
                for (int k2 = 0; k2 < 4; ++k2) \
_Pragma("unroll") \
                    for (int qt = 0; qt < 2; ++qt) \
_Pragma("unroll") \
                        for (int r = 0; r < 4; ++r) { const int key = key0 + 16 * k2 + 4 * gq + r, q = q0 + 16 * qt + li; if (key < PADL || key > q) S[k2][qt][r] = -1e30f; } \
            } \
            __builtin_amdgcn_s_setprio(0); float mxq[2]; \
_Pragma("unroll") \
            for (int qt = 0; qt < 2; ++qt) { \
                float mx = fmaxf(fmaxf(S[0][qt][0], S[0][qt][1]), fmaxf(S[0][qt][2], S[0][qt][3])); \
_Pragma("unroll") \
                for (int k2 = 1; k2 < 4; ++k2) mx = fmaxf(mx, fmaxf(fmaxf(S[k2][qt][0], S[k2][qt][1]), fmaxf(S[k2][qt][2], S[k2][qt][3]))); \
                mxq[qt] = rowmax4(mx); \
            } \
            if (__any((mxq[0] > mref[0] + ATT_THR) || (mxq[1] > mref[1] + ATT_THR))) { \
_Pragma("unroll") \
                for (int qt = 0; qt < 2; ++qt) { \
                    const float mn = (mxq[qt] > mref[qt] + ATT_THR) ? mxq[qt] : mref[qt], al = ex2(mref[qt] - mn); mref[qt] = mn; \
_Pragma("unroll") \
                    for (int dt = 0; dt < 5; ++dt) O[dt][qt] = O[dt][qt] * al; \
                } \
            } \
            u32x4 bp[2][2]; \
_Pragma("unroll") \
            for (int qt = 0; qt < 2; ++qt) { \
                const float mn = mref[qt]; \
_Pragma("unroll") \
                for (int k2 = 0; k2 < 4; ++k2) { \
                    const unsigned w0 = pk2(ex2(S[k2][qt][0] - mn), ex2(S[k2][qt][1] - mn)), w1 = pk2(ex2(S[k2][qt][2] - mn), ex2(S[k2][qt][3] - mn)); \
                    if (k2 & 1) { bp[k2 >> 1][qt].z = w0; bp[k2 >> 1][qt].w = w1; } else { bp[k2 >> 1][qt].x = w0; bp[k2 >> 1][qt].y = w1; } } \
            } \
_Pragma("unroll") \
            for (int dt = 0; dt < 4; ++dt) { \
                const LAS unsigned char* vr = B + 8192 + (16 * dt + li) * 128 + 8 * ((gq ^ li) & 1); \
_Pragma("unroll") \
                for (int kh = 0; kh < 2; ++kh) { \
                    const int c = 4 * kh + (gq >> 1); \
                    const u32x2 x0 = *(const LAS u32x2*)(vr + ((c ^ xr) << 4)), x1 = *(const LAS u32x2*)(vr + (((c + 2) ^ xr) << 4)); \
                    const bf16x8 av = mk8((u32x4){x0.x, x0.y, x1.x, x1.y}); \
                    O[dt][0] = mfma16(av, mk8(bp[kh][0]), O[dt][0]); O[dt][1] = mfma16(av, mk8(bp[kh][1]), O[dt][1]); \
                } \
            } \
_Pragma("unroll") \
            for (int kh = 0; kh < 2; ++kh) { O[4][0] = mfma16(ones8, mk8(bp[kh][0]), O[4][0]); O[4][1] = mfma16(ones8, mk8(bp[kh][1]), O[4][1]); } \
        } \
} while (0)
#define FOX_STEP(RK, RV, RC) do { LAS unsigned char* B_ = lds + cur * FOX_BUF; LAS unsigned char* Bn_ = lds + (cur ^ 1) * FOX_BUF; \
        FOX_WRITE(Bn_, RK, RV, RC); FOX_LOAD(kt + 4, RK, RV, RC); FOX_COMPUTE(kt, B_); __syncthreads(); cur ^= 1; } while (0)
    FOX_LOAD(kt_first, rk0, rv0, rc0); FOX_LOAD(kt_first + 1, rk1, rv1, rc1); FOX_LOAD(kt_first + 2, rk2, rv2, rc2);
    FOX_WRITE(lds, rk0, rv0, rc0);
    __syncthreads();
    FOX_LOAD(kt_first + 3, rk0, rv0, rc0);
    { int kt = kt_first, cur = 0;
      for (;;) {
        FOX_STEP(rk1, rv1, rc1); if (++kt > kt_last) break;
        FOX_STEP(rk2, rv2, rc2); if (++kt > kt_last) break;
        FOX_STEP(rk0, rv0, rc0); if (++kt > kt_last) break;
      } }
#undef FOX_STEP
#undef FOX_COMPUTE
#undef FOX_LOAD
#undef FOX_WRITE
    if (active) {
#pragma unroll
        for (int qt = 0; qt < 2; ++qt) {
            const float inv = 1.0f / O[4][qt][0];
            const int q = q0 + 16 * qt + li;
            if (q >= PADL) {
                bf16* op = dry ? (bf16*)(g_scratch + G_BNAT) + ((rb + q) & 8191) * 1024 + h * 64 + 4 * gq : Y + (rb + q) * 3072 + 2048 + h * 64 + 4 * gq;
#pragma unroll
                for (int dt = 0; dt < 4; ++dt) { u32x2 w; w.x = pk2(O[dt][qt][0] * inv, O[dt][qt][1] * inv); w.y = pk2(O[dt][qt][2] * inv, O[dt][qt][3] * inv); *(u32x2*)(op + 16 * dt) = w; }
            }
        }
    }
}
__device__ __forceinline__ void fox_phase(const P& a, LAS unsigned char* lds, int tid, int wave, int lane, bool dry) {
    constexpr int NU = 33 * 32;
    unsigned* counter = (unsigned*)a.ws + 8192;
    volatile LAS unsigned* ctrl = (volatile LAS unsigned*)(lds + 131072);
    for (;;) {
        if (tid == 0) ctrl[32] = atomicAdd(counter, 1u);
        __syncthreads();
        const int u = (int)ctrl[32];
        __syncthreads();
        if (u >= NU) break;
        const int j = 32 - u / 32, bh = u % 32;
        fox_unit(a, lds, bh >> 4, bh & 15, j, tid, wave, lane, dry);
    }
}

constexpr int DIF_BUF = 16384 + 16384;
__device__ __forceinline__ void diff_unit(const P& a, LAS unsigned char* lds, int b, int h, int j, int tid, int wave, int lane, float lam, bool dry) {
    const LAS float* tab = (const LAS float*)(lds + 2 * DIF_BUF);
    const int q0 = 128 * j + 16 * wave;
    const bool active = q0 + 15 >= PADL;
    const int li = lane & 15, gq = lane >> 4, xr = (li >> 1) & 7;
    bf16* Q = (bf16*)(g_scratch + G_DQ); const bf16* Kp = (const bf16*)(g_scratch + G_DK); const bf16* Vt = (const bf16*)(g_scratch + G_DVT);
    const size_t rb = (size_t)b * LP; const int q = q0 + li;
    const int srow = tid >> 3, sch = tid & 7;
    const bf16* kg = Kp + (rb + srow) * 1024 + h * 128 + 8 * sch;
    const bf16* vg = Vt + ((size_t)(b * 8 + h) * 128 + srow) * LP + 8 * sch;
    const int kof0 = srow * 256 + ((sch ^ (srow & 15)) << 4), kof1 = srow * 256 + (((sch + 8) ^ (srow & 15)) << 4);
    const int vof0 = 16384 + srow * 128 + ((sch ^ ((srow >> 1) & 7)) << 4), vof1 = vof0 + 64 * 128;
    bf16x8 bq[2][2];
    if (active) {
#pragma unroll
        for (int cp = 0; cp < 2; ++cp)
#pragma unroll
            for (int ks = 0; ks < 2; ++ks) bq[cp][ks] = *(const bf16x8*)(Q + (rb + q) * 1024 + h * 128 + cp * 64 + 32 * ks + 8 * gq);
    }
    f32x4 O[2][9];
#pragma unroll
    for (int dt = 0; dt < 9; ++dt) { O[0][dt] = (f32x4){0.f, 0.f, 0.f, 0.f}; O[1][dt] = (f32x4){0.f, 0.f, 0.f, 0.f}; }
    float mref[2] = {-1e30f, -1e30f};
    const bf16x8 ones8 = mk8((u32x4){0x3f803f80u, 0x3f803f80u, 0x3f803f80u, 0x3f803f80u});
    const int kt_first = 1, kt_last = 2 * j + 1;
    u32x4 ak0, ak1, av0, av1, bk0, bk1, bv0, bv1;
#define DIF_LOAD(T, K0, K1, V0, V1) do { const int t_ = (T) < kt_last ? (T) : kt_last; const size_t ko_ = (size_t)(t_ * 64) * 1024; K0 = *(const u32x4*)(kg + ko_); K1 = *(const u32x4*)(kg + ko_ + 64); \
        V0 = *(const u32x4*)(vg + t_ * 64); V1 = *(const u32x4*)(vg + (size_t)64 * LP + t_ * 64); } while (0)
#define DIF_WRITE(BUF, K0, K1, V0, V1) do { *(LAS u32x4*)((BUF) + kof0) = K0; *(LAS u32x4*)((BUF) + kof1) = K1; *(LAS u32x4*)((BUF) + vof0) = (srow & 1) ? (u32x4){V0.z, V0.w, V0.x, V0.y} : V0; *(LAS u32x4*)((BUF) + vof1) = (srow & 1) ? (u32x4){V1.z, V1.w, V1.x, V1.y} : V1; } while (0)
#define DIF_COMPUTE(kt, B) do { \
        const int key0 = kt * 64; \
        if (active && key0 <= q0 + 15) { \
            f32x4 S[2][4]; __builtin_amdgcn_s_setprio(1); \
_Pragma("unroll") \
            for (int k2 = 0; k2 < 4; ++k2) { \
                const LAS unsigned char* kr = B + (16 * k2 + li) * 256; \
_Pragma("unroll") \
                for (int cp = 0; cp < 2; ++cp) { \
                    const bf16x8 a0 = *(const LAS bf16x8*)(kr + (((8 * cp + gq) ^ li) << 4)), a1 = *(const LAS bf16x8*)(kr + (((8 * cp + 4 + gq) ^ li) << 4)); \
                    f32x4 t = mfma16(a0, bq[cp][0], (f32x4){0.f, 0.f, 0.f, 0.f}); S[cp][k2] = mfma16(a1, bq[cp][1], t); \
                } \
            } \
            if (kt == 1 || key0 + 63 + 113 > q0) { \
_Pragma("unroll") \
                for (int k2 = 0; k2 < 4; ++k2) \
_Pragma("unroll") \
                    for (int r = 0; r < 4; ++r) { \
                        const int key = key0 + 16 * k2 + 4 * gq + r, n = q - key; \
                        if (n < 0 || key < PADL) { S[0][k2][r] = -1e30f; S[1][k2][r] = -1e30f; } \
                        else { const float bv = tab[n < 127 ? n : 127]; S[0][k2][r] += bv; S[1][k2][r] += bv; } \
                    } \
            } \
            __builtin_amdgcn_s_setprio(0); float mxq[2]; \
_Pragma("unroll") \
            for (int cp = 0; cp < 2; ++cp) { \
                float mx = fmaxf(fmaxf(S[cp][0][0], S[cp][0][1]), fmaxf(S[cp][0][2], S[cp][0][3])); \
_Pragma("unroll") \
                for (int k2 = 1; k2 < 4; ++k2) mx = fmaxf(mx, fmaxf(fmaxf(S[cp][k2][0], S[cp][k2][1]), fmaxf(S[cp][k2][2], S[cp][k2][3]))); \
                mxq[cp] = rowmax4(mx); \
            } \
            if (__any((mxq[0] > mref[0] + ATT_THR) || (mxq[1] > mref[1] + ATT_THR))) { \
_Pragma("unroll") \
                for (int cp = 0; cp < 2; ++cp) { \
                    const float mn = (mxq[cp] > mref[cp] + ATT_THR) ? mxq[cp] : mref[cp], al = ex2(mref[cp] - mn); mref[cp] = mn; \
_Pragma("unroll") \
                    for (int dt = 0; dt < 9; ++dt) O[cp][dt] = O[cp][dt] * al; \
                } \
            } \
            u32x4 bp[2][2]; \
_Pragma("unroll") \
            for (int cp = 0; cp < 2; ++cp) { \
                const float mn = mref[cp]; \
_Pragma("unroll") \
                for (int k2 = 0; k2 < 4; ++k2) { \
                    const unsigned w0 = pk2(ex2(S[cp][k2][0] - mn), ex2(S[cp][k2][1] - mn)), w1 = pk2(ex2(S[cp][k2][2] - mn), ex2(S[cp][k2][3] - mn)); \
                    if (k2 & 1) { bp[cp][k2 >> 1].z = w0; bp[cp][k2 >> 1].w = w1; } else { bp[cp][k2 >> 1].x = w0; bp[cp][k2 >> 1].y = w1; } } \
            } \
_Pragma("unroll") \
            for (int dt = 0; dt < 8; ++dt) { \
                const LAS unsigned char* vr = B + 16384 + (16 * dt + li) * 128 + 8 * ((gq ^ li) & 1); \
_Pragma("unroll") \
                for (int kh = 0; kh < 2; ++kh) { \
                    const int c = 4 * kh + (gq >> 1); \
                    const u32x2 x0 = *(const LAS u32x2*)(vr + ((c ^ xr) << 4)), x1 = *(const LAS u32x2*)(vr + (((c + 2) ^ xr) << 4)); \
                    const bf16x8 av = mk8((u32x4){x0.x, x0.y, x1.x, x1.y}); \
                    O[0][dt] = mfma16(av, mk8(bp[0][kh]), O[0][dt]); O[1][dt] = mfma16(av, mk8(bp[1][kh]), O[1][dt]); \
                } \
            } \
_Pragma("unroll") \
            for (int kh = 0; kh < 2; ++kh) { O[0][8] = mfma16(ones8, mk8(bp[0][kh]), O[0][8]); O[1][8] = mfma16(ones8, mk8(bp[1][kh]), O[1][8]); } \
        } \
} while (0)
#define DIF_STEP(K0, K1, V0, V1) do { LAS unsigned char* B_ = lds + cur * DIF_BUF; LAS unsigned char* Bn_ = lds + (cur ^ 1) * DIF_BUF; \
        DIF_WRITE(Bn_, K0, K1, V0, V1); DIF_LOAD(kt + 3, K0, K1, V0, V1); DIF_COMPUTE(kt, B_); __syncthreads(); cur ^= 1; } while (0)
    DIF_LOAD(kt_first, ak0, ak1, av0, av1); DIF_LOAD(kt_first + 1, bk0, bk1, bv0, bv1);
    DIF_WRITE(lds, ak0, ak1, av0, av1);
    __syncthreads();
    DIF_LOAD(kt_first + 2, ak0, ak1, av0, av1);
    { int kt = kt_first, cur = 0;
      for (;;) {
        DIF_STEP(bk0, bk1, bv0, bv1); if (++kt > kt_last) break;
        DIF_STEP(ak0, ak1, av0, av1); if (++kt > kt_last) break;
      } }
#undef DIF_STEP
#undef DIF_COMPUTE
#undef DIF_LOAD
#undef DIF_WRITE
    if (active) {
        const float i0 = 1.0f / O[0][8][0], i1 = lam / O[1][8][0]; float ss = 0.f;
#pragma unroll
        for (int dt = 0; dt < 8; ++dt) { O[0][dt] = O[0][dt] * i0 - O[1][dt] * i1; ss += (O[0][dt][0] * O[0][dt][0] + O[0][dt][1] * O[0][dt][1]) + (O[0][dt][2] * O[0][dt][2] + O[0][dt][3] * O[0][dt][3]); }
        ss += __shfl_xor(ss, 16); ss += __shfl_xor(ss, 32);
        const float rstd = (1.0f - LAM_INIT) / sqrtf(ss * (1.f / 128.f) + 1e-5f);
        if (q >= PADL) {
            bf16* op = (dry ? (bf16*)(a.ws + WS_ACT) : Q) + (rb + q) * 1024 + h * 128 + 4 * gq; const float* sw = a.in[24] + 4 * gq;
#pragma unroll
            for (int dt = 0; dt < 8; ++dt) { const f32x4 w4 = *(const f32x4*)(sw + 16 * dt); u32x2 w;
                w.x = pk2(O[0][dt][0] * rstd * w4[0], O[0][dt][1] * rstd * w4[1]); w.y = pk2(O[0][dt][2] * rstd * w4[2], O[0][dt][3] * rstd * w4[3]); *(u32x2*)(op + 16 * dt) = w; }
        }
    }
}
__device__ __forceinline__ void diff_phase(const P& a, LAS unsigned char* lds, int tid, int wave, int lane, bool dry) {
    LAS float* tab = (LAS float*)(lds + 2 * DIF_BUF);
    const float s1 = wave_sum(a.in[20][lane] * a.in[21][lane]), s2 = wave_sum(a.in[22][lane] * a.in[23][lane]);
    const float lam = expf(s1) - expf(s2) + LAM_INIT;
    const int G = gdim(), c = bidx(); constexpr int NU = 65 * 16;
    for (int r = 0;; ++r) {
        const int u = (r & 1) ? r * G + (G - 1 - c) : r * G + c;
        if (r * G >= NU) break;
        if (u >= NU) continue;
        const int j = 64 - u / 16, bh = u % 16, h = bh & 7;
        if (tid < 128) { const int n = tid; int bk = n; if (n >= 16) { bk = 16 + (int)(logf((float)n / 16.0f) / 2.0794415416798357f * 16.0f); bk = bk > 31 ? 31 : bk; }
            tab[n] = (a.in[26][bk * 8 + h] - a.in[26][31 * 8 + h]) * LOG2E; }
        diff_unit(a, lds, bh >> 3, h, j, tid, wave, lane, lam, dry);
    }
}


__device__ __forceinline__ void ssd_prep_phase(const P& a, LAS unsigned char* lds, int tid, int wave, int lane) {
    LAS unsigned short* tin = (LAS unsigned short*)lds;
    LAS float* sdt = (LAS float*)(lds + 20480); LAS float* sac = sdt + 128;
    const bf16* xbc = (const bf16*)(g_scratch + G_XBC);
    bf16* XT = (bf16*)(a.ws + WS_XT); bf16* BT = (bf16*)(a.ws + WS_BT); bf16* Bn = (bf16*)(g_scratch + G_BNAT); bf16* Cn = (bf16*)(a.ws + WS_CNAT);
    const float* dtf = (const float*)(a.ws + WS_DTF);
    float* acum = (float*)(a.ws + WS_ACUM); float* scv = (float*)(a.ws + WS_SCV); float* dtv = (float*)(a.ws + WS_DTV);
    const float* cw = a.in[11]; const float* cbias = a.in[12];
    for (int it = bidx(); it < NCB * 48; it += gdim()) {
        const int cbi = it / 48, hb = it % 48, b = cbi / NCH, c = cbi % NCH, row0 = b * LP + c * 128;
        for (int i = tid; i < 131 * 8; i += 512) { const int r = i >> 3, pc = i & 7, prow = c * 128 - 3 + r;
            u32x4 v = (u32x4){0u, 0u, 0u, 0u}; if (prow >= 0) v = *(const u32x4*)(xbc + (size_t)(b * LP + prow) * 3072 + hb * 64 + pc * 8);
            LAS unsigned* d = (LAS unsigned*)(tin + r * 66 + pc * 8); d[0] = v.x; d[1] = v.y; d[2] = v.z; d[3] = v.w; }
        if (hb < 32 && tid < 128) {
            const float raw = dtf[(size_t)(row0 + tid) * 64 + hb] + a.in[13][hb];
            float dt = raw > 20.f ? raw : log1pf(expf(raw));
            if (c == 0 && tid < PADL) dt = 0.f;
            sdt[tid] = dt; sac[tid] = -expf(a.in[14][hb]) * dt;
        }
        __syncthreads();
        if (hb < 32 && wave == 0) {
            const float v0 = sac[2 * lane], v1 = sac[2 * lane + 1], s = v0 + v1; float v = s;
#pragma unroll
            for (int o = 1; o < 64; o <<= 1) { const float t = __shfl_up(v, o); if (lane >= o) v += t; }
            sac[2 * lane] = v - s + v0; sac[2 * lane + 1] = v;
        }
        __syncthreads();
        if (hb < 32 && tid < 128) { const size_t idx = ((size_t)cbi * 32 + hb) * 128 + tid; const float ac = sac[tid], dt = sdt[tid];
            acum[idx] = ac; dtv[idx] = dt; scv[idx] = dt * expf(sac[127] - ac); }
        const int l = tid & 127, cg_ = tid >> 7;
        unsigned pk[8];
#pragma unroll
        for (int cc = 0; cc < 16; cc += 2) {
            float vv[2];
#pragma unroll
            for (int e = 0; e < 2; ++e) { const int ch = cg_ * 16 + cc + e, gch = hb * 64 + ch;
                float acc = cbias[gch];
#pragma unroll
                for (int k = 0; k < 4; ++k) acc += cw[k * 3072 + gch] * bf2f(tin[(l + k) * 66 + ch]);
                vv[e] = siluf(acc); }
            pk[cc >> 1] = pk2(vv[0], vv[1]);
        }
        if (hb < 32) {
            bf16* xt = XT + (((size_t)cbi * 32 + hb) * 64 + cg_ * 16) * 128 + l;
#pragma unroll
            for (int cc = 0; cc < 16; ++cc) xt[(size_t)cc * 128] = (bf16)((cc & 1) ? (pk[cc >> 1] >> 16) : (pk[cc >> 1] & 0xffffu));
        } else {
            const int g = ((hb - 32) & 7) >> 1, n0 = ((hb - 32) & 1) * 64 + cg_ * 16;
            bf16* nat = (hb < 40 ? Bn : Cn) + (size_t)(row0 + l) * 512 + g * 128 + n0;
            *(u32x4*)nat = (u32x4){pk[0], pk[1], pk[2], pk[3]}; *(u32x4*)(nat + 8) = (u32x4){pk[4], pk[5], pk[6], pk[7]};
            if (hb < 40) { bf16* bt = BT + (((size_t)cbi * 4 + g) * 128 + n0) * 128 + l;
#pragma unroll
                for (int cc = 0; cc < 16; ++cc) bt[(size_t)cc * 128] = (bf16)((cc & 1) ? (pk[cc >> 1] >> 16) : (pk[cc >> 1] & 0xffffu)); }
        }
        __syncthreads();
    }
}

__device__ __forceinline__ void ssd_s1_phase(const P& a, int wave, int lane) {
    const int li = lane & 15, gq = lane >> 4;
    const bf16* XT = (const bf16*)(a.ws + WS_XT); const bf16* BT = (const bf16*)(a.ws + WS_BT); const float* scv = (const float*)(a.ws + WS_SCV);
    bf16* ST = (bf16*)(g_scratch + G_ST);
    for (int it = bidx(); it < NCB * 4; it += gdim()) {
        const int cbi = it >> 2, g = it & 3, h = 8 * g + wave;
        const bf16* xth = XT + ((size_t)cbi * 32 + h) * 8192 + li * 128 + 8 * gq; const bf16* btg = BT + ((size_t)cbi * 4 + g) * 16384 + li * 128 + 8 * gq;
        const float* sc = scv + ((size_t)cbi * 32 + h) * 128 + 8 * gq;
        f32x4 acc[4][8];
#pragma unroll
        for (int pt = 0; pt < 4; ++pt)
#pragma unroll
            for (int nt = 0; nt < 8; ++nt) acc[pt][nt] = (f32x4){0.f, 0.f, 0.f, 0.f};
#pragma unroll 1
        for (int ks = 0; ks < 4; ++ks) {
            const f32x4 s0 = *(const f32x4*)(sc + 32 * ks), s1 = *(const f32x4*)(sc + 32 * ks + 4);
            bf16x8 af[4];
#pragma unroll
            for (int pt = 0; pt < 4; ++pt) { const u32x4 w = *(const u32x4*)(xth + pt * 2048 + 32 * ks); u32x4 o;
                o.x = pk2(bflo(w.x) * s0[0], bfhi(w.x) * s0[1]); o.y = pk2(bflo(w.y) * s0[2], bfhi(w.y) * s0[3]);
                o.z = pk2(bflo(w.z) * s1[0], bfhi(w.z) * s1[1]); o.w = pk2(bflo(w.w) * s1[2], bfhi(w.w) * s1[3]); af[pt] = mk8(o); }
#pragma unroll
            for (int nt = 0; nt < 8; ++nt) { const bf16x8 bf = *(const bf16x8*)(btg + nt * 2048 + 32 * ks);
#pragma unroll
                for (int pt = 0; pt < 4; ++pt) acc[pt][nt] = mfma16(af[pt], bf, acc[pt][nt]); }
        }
        bf16* st = ST + ((size_t)cbi * 32 + h) * 8192 + (4 * gq) * 128 + li;
#pragma unroll
        for (int pt = 0; pt < 4; ++pt)
#pragma unroll
            for (int nt = 0; nt < 8; ++nt)
#pragma unroll
                for (int r = 0; r < 4; ++r) st[(16 * pt + r) * 128 + 16 * nt] = (bf16)f2bf(acc[pt][nt][r]);
    }
}
__device__ __forceinline__ void ssd_scan_phase(const P& a, int tid, bool dry) {
    bf16* ST = (bf16*)(g_scratch + G_ST); const float* acum = (const float*)(a.ws + WS_ACUM);
    for (int e = bidx() * 512 + tid; e < 131072; e += gdim() * 512) {
        const int b = e >> 16, r = e & 65535, h = r >> 11, off = (r & 2047) * 4;
        float r0 = 0.f, r1 = 0.f, r2 = 0.f, r3 = 0.f;
        u32x2 nx = *(const u32x2*)(ST + ((size_t)(b * NCH) * 32 + h) * 8192 + off); float nd = acum[((size_t)(b * NCH) * 32 + h) * 128 + 127];
        for (int c = 0; c < NCH; ++c) {
            const size_t cbh = (size_t)(b * NCH + c) * 32 + h; u32x2* p = (u32x2*)(ST + cbh * 8192 + off);
            const u32x2 v = nx; const float dec = expf(nd); if (c + 1 < NCH) { nx = *(const u32x2*)(ST + (cbh + 32) * 8192 + off); nd = acum[(cbh + 32) * 128 + 127]; }
            u32x2 o; o.x = pk2(r0, r1); o.y = pk2(r2, r3); if (!dry) *p = o;
            r0 = r0 * dec + bflo(v.x); r1 = r1 * dec + bfhi(v.x); r2 = r2 * dec + bflo(v.y); r3 = r3 * dec + bfhi(v.y);
        }
    }
}
__device__ __forceinline__ void ssd_s3_phase(const P& a, LAS unsigned char* lds, int wave, int lane, bool dry) {
    LAS float* cbl = (LAS float*)lds;
    LAS float* ssum = (LAS float*)(lds + 69632);
    LAS float* sad = (LAS float*)(lds + 73728) + wave * 256;
    const int li = lane & 15, gq = lane >> 4;
    const bf16* XT = (const bf16*)(a.ws + WS_XT); const bf16* Bn = (const bf16*)(g_scratch + G_BNAT); const bf16* Cn = (const bf16*)(a.ws + WS_CNAT);
    const bf16* ST = (const bf16*)(g_scratch + G_ST); bf16* Y = (bf16*)(g_scratch + G_YMIX);
    const float* acum = (const float*)(a.ws + WS_ACUM); const float* dtv = (const float*)(a.ws + WS_DTV);
    for (int it = bidx(); it < NCB * 8; it += gdim()) {
        const int half = it < NCB * 4 ? 1 : 0, idx = it < NCB * 4 ? it : it - NCB * 4;
        const int cbi = idx >> 2, g = idx & 3, h = 8 * g + wave, b = cbi / NCH, c = cbi % NCH, row0 = b * LP + c * 128;
        const bf16* xth = XT + ((size_t)cbi * 32 + h) * 8192; const bf16* pv = ST + ((size_t)cbi * 32 + h) * 8192 + li * 128 + 8 * gq;
        const bf16* bn = Bn + (size_t)row0 * 512 + g * 128 + 8 * gq; const bf16* cn = Cn + (size_t)row0 * 512 + g * 128 + 8 * gq;
        const float Dh = a.in[15][h];
        { const float* ac = acum + ((size_t)cbi * 32 + h) * 128; const float* dtp = dtv + ((size_t)cbi * 32 + h) * 128;
          sad[lane] = ac[lane]; sad[64 + lane] = ac[64 + lane]; sad[128 + lane] = dtp[lane]; sad[192 + lane] = dtp[64 + lane]; }
        bf16x8 pf[4][4];
#pragma unroll
        for (int pt = 0; pt < 4; ++pt)
#pragma unroll
            for (int ks = 0; ks < 4; ++ks) pf[pt][ks] = *(const bf16x8*)(pv + pt * 2048 + 32 * ks);
        {
            const int lcol = 16 * (4 * half + (wave >> 1)) + li; bf16x8 cf[4];
#pragma unroll
            for (int ks = 0; ks < 4; ++ks) cf[ks] = *(const bf16x8*)(cn + (size_t)lcol * 512 + 32 * ks);
#pragma unroll
            for (int sq = 0; sq < 4; ++sq) { const int st = (wave & 1) * 4 + sq;
                f32x4 acc = (f32x4){0.f, 0.f, 0.f, 0.f};
#pragma unroll
                for (int ks = 0; ks < 4; ++ks) acc = mfma16(*(const bf16x8*)(bn + (size_t)(16 * st + li) * 512 + 32 * ks), cf[ks], acc);
                *(LAS f32x4*)(cbl + lcol * 132 + 16 * st + 4 * gq) = acc;
            }
        }
        __syncthreads();
#pragma unroll 1
        for (int lt = 4 * half; lt < 4 * half + 4; ++lt) {
            const int lcol = 16 * lt + li; const float al = sad[lcol];
            f32x4 yo[4], yd[4];
            {
                bf16x8 cf[4];
#pragma unroll
                for (int ks = 0; ks < 4; ++ks) cf[ks] = *(const bf16x8*)(cn + (size_t)lcol * 512 + 32 * ks);
#pragma unroll
                for (int pt = 0; pt < 4; ++pt) { yo[pt] = (f32x4){0.f, 0.f, 0.f, 0.f}; yd[pt] = (f32x4){0.f, 0.f, 0.f, 0.f};
#pragma unroll
                    for (int ks = 0; ks < 4; ++ks) yo[pt] = mfma16(pf[pt][ks], cf[ks], yo[pt]); }
            }
#pragma unroll 1
            for (int sp = 0; sp <= (lt >> 1); ++sp) {
                const int s0 = 32 * sp + 8 * gq;
                bf16x8 xa[4];
#pragma unroll
                for (int pt = 0; pt < 4; ++pt) xa[pt] = *(const bf16x8*)(xth + (size_t)(16 * pt + li) * 128 + s0);
                const f32x4 c0 = *(const LAS f32x4*)(cbl + lcol * 132 + s0), c1 = *(const LAS f32x4*)(cbl + lcol * 132 + s0 + 4);
                const f32x4 a0 = *(const LAS f32x4*)(sad + s0), a1 = *(const LAS f32x4*)(sad + s0 + 4), d0 = *(const LAS f32x4*)(sad + 128 + s0), d1 = *(const LAS f32x4*)(sad + 128 + s0 + 4);
                float mv[8];
#pragma unroll
                for (int r = 0; r < 4; ++r) { mv[r] = (s0 + r <= lcol) ? c0[r] * ex2((al - a0[r]) * LOG2E) * d0[r] : 0.f; mv[4 + r] = (s0 + 4 + r <= lcol) ? c1[r] * ex2((al - a1[r]) * LOG2E) * d1[r] : 0.f; }
                u32x4 bp; bp.x = pk2(mv[0], mv[1]); bp.y = pk2(mv[2], mv[3]); bp.z = pk2(mv[4], mv[5]); bp.w = pk2(mv[6], mv[7]);
#pragma unroll
                for (int pt = 0; pt < 4; ++pt) yd[pt] = mfma16(xa[pt], mk8(bp), yd[pt]);
            }
            const float eal = ex2(al * LOG2E); float ss = 0.f;
            bf16* yrow = Y + (size_t)(row0 + lcol) * 3072 + h * 64 + 4 * gq;
#pragma unroll
            for (int pt = 0; pt < 4; ++pt) {
                const u32x2 zw = *(const u32x2*)(yrow + 16 * pt); const float z[4] = {bflo(zw.x), bfhi(zw.x), bflo(zw.y), bfhi(zw.y)}; float yg[4];
#pragma unroll
                for (int r = 0; r < 4; ++r) { const float xs = bf2f(xth[(size_t)(16 * pt + 4 * gq + r) * 128 + lcol]);
                    yg[r] = (yd[pt][r] + eal * yo[pt][r] + Dh * xs) * siluf(z[r]); ss += yg[r] * yg[r]; }
                u32x2 w; w.x = pk2(yg[0], yg[1]); w.y = pk2(yg[2], yg[3]); if (!dry) *(u32x2*)(yrow + 16 * pt) = w;
            }
            ss += __shfl_xor(ss, 16); ss += __shfl_xor(ss, 32);
            if (gq == 0) ssum[wave * 128 + lcol] = ss;
        }
        __syncthreads();
#pragma unroll 1
        for (int lt = 4 * half; lt < 4 * half + 4; ++lt) {
            const int lcol = 16 * lt + li; float tot = 0.f;
#pragma unroll
            for (int w = 0; w < 8; ++w) tot += ssum[w * 128 + lcol];
            const float rstd = 1.0f / sqrtf(tot * (1.f / 512.f) + 1e-5f);
            bf16* yrow = Y + (size_t)(row0 + lcol) * 3072 + h * 64 + 4 * gq; const float* nw = a.in[16] + h * 64 + 4 * gq;
#pragma unroll
            for (int pt = 0; pt < 4; ++pt) { const u32x2 yw = *(const u32x2*)(yrow + 16 * pt); const f32x4 w4 = *(const f32x4*)(nw + 16 * pt); u32x2 w;
                w.x = pk2(bflo(yw.x) * rstd * w4[0], bfhi(yw.x) * rstd * w4[1]); w.y = pk2(bflo(yw.y) * rstd * w4[2], bfhi(yw.y) * rstd * w4[3]); if (!dry) *(u32x2*)(yrow + 16 * pt) = w; }
        }
        __syncthreads();
    }
}

template <class Epi> __device__ __forceinline__ void run_gemm(LAS unsigned char* lds, const bf16* A, const bf16* Bt, int N, int K, const Epi& E) {
    pg8::Gemm g{A, Bt, M, N, K, K}; pg8::StaticOrder S; S.init(M, N, gdim(), bidx());
    pg8::gemm_phase<Epi, pg8::StaticOrder, true, true>(lds, g, S, E);
}
__device__ __forceinline__ void thin_resid_tail(LAS unsigned char* lds, const bf16* A, const bf16* Bt, int K, bf16* mout, float scale) {
    int tid = threadIdx.x; asm volatile("" : "+v"(tid));
    const int lane = tid & 63, wave = __builtin_amdgcn_readfirstlane(tid >> 6), li = lane & 15, gq = lane >> 4;
    for (int c = bidx(); c < 256; c += gdim()) {
    const int rt = c >> 4, cgp = c & 15, kw = K >> 3;
    const bf16* xa = A + (size_t)(16 * rt + li) * K + wave * kw + 8 * gq;
    const bf16* wb = Bt + (size_t)(64 * cgp + li) * K + wave * kw + 8 * gq;
    f32x4 acc[4];
#pragma unroll
    for (int nt = 0; nt < 4; ++nt) acc[nt] = (f32x4){0.f, 0.f, 0.f, 0.f};
#pragma unroll 4
    for (int ks = 0; ks < kw; ks += 32) {
        const bf16x8 xf = *(const bf16x8*)(xa + ks);
#pragma unroll
        for (int nt = 0; nt < 4; ++nt) acc[nt] = mfma16(*(const bf16x8*)(wb + (size_t)(16 * nt) * K + ks), xf, acc[nt]);
    }
    LAS f32x4* red = (LAS f32x4*)lds;
#pragma unroll
    for (int nt = 0; nt < 4; ++nt) red[(wave * 4 + nt) * 64 + lane] = acc[nt];
    __syncthreads();
    if (wave < 4) {
        f32x4 sum = red[wave * 64 + lane];
#pragma unroll
        for (int w = 1; w < 8; ++w) sum = sum + red[(w * 4 + wave) * 64 + lane];
        u32x2 w; w.x = pk2(sum[0] * scale, sum[1] * scale); w.y = pk2(sum[2] * scale, sum[3] * scale);
        *(u32x2*)(mout + (size_t)(16384 + 16 * rt + li) * 1024 + 64 * cgp + 16 * wave + 4 * gq) = w;
    }
    __syncthreads();
    }
}
__device__ __forceinline__ void thin_qkv_tail(LAS unsigned char* lds, const bf16* A, const bf16* Bt, bf16* dq, bf16* dk, bf16* dvt) {
    int tid = threadIdx.x; asm volatile("" : "+v"(tid));
    const int lane = tid & 63, wave = __builtin_amdgcn_readfirstlane(tid >> 6), li = lane & 15, gq = lane >> 4;
    for (int c = bidx(); c < 256; c += gdim()) {
        const int rt = c >> 4, cgp = c & 15;
        const bf16* xa = A + (size_t)(16 * rt + li) * 1024 + wave * 128 + 8 * gq;
        const bf16* wb = Bt + (size_t)(192 * cgp + li) * 1024 + wave * 128 + 8 * gq;
        f32x4 acc[12];
#pragma unroll
        for (int nt = 0; nt < 12; ++nt) acc[nt] = (f32x4){0.f, 0.f, 0.f, 0.f};
#pragma unroll 2
        for (int ks = 0; ks < 128; ks += 32) {
            const bf16x8 xf = *(const bf16x8*)(xa + ks);
#pragma unroll
            for (int nt = 0; nt < 12; ++nt) acc[nt] = mfma16(*(const bf16x8*)(wb + (size_t)(16 * nt) * 1024 + ks), xf, acc[nt]);
        }
        LAS f32x4* red = (LAS f32x4*)lds;
#pragma unroll
        for (int nt = 0; nt < 12; ++nt) red[(wave * 12 + nt) * 64 + lane] = acc[nt];
        __syncthreads();
        const int row = 16384 + 16 * rt + li, p = row - LP;
        for (int nt = wave; nt < 12; nt += 8) {
            f32x4 sum = red[nt * 64 + lane];
#pragma unroll
            for (int w = 1; w < 8; ++w) sum = sum + red[(w * 12 + nt) * 64 + lane];
            const int col = 192 * cgp + 16 * nt + 4 * gq;
            if (col < 1024) { u32x2 o; o.x = pk2(sum[0] * QSCALE, sum[1] * QSCALE); o.y = pk2(sum[2] * QSCALE, sum[3] * QSCALE); *(u32x2*)(dq + (size_t)row * 1024 + col) = o; }
            else if (col < 2048) { u32x2 o; o.x = pk2(sum[0], sum[1]); o.y = pk2(sum[2], sum[3]); *(u32x2*)(dk + (size_t)row * 1024 + col - 1024) = o; }
            else { const int cv = col - 2048; bf16* vp = dvt + ((size_t)((8 + (cv >> 7)) * 128 + (cv & 127))) * LP + p;
#pragma unroll
                for (int i = 0; i < 4; ++i) vp[(size_t)i * LP] = (bf16)f2bf(sum[i]); }
        }
        __syncthreads();
    }
}
__device__ __forceinline__ void run_resid_gemm(LAS unsigned char* lds, const bf16* A, const bf16* Bt, int K, bf16* mout, float scale) {
    { EpiBranch E{mout, scale}; pg8::Gemm g{A, Bt, 16384, 1024, K, K}; pg8::StaticOrder S; S.init(16384, 1024, gdim(), bidx());
      pg8::gemm_phase<EpiBranch, pg8::StaticOrder, false, true>(lds, g, S, E); }
    thin_resid_tail(lds, A + (size_t)16384 * K, Bt, K, mout, scale);
}
#define PH_BEGIN(k) if (lo <= (k) && (k) < hi) { \
        const __attribute__((address_space(4))) P* ap_ = (const __attribute__((address_space(4))) P*)__builtin_amdgcn_kernarg_segment_ptr(); asm volatile("" : "+s"(ap_)); \
        const P& a = *(const P*)ap_; int tid = threadIdx.x; asm volatile("" : "+v"(tid)); \
        const int lane = tid & 63, wave = __builtin_amdgcn_readfirstlane(tid >> 6); (void)lane; (void)wave; \
        unsigned char* ws = a.ws; asm volatile("" : "+s"(ws)); unsigned char* gs = g_scratch; asm volatile("" : "+s"(gs)); \
        bf16* hb = (bf16*)(ws + WS_HB); bf16* act = (bf16*)(ws + WS_ACT); float* hs = (float*)(ws + WS_HS); bf16* ymix = (bf16*)(gs + G_YMIX); (void)hb; (void)act; (void)hs; (void)ymix;
#define PH_END(k) if ((k) + 1 < hi) { \
            if (USE_XB) { XcdBarrier xbar; xbar.bar = (unsigned*)ws; xbar.x = xb_xcc_id(); xbar.st = (volatile LAS unsigned*)(lds + 131072) + 8; xcd_barrier(xbar); } \
            else { cg::this_grid().sync(); } } }
#define FFN3(base, f, lnidx, fin) \
    PH_BEGIN(base) { EpiSwiGLU E{act}; run_gemm(lds, hb, (const bf16*)(ws + WS_GU + (f) * SZ_GU), 5632, 1024, E); } PH_END(base) \
    PH_BEGIN((base) + 1) run_resid_gemm(lds, act, (const bf16*)(ws + WS_DN + (f) * SZ_DN), DFF, hb, 0.5f); PH_END((base) + 1) \
    PH_BEGIN((base) + 2) ln_phase(a, a.in[2] + (lnidx) * 1024, a.in[3] + (lnidx) * 1024, fin, wave, lane, false); PH_END((base) + 2)
__global__ void __launch_bounds__(512, 2) mk_fwd(P a_) {
    extern __shared__ __attribute__((aligned(16))) unsigned char lds_raw[];
    LAS unsigned char* lds = (LAS unsigned char*)lds_raw;
    if (threadIdx.x < 64) ((LAS unsigned*)(lds + 131072))[threadIdx.x] = 0u;
    __syncthreads();
    (void)xcd_barrier_post((unsigned*)a_.ws, (volatile LAS unsigned*)(lds + 131072) + 8);
    const int lo = a_.ph_lo, hi = a_.ph_hi;
    if (lo < 0) cg::this_grid().sync();
    PH_BEGIN(0) prologue_phase(a, lds, wave, lane); PH_END(0)
    FFN3(1, 0, 0, false)
    PH_BEGIN(4) {
        EpiSplit E{}; E.A = ymix; E.lda = 3072; E.ca = 0; E.t_a = 8; E.B = (bf16*)(gs + G_XBC); E.ldb = 3072; E.cb = 0; E.t_b = 20;
        E.C = ymix; E.ldc = 3072; E.cc = 2048; E.t_c = 24; E.qs = QSCALE; E.Dd = (bf16*)(ws + WS_K); E.ldd = 1024; E.cd = 0; E.t_d = 28;
        E.VT = (bf16*)(ws + WS_VT); E.t_e = 32; E.hd_shift = 6; E.nheads = 16; E.dtf = (float*)(ws + WS_DTF);
        run_gemm(lds, hb, (const bf16*)(ws + WS_WIN), NIN_PAD, 1024, E); } PH_END(4)
    PH_BEGIN(5) c2_phase(a, lds, tid, wave, lane); PH_END(5)
    PH_BEGIN(6) fox_phase(a, lds, tid, wave, lane, false); PH_END(6)
    PH_BEGIN(7) ssd_prep_phase(a, lds, tid, wave, lane); PH_END(7)
    PH_BEGIN(8) ssd_s1_phase(a, wave, lane); PH_END(8)
    PH_BEGIN(9) ssd_scan_phase(a, tid, false); PH_END(9)
    PH_BEGIN(10) ssd_s3_phase(a, lds, wave, lane, false); PH_END(10)
    PH_BEGIN(11) run_resid_gemm(lds, ymix, (const bf16*)(ws + WS_WOUT), 3072, hb, 1.0f); PH_END(11)
    PH_BEGIN(12) ln_phase(a, a.in[2] + 1 * 1024, a.in[3] + 1 * 1024, false, wave, lane, false); PH_END(12)
    FFN3(13, 1, 2, false)
    FFN3(16, 2, 3, false)
    PH_BEGIN(19) {
        EpiSplit E{}; E.t_a = 0; E.t_b = 0; E.A = E.B = nullptr; E.lda = E.ldb = 0; E.ca = E.cb = 0;
        E.C = (bf16*)(gs + G_DQ); E.ldc = 1024; E.cc = 0; E.t_c = 4; E.qs = QSCALE; E.Dd = (bf16*)(gs + G_DK); E.ldd = 1024; E.cd = 0; E.t_d = 8;
        E.VT = (bf16*)(gs + G_DVT); E.t_e = 12; E.hd_shift = 7; E.nheads = 8; E.dtf = nullptr;
        { pg8::Gemm g{hb, (const bf16*)(ws + WS_WQKV), 16384, 3072, 1024, 1024}; pg8::StaticOrder S; S.init(16384, 3072, gdim(), bidx());
          pg8::gemm_phase<EpiSplit, pg8::StaticOrder, true, true>(lds, g, S, E); }
        thin_qkv_tail(lds, hb + (size_t)16384 * 1024, (const bf16*)(ws + WS_WQKV), (bf16*)(gs + G_DQ), (bf16*)(gs + G_DK), (bf16*)(gs + G_DVT)); } PH_END(19)
    PH_BEGIN(20) diff_phase(a, lds, tid, wave, lane, false); PH_END(20)
    PH_BEGIN(21) run_resid_gemm(lds, (const bf16*)(gs + G_DQ), (const bf16*)(ws + WS_WO), 1024, hb, 1.0f); PH_END(21)
    PH_BEGIN(22) ln_phase(a, a.in[2] + 4 * 1024, a.in[3] + 4 * 1024, false, wave, lane, false); PH_END(22)
    FFN3(23, 3, 5, true)
}
}

extern "C" void kernel_launch(void* const* d_in, const int* in_sizes, int n_in, void* d_out, int out_size, void* d_ws, size_t ws_size, hipStream_t stream) {
    static int grid = 0;
    if (grid == 0) {
        if (n_in != 27 || ws_size < mk::WS_END2) { fprintf(stderr, "kernel_launch: unexpected n_in %d / ws_size %zu (need %zu)\n", n_in, ws_size, (size_t)mk::WS_END2); grid = -1; return; }
        int dev = 0, cus = 0, per_cu = 0;
        hipGetDevice(&dev); hipDeviceGetAttribute(&cus, hipDeviceAttributeMultiprocessorCount, dev);
        if (hipFuncSetAttribute((const void*)mk::mk_fwd, hipFuncAttributeMaxDynamicSharedMemorySize, mk::LDS_BYTES) != hipSuccess) { fprintf(stderr, "kernel_launch: hipFuncSetAttribute failed\n"); grid = -1; return; }
        hipOccupancyMaxActiveBlocksPerMultiprocessor(&per_cu, (const void*)mk::mk_fwd, 512, mk::LDS_BYTES);
        (void)hipGetLastError();
        if (per_cu < 1) fprintf(stderr, "kernel_launch: occupancy query says %d blocks/CU\n", per_cu);
        grid = cus > 0 ? cus : 256;
    }
    if (grid < 0) return;
    if (hipMemsetAsync(d_ws, 0, 65536, stream) != hipSuccess) { fprintf(stderr, "kernel_launch: memset of barrier words failed\n"); return; }
    mk::P a{};
    for (int i = 0; i < 27; ++i) a.in[i] = (const float*)d_in[i];
    a.out = (float*)d_out; a.ws = (unsigned char*)d_ws;
#if MK_MULTI
    for (int ph = 0; ph < mk::NPH; ++ph) { a.ph_lo = ph; a.ph_hi = ph + 1; hipLaunchKernelGGL(mk::mk_fwd, dim3(grid), dim3(512), mk::LDS_BYTES, stream, a); }
#else
    a.ph_lo = 0; a.ph_hi = mk::NPH;
    void* args[] = {&a};
    hipError_t e = hipLaunchCooperativeKernel((const void*)mk::mk_fwd, dim3(grid), dim3(512), args, mk::LDS_BYTES, stream);
    if (e != hipSuccess) fprintf(stderr, "cooperative launch failed: %s (grid %d)\n", hipGetErrorString(e), grid);
#endif
}
```

```cpp
#include <hip/hip_runtime.h>
#include <hip/hip_cooperative_groups.h>
#include <cstdio>
#include <cstdint>
namespace cg = cooperative_groups;
namespace pg8 {
#define PG8_LAS __attribute__((address_space(3)))
typedef unsigned short bf16_t;
typedef short bf16x8 __attribute__((ext_vector_type(8)));
typedef float f32x4 __attribute__((ext_vector_type(4)));
typedef unsigned u32x4 __attribute__((ext_vector_type(4)));
constexpr int BM = 256, BK = 64, HALF = 128, HTB = HALF * BK * 2  , STAGE_BYTES = 8 * HTB, NXCD = 8, WGM = 8;

__host__ __device__ __forceinline__ int lds_byte(int r, int c) { const int st = (r >> 4) * 2 + (c >> 5), rr = r & 15, cc = c & 31, ob = rr * 64 + cc * 2; return st * 1024 + (ob ^ (((ob >> 9) & 1) << 5)); }
__host__ __device__ __forceinline__ void stage_rc(int b, int& R, int& C) { const int st = b / 1024, sb = b % 1024, swz = sb ^ (((sb >> 9) & 1) << 5); R = (st >> 1) * 16 + swz / 64; C = (st & 1) * 32 + (swz % 64) / 2; }
__host__ __device__ __forceinline__ int perm32(int rho) { const int n = rho >> 4, i = rho & 15; return 8 * (i >> 2) + 4 * n + (i & 3); }

struct Unit { int pm, pn; };
struct Gemm { const bf16_t* A; const bf16_t* Bt; int M, N, K, ld; };

struct StaticOrder {
    int nM, nN, nwg, G, c;
    __host__ __device__ void init(int M, int N, int G_, int c_) { nM = M / BM; nN = N / BM; nwg = nM * nN; G = G_; c = c_; }
    __host__ __device__ bool next(int i, Unit& u) const {
        const long L = (long)i * G + c; if (L >= nwg) return false;
        int wgid = (int)L; { const int q = nwg / NXCD, r = nwg % NXCD, xcd = wgid % NXCD, off = wgid / NXCD; wgid = (xcd < r ? xcd * (q + 1) : r * (q + 1) + (xcd - r) * q) + off; }
        const int nig = WGM * nN, gid = wgid / nig, fm = gid * WGM, gsz = (nM - fm) < WGM ? (nM - fm) : WGM;
        u.pm = fm + ((wgid % nig) % gsz); u.pn = (wgid % nig) / gsz; return true;
    }
    __device__ __forceinline__ void a_ready(const Unit&) const {}
    __device__ __forceinline__ void done(const Unit&) const {}
};

__device__ __forceinline__ unsigned cvt_pk_bf16(float lo, float hi) { unsigned r; asm volatile("v_cvt_pk_bf16_f32 %0, %1, %2" : "=v"(r) : "v"(lo), "v"(hi)); return r; }
typedef float f32x2 __attribute__((ext_vector_type(2)));
__device__ __forceinline__ f32x2 gelu_pk(f32x2 v) {
    const f32x2 av = __builtin_elementwise_abs(v), d = av * 0.2316418882f + 1.0f;
    f32x2 t; t.x = __builtin_amdgcn_rcpf(d.x); t.y = __builtin_amdgcn_rcpf(d.y);
    f32x2 q = t * 0.5307027145f + (-0.7265760135f); q = q * t + 0.7107068705f; q = q * t + (-0.142248368f); q = q * t + 0.127414796f; q = q * t;
    const f32x2 s = (v * v) * (-0.72134752044f);
    f32x2 e; e.x = __builtin_amdgcn_exp2f(s.x); e.y = __builtin_amdgcn_exp2f(s.y);
    const f32x2 m = v * (q * e), r = v - m;
    f32x2 o; o.x = v.x < 0.f ? m.x : r.x; o.y = v.y < 0.f ? m.y : r.y; return o;
}

template <int ACT  > struct EpiBf16 {
    static constexpr bool PERM = true, AFTER_DRAIN = false; static_assert(ACT == 0 || ACT == 1, "EpiBf16: ACT is 0 (none) or 1 (gelu_pk)");
    bf16_t* O; int ldc; const float* bias; int split_cols; size_t split_stride; float scale0;
    __device__ __forceinline__ void operator()(const f32x4 (&acc)[2][2][4][2], const Unit& u, int wr, int wc, int fr, int fq) const {
        const int row0 = u.pm * BM + wr * 64 + fr; int colt = u.pn * BM; bf16_t* base = O;
        float sc = 1.f; if (split_cols) { const int t = colt / split_cols; base += (size_t)t * split_stride; colt -= t * split_cols; if (t == 0) sc = scale0; }
        const int col0 = colt + wc * 32 + 8 * fq, bcol0 = u.pn * BM + wc * 32 + 8 * fq;
        f32x4 bv[2][2];
#pragma unroll
        for (int bj = 0; bj < 2; ++bj)
#pragma unroll
            for (int n = 0; n < 2; ++n) bv[bj][n] = bias ? *(const f32x4*)(bias + bcol0 + bj * HALF + 4 * n) : (f32x4){0.f, 0.f, 0.f, 0.f};
#pragma unroll
        for (int ai = 0; ai < 2; ++ai)
#pragma unroll
            for (int m = 0; m < 4; ++m) { bf16_t* rowp = base + (size_t)(row0 + ai * HALF + m * 16) * ldc + col0;
#pragma unroll
                for (int bj = 0; bj < 2; ++bj) { f32x4 v0 = acc[ai][bj][m][0] + bv[bj][0], v1 = acc[ai][bj][m][1] + bv[bj][1];
                    if (ACT == 1) { f32x2 a = gelu_pk((f32x2){v0[0], v0[1]}), b = gelu_pk((f32x2){v0[2], v0[3]}), c = gelu_pk((f32x2){v1[0], v1[1]}), d = gelu_pk((f32x2){v1[2], v1[3]});
                        v0 = (f32x4){a.x, a.y, b.x, b.y}; v1 = (f32x4){c.x, c.y, d.x, d.y}; }
                    v0 = v0 * sc; v1 = v1 * sc; u32x4 w; w.x = cvt_pk_bf16(v0[0], v0[1]); w.y = cvt_pk_bf16(v0[2], v0[3]); w.z = cvt_pk_bf16(v1[0], v1[1]); w.w = cvt_pk_bf16(v1[2], v1[3]);
                    *(u32x4*)(rowp + bj * HALF) = w; } }
    }
};

struct PanelStats {
    unsigned* xbuf;
    unsigned* cnt;
    unsigned* tmo;
    int ntn; float eps;
    unsigned code;
    __device__ __forceinline__ bool run(const f32x4 (&v)[2][2][4][2], const Unit& u, int wr, int wc, int fr, int fq, PG8_LAS unsigned char* lds, int wid, int lane) const {
        typedef float f32x2v __attribute__((ext_vector_type(2)));
        PG8_LAS f32x2v* P = (PG8_LAS f32x2v*)lds;
        PG8_LAS f32x2v* S = (PG8_LAS f32x2v*)(lds + 8192);
        PG8_LAS unsigned* flag = (PG8_LAS unsigned*)(lds + 8192 + 2048);
#pragma unroll
        for (int ai = 0; ai < 2; ++ai)
#pragma unroll
            for (int m = 0; m < 4; ++m) {
                float s = 0.f;
#pragma unroll
                for (int bj = 0; bj < 2; ++bj)
#pragma unroll
                    for (int n = 0; n < 2; ++n) { const f32x4 x = v[ai][bj][m][n]; s += (x[0] + x[1]) + (x[2] + x[3]); }
                s += __shfl_xor(s, 16); s += __shfl_xor(s, 32);
                const float mw = s * (1.0f / 64.0f); float q = 0.f;
#pragma unroll
                for (int bj = 0; bj < 2; ++bj)
#pragma unroll
                    for (int n = 0; n < 2; ++n) { const f32x4 d = v[ai][bj][m][n] - mw; q += (d[0] * d[0] + d[1] * d[1]) + (d[2] * d[2] + d[3] * d[3]); }
                q += __shfl_xor(q, 16); q += __shfl_xor(q, 32);
                if (fq == 0) P[(ai * HALF + wr * 64 + m * 16 + fr) * 4 + wc] = (f32x2v){mw, q};
            }
        asm volatile("s_waitcnt lgkmcnt(0)" ::: "memory"); __builtin_amdgcn_s_barrier(); asm volatile("" ::: "memory");
#if defined(BROKEN_EXCHANGE_NO_WAIT)
#warning BROKEN CONTROL BUILD: the row-statistics exchange does not wait; results are wrong by design
        if (blockIdx.x >= 64) { const long long t0_ = clock64(); while (clock64() - t0_ < 60000) __builtin_amdgcn_s_sleep(8); }
#endif
        const int row = wid * 32 + (lane & 31);
        if (lane < 32) {
            const f32x2v a = P[row * 4 + 0], b = P[row * 4 + 1], c = P[row * 4 + 2], d = P[row * 4 + 3];
            const float mt = (a.x + b.x + c.x + d.x) * 0.25f;
            const float da = a.x - mt, db = b.x - mt, dc = c.x - mt, dd = d.x - mt;
            const float m2 = (a.y + b.y) + (c.y + d.y) + 64.0f * ((da * da + db * db) + (dc * dc + dd * dd));
            unsigned long long* slot = (unsigned long long*)xbuf + ((size_t)(u.pm * BM + row) * 4 + u.pn);
            __hip_atomic_store(slot, ((unsigned long long)__float_as_uint(m2) << 32) | __float_as_uint(mt), __ATOMIC_RELAXED, __HIP_MEMORY_SCOPE_AGENT);
        }
        asm volatile("s_waitcnt vmcnt(0)" ::: "memory");
        if (lane == 0) __hip_atomic_fetch_add(cnt + 64 * u.pm, 1u, __ATOMIC_RELAXED, __HIP_MEMORY_SCOPE_AGENT);
        if (wid == 0) {
            bool dead = false; const unsigned long long t0 = __builtin_amdgcn_s_memrealtime(); const unsigned want = 8u * (unsigned)ntn;
            for (;;) {
#if defined(BROKEN_EXCHANGE_NO_WAIT)
                break;
#endif
                if ((unsigned)__builtin_amdgcn_readfirstlane(__hip_atomic_load(cnt + 64 * u.pm, __ATOMIC_RELAXED, __HIP_MEMORY_SCOPE_AGENT)) >= want) break;
                if (__builtin_amdgcn_s_memrealtime() - t0 > 2000000ull) {
                    if (lane == 0) { unsigned expect = 0u; __hip_atomic_compare_exchange_strong(tmo + 1, &expect, code | (unsigned)(u.pm & 0xff), __ATOMIC_RELAXED, __ATOMIC_RELAXED, __HIP_MEMORY_SCOPE_AGENT);
                                     __hip_atomic_store(tmo, 1u, __ATOMIC_RELAXED, __HIP_MEMORY_SCOPE_AGENT); }
                    dead = true; break; }
                __builtin_amdgcn_s_sleep(2);
            }
            __builtin_amdgcn_fence(__ATOMIC_ACQUIRE, "agent");
            if (lane == 0) flag[0] = dead ? 1u : 0u;
        }
        asm volatile("s_waitcnt vmcnt(0) lgkmcnt(0)" ::: "memory"); __builtin_amdgcn_s_barrier(); asm volatile("" ::: "memory");
        const bool bad = flag[0] != 0u;
        if (lane < 32) {
            const unsigned long long* slot = (const unsigned long long*)xbuf + (size_t)(u.pm * BM + row) * 4; float mt[4], m2[4]; float ms = 0.f;
#pragma unroll
            for (int t = 0; t < 4; ++t) { if (t < ntn) { const unsigned long long w = __hip_atomic_load(slot + t, __ATOMIC_RELAXED, __HIP_MEMORY_SCOPE_AGENT); mt[t] = __uint_as_float((unsigned)w); m2[t] = __uint_as_float((unsigned)(w >> 32)); } else { mt[t] = 0.f; m2[t] = 0.f; } ms += mt[t]; }
            const float mean = ms / (float)ntn; float q = 0.f;
#pragma unroll
            for (int t = 0; t < 4; ++t) if (t < ntn) { const float dm = mt[t] - mean; q += m2[t] + 256.0f * dm * dm; }
            S[row] = (f32x2v){mean, 1.0f / sqrtf(q / (256.0f * (float)ntn) + eps)};
        }
        asm volatile("s_waitcnt lgkmcnt(0)" ::: "memory"); __builtin_amdgcn_s_barrier(); asm volatile("" ::: "memory");
        return bad;
    }
};
struct EpiLnRes {
    static constexpr bool PERM = false, AFTER_DRAIN = true;
    const float* base; float* out; int ldc; const float* bias; PanelStats st; unsigned poison;
    __device__ __forceinline__ void fused(f32x4 (&acc)[2][2][4][2], const Unit& u, int wr, int wc, int fr, int fq, PG8_LAS unsigned char* lds, int wid, int lane) const {
        typedef float f32x2v __attribute__((ext_vector_type(2)));
        const PG8_LAS f32x2v* S = (const PG8_LAS f32x2v*)(lds + 8192);
        const int col0 = u.pn * BM + wc * 32 + 4 * fq;
#pragma unroll
        for (int bj = 0; bj < 2; ++bj)
#pragma unroll
            for (int n = 0; n < 2; ++n) { const f32x4 bv = bias ? *(const f32x4*)(bias + col0 + bj * HALF + n * 16) : (f32x4){0.f, 0.f, 0.f, 0.f};
#pragma unroll
                for (int ai = 0; ai < 2; ++ai)
#pragma unroll
                    for (int m = 0; m < 4; ++m) acc[ai][bj][m][n] += bv; }
        f32x4 pre[4][2][2];
#pragma unroll
        for (int m = 0; m < 4; ++m) { const size_t off = (size_t)(u.pm * BM + wr * 64 + m * 16 + fr) * ldc + col0;
#pragma unroll
            for (int bj = 0; bj < 2; ++bj)
#pragma unroll
                for (int n = 0; n < 2; ++n) pre[m][bj][n] = *(const f32x4*)(base + off + bj * HALF + n * 16); }
        const bool bad = st.run(acc, u, wr, wc, fr, fq, lds, wid, lane) || poison != 0u;
        const float qnan = __builtin_nanf("");
#pragma unroll
        for (int ai = 0; ai < 2; ++ai)
#pragma unroll
            for (int m = 0; m < 4; ++m) { const int r = ai * HALF + wr * 64 + m * 16 + fr; const f32x2v sr = S[r]; const size_t off = (size_t)(u.pm * BM + r) * ldc + col0;
#pragma unroll
                for (int bj = 0; bj < 2; ++bj)
#pragma unroll
                    for (int n = 0; n < 2; ++n) { const f32x4 bs = ai == 0 ? pre[m][bj][n] : *(const f32x4*)(base + off + bj * HALF + n * 16); f32x4 o = bs + (acc[ai][bj][m][n] - sr.x) * sr.y;
                        if (bad) o = (f32x4){qnan, qnan, qnan, qnan}; *(f32x4*)(out + off + bj * HALF + n * 16) = o; }
                if (m & 1) asm volatile("" ::: "memory"); }
    }
};
struct EpiLnResLn {
    static constexpr bool PERM = false, AFTER_DRAIN = true;
    const float* base; float* out; bf16_t* xn; int ldc; const float* bias; PanelStats st1, st2; unsigned poison;
    __device__ __forceinline__ void fused(f32x4 (&acc)[2][2][4][2], const Unit& u, int wr, int wc, int fr, int fq, PG8_LAS unsigned char* lds, int wid, int lane) const {
        typedef float f32x2v __attribute__((ext_vector_type(2))); typedef unsigned u32x2v __attribute__((ext_vector_type(2)));
        const PG8_LAS f32x2v* S = (const PG8_LAS f32x2v*)(lds + 8192);
        const int col0 = u.pn * BM + wc * 32 + 4 * fq;
#pragma unroll
        for (int bj = 0; bj < 2; ++bj)
#pragma unroll
            for (int n = 0; n < 2; ++n) { const f32x4 bv = bias ? *(const f32x4*)(bias + col0 + bj * HALF + n * 16) : (f32x4){0.f, 0.f, 0.f, 0.f};
#pragma unroll
                for (int ai = 0; ai < 2; ++ai)
#pragma unroll
                    for (int m = 0; m < 4; ++m) acc[ai][bj][m][n] += bv; }
        bool bad = st1.run(acc, u, wr, wc, fr, fq, lds, wid, lane) || poison != 0u;
        const float qnan = __builtin_nanf("");
#pragma unroll
        for (int ai = 0; ai < 2; ++ai)
#pragma unroll
            for (int m = 0; m < 4; ++m) { const int r = ai * HALF + wr * 64 + m * 16 + fr; const f32x2v sr = S[r]; const size_t off = (size_t)(u.pm * BM + r) * ldc + col0;
#pragma unroll
                for (int bj = 0; bj < 2; ++bj)
#pragma unroll
                    for (int n = 0; n < 2; ++n) { const f32x4 bs = *(const f32x4*)(base + off + bj * HALF + n * 16); acc[ai][bj][m][n] = bs + (acc[ai][bj][m][n] - sr.x) * sr.y; }
                asm volatile("" : "+v"(acc[ai][0][m][0]), "+v"(acc[ai][0][m][1]), "+v"(acc[ai][1][m][0]), "+v"(acc[ai][1][m][1]));
                if (m & 1) asm volatile("" ::: "memory"); }
        const bool bad1 = bad;
        bad = st2.run(acc, u, wr, wc, fr, fq, lds, wid, lane) || bad;
#pragma unroll
        for (int ai = 0; ai < 2; ++ai)
#pragma unroll
            for (int m = 0; m < 4; ++m) { const int r = ai * HALF + wr * 64 + m * 16 + fr; const f32x2v sr = S[r]; const size_t off = (size_t)(u.pm * BM + r) * ldc + col0;
#pragma unroll
                for (int bj = 0; bj < 2; ++bj)
#pragma unroll
                    for (int n = 0; n < 2; ++n) { const f32x4 x1 = acc[ai][bj][m][n]; *(f32x4*)(out + off + bj * HALF + n * 16) = bad1 ? (f32x4){qnan, qnan, qnan, qnan} : x1;
                        const f32x4 o = (x1 - sr.x) * sr.y; u32x2v w; w.x = cvt_pk_bf16(o[0], o[1]); w.y = cvt_pk_bf16(o[2], o[3]);
                        if (bad) { w.x = 0x7fc07fc0u; w.y = 0x7fc07fc0u; } *(u32x2v*)(xn + off + bj * HALF + n * 16) = w; }
                asm volatile("" ::: "memory"); }
    }
};

template <class Epi, class Sched, bool ALIGN_EPI = false, bool SP2 = false>
__device__ __forceinline__ void gemm_phase(PG8_LAS unsigned char* lds, const Gemm g, const Sched& S, const Epi& E) {
    int tid_raw_ = threadIdx.x; asm volatile("" : "+v"(tid_raw_));
    const int tid = tid_raw_, wid = __builtin_amdgcn_readfirstlane(tid >> 6), lane = tid & 63, wr = wid >> 2, wc = wid & 3, fr = lane & 15, fq = lane >> 4;
    const int K = g.K, nt = K / BK, LD = g.ld;
    unsigned voffA[2], voffB[2];
#pragma unroll
    for (int i = 0; i < 2; ++i) { int R, C; stage_rc(tid * 16 + i * 8192, R, C); const int Rb = Epi::PERM ? ((R & ~31) + perm32(R & 31)) : R;
        voffA[i] = (unsigned)(R * LD + C) * 2u; voffB[i] = (unsigned)(Rb * LD + C) * 2u; }
    const size_t kstep = (size_t)(BK * 2);
    const size_t hstep = (size_t)HALF * LD * 2;
    const size_t tstep = 2 * hstep;
    const unsigned ldsw = (unsigned)wid * 1024u;
    const int aoff = lds_byte(wr * 64 + fr, fq * 8), boff = lds_byte(wc * 32 + fr, fq * 8);
#define PG8_SA(b, h) (((b) * 2 + (h)) * HTB)
#define PG8_SB(b, h) ((4 + (b) * 2 + (h)) * HTB)
#define PG8_STAGE(bufoff, gbase, voff) do { _Pragma("unroll") for (int _i = 0; _i < 2; ++_i) \
        __builtin_amdgcn_global_load_lds((const unsigned*)((const char*)(gbase) + (voff)[_i]), (PG8_LAS unsigned*)(lds + (bufoff) + ldsw + _i * 8192), 16, 0, 0); } while (0)
#define PG8_LDA(dst, b, h) do { _Pragma("unroll") for (int m = 0; m < 4; ++m) _Pragma("unroll") for (int k = 0; k < 2; ++k) dst[m][k] = *(const PG8_LAS bf16x8*)(lds + PG8_SA(b, h) + aoff + m * 2048 + k * 1024); } while (0)
#define PG8_LDB(dst, b, h) do { _Pragma("unroll") for (int n = 0; n < 2; ++n) _Pragma("unroll") for (int k = 0; k < 2; ++k) dst[n][k] = *(const PG8_LAS bf16x8*)(lds + PG8_SB(b, h) + boff + n * 2048 + k * 1024); } while (0)
#define PG8_MMA(ai, bj, At, Bt) do { __builtin_amdgcn_s_setprio(1); _Pragma("unroll") for (int m = 0; m < 4; ++m) _Pragma("unroll") for (int n = 0; n < 2; ++n) _Pragma("unroll") for (int k = 0; k < 2; ++k) \
        acc[ai][bj][m][n] = __builtin_amdgcn_mfma_f32_16x16x32_bf16(Bt[n][k], At[m][k], acc[ai][bj][m][n], 0, 0, 0); __builtin_amdgcn_s_setprio(0); } while (0)
#define PG8_WAIT_V(n) asm volatile("s_waitcnt vmcnt(" #n ")" ::: "memory")
#define PG8_WAIT_L(n) asm volatile("s_waitcnt lgkmcnt(" #n ")" ::: "memory")
#define PG8_BAR __builtin_amdgcn_s_barrier()
#define PG8_SCHED __builtin_amdgcn_sched_barrier(0)
    Unit cur, nxt; int ui = 0;
    if (!S.next(0, cur)) return;
    f32x4 acc[2][2][4][2];
#pragma unroll
    for (int a = 0; a < 2; ++a)
#pragma unroll
        for (int b = 0; b < 2; ++b)
#pragma unroll
            for (int m = 0; m < 4; ++m)
#pragma unroll
                for (int n = 0; n < 2; ++n) acc[a][b][m][n] = (f32x4){0.f, 0.f, 0.f, 0.f};
    bf16x8 At[4][2], B0[2][2], B1[2][2];
    const char* cA = (const char*)g.A + (size_t)cur.pm * tstep; const char* cB = (const char*)g.Bt + (size_t)cur.pn * tstep;
    S.a_ready(cur);
    if constexpr (SP2) {
        PG8_STAGE(PG8_SB(0, 0), cB, voffB); PG8_STAGE(PG8_SB(0, 1), cB + hstep, voffB); PG8_STAGE(PG8_SA(0, 0), cA, voffA); PG8_STAGE(PG8_SA(0, 1), cA + hstep, voffA);
        if (wr == 1) PG8_BAR;
        PG8_WAIT_V(2); PG8_BAR;
        PG8_STAGE(PG8_SB(1, 0), cB + kstep, voffB); PG8_STAGE(PG8_SA(1, 0), cA + kstep, voffA); PG8_STAGE(PG8_SB(1, 1), cB + hstep + kstep, voffB);
        PG8_WAIT_V(6); PG8_BAR;
    } else {
        PG8_STAGE(PG8_SB(0, 0), cB, voffB); PG8_STAGE(PG8_SA(0, 0), cA, voffA); PG8_STAGE(PG8_SB(0, 1), cB + hstep, voffB); PG8_STAGE(PG8_SA(0, 1), cA + hstep, voffA);
        if (wr == 1) PG8_BAR;
        PG8_WAIT_V(4); PG8_BAR;
        PG8_STAGE(PG8_SB(1, 0), cB + kstep, voffB); PG8_STAGE(PG8_SA(1, 0), cA + kstep, voffA); PG8_STAGE(PG8_SB(1, 1), cB + hstep + kstep, voffB);
        PG8_WAIT_V(6); PG8_BAR;
    }
    for (;;) {
        const bool has_next = S.next(ui + 1, nxt);
        const char* nA = has_next ? (const char*)g.A + (size_t)nxt.pm * tstep : cA; const char* nB = has_next ? (const char*)g.Bt + (size_t)nxt.pn * tstep : cB;
        for (int t = 0; t < nt; t += 2) {
            const bool last = (t == nt - 2);
            const char* a1 = cA + (size_t)(t + 1) * kstep;
            const char* a2 = last ? nA : cA + (size_t)(t + 2) * kstep; const char* b2 = last ? nB : cB + (size_t)(t + 2) * kstep;
            const char* a3 = a2 + kstep; const char* b3 = b2 + kstep;
            if (last && has_next) S.a_ready(nxt);
            if constexpr (SP2) {
            PG8_LDB(B0, 0, 0); PG8_LDB(B1, 0, 1); PG8_SCHED; PG8_LDA(At, 0, 0); PG8_STAGE(PG8_SA(1, 1), a1 + hstep, voffA);
            PG8_WAIT_V(8); PG8_WAIT_L(0); PG8_BAR; PG8_MMA(0, 0, At, B0); PG8_MMA(0, 1, At, B1); PG8_BAR; PG8_SCHED;
            PG8_LDA(At, 0, 1); PG8_STAGE(PG8_SB(0, 0), b2, voffB); PG8_STAGE(PG8_SB(0, 1), b2 + hstep, voffB); PG8_STAGE(PG8_SA(0, 0), a2, voffA);
            PG8_WAIT_V(8); PG8_WAIT_L(0); PG8_BAR; PG8_MMA(1, 0, At, B0); PG8_MMA(1, 1, At, B1); PG8_BAR; PG8_SCHED;
            PG8_LDB(B0, 1, 0); PG8_LDB(B1, 1, 1); PG8_SCHED; PG8_LDA(At, 1, 0); PG8_STAGE(PG8_SA(0, 1), a2 + hstep, voffA);
            PG8_WAIT_V(8); PG8_WAIT_L(0); PG8_BAR; PG8_MMA(0, 0, At, B0); PG8_MMA(0, 1, At, B1); PG8_BAR; PG8_SCHED;
            PG8_LDA(At, 1, 1); PG8_STAGE(PG8_SB(1, 0), b3, voffB); PG8_STAGE(PG8_SB(1, 1), b3 + hstep, voffB); PG8_STAGE(PG8_SA(1, 0), a3, voffA);
            PG8_WAIT_V(8); PG8_WAIT_L(0); PG8_BAR; PG8_MMA(1, 0, At, B0); PG8_MMA(1, 1, At, B1); PG8_BAR; PG8_SCHED;
            } else {
            PG8_LDB(B0, 0, 0); PG8_SCHED; PG8_LDA(At, 0, 0); PG8_STAGE(PG8_SA(1, 1), a1 + hstep, voffA);
            PG8_WAIT_L(8); PG8_BAR; PG8_WAIT_L(0); PG8_MMA(0, 0, At, B0); PG8_BAR; PG8_SCHED;
            PG8_LDB(B1, 0, 1); PG8_STAGE(PG8_SB(0, 0), b2, voffB);
            PG8_BAR; PG8_WAIT_L(0); PG8_MMA(0, 1, At, B1); PG8_BAR;
            PG8_LDA(At, 0, 1); PG8_STAGE(PG8_SA(0, 0), a2, voffA);
            PG8_BAR; PG8_WAIT_L(0); PG8_MMA(1, 0, At, B0); PG8_BAR; PG8_SCHED;
            PG8_STAGE(PG8_SB(0, 1), b2 + hstep, voffB);
            PG8_WAIT_V(6); PG8_BAR; PG8_MMA(1, 1, At, B1); PG8_BAR;
            PG8_LDB(B0, 1, 0); PG8_SCHED; PG8_LDA(At, 1, 0); PG8_STAGE(PG8_SA(0, 1), a2 + hstep, voffA);
            PG8_WAIT_L(8); PG8_BAR; PG8_WAIT_L(0); PG8_MMA(0, 0, At, B0); PG8_BAR; PG8_SCHED;
            PG8_LDB(B1, 1, 1); PG8_STAGE(PG8_SB(1, 0), b3, voffB);
            PG8_BAR; PG8_WAIT_L(0); PG8_MMA(0, 1, At, B1); PG8_BAR;
            PG8_LDA(At, 1, 1); PG8_STAGE(PG8_SA(1, 0), a3, voffA);
            PG8_BAR; PG8_WAIT_L(0); PG8_MMA(1, 0, At, B0); PG8_BAR; PG8_SCHED;
            PG8_STAGE(PG8_SB(1, 1), b3 + hstep, voffB);
            PG8_WAIT_V(6); PG8_BAR; PG8_MMA(1, 1, At, B1); PG8_BAR;
            }
        }
        if constexpr (ALIGN_EPI) { if (wr == 0) PG8_BAR; }
        if constexpr (!Epi::AFTER_DRAIN) { E(acc, cur, wr, wc, fr, fq); S.done(cur); }
        if (!has_next) break;
#pragma unroll
        for (int a = 0; a < 2; ++a)
#pragma unroll
            for (int b = 0; b < 2; ++b)
#pragma unroll
                for (int m = 0; m < 4; ++m)
#pragma unroll
                    for (int n = 0; n < 2; ++n) acc[a][b][m][n] = (f32x4){0.f, 0.f, 0.f, 0.f};
        cur = nxt; cA = nA; cB = nB; ++ui;
        if constexpr (ALIGN_EPI) { if (wr == 1) PG8_BAR; }
    }
    PG8_WAIT_V(0);
    if constexpr (!ALIGN_EPI) { if (wr == 0) PG8_BAR; }
    PG8_BAR;
    if constexpr (Epi::AFTER_DRAIN) { E.fused(acc, cur, wr, wc, fr, fq, lds, wid, lane); S.done(cur); }
#undef PG8_SA
#undef PG8_SB
#undef PG8_STAGE
#undef PG8_LDA
#undef PG8_LDB
#undef PG8_MMA
#undef PG8_WAIT_V
#undef PG8_WAIT_L
#undef PG8_BAR
#undef PG8_SCHED
}
}

#ifndef USE_XB
#define USE_XB 1
#endif
#ifndef MK_MULTI
#define MK_MULTI 0
#endif
namespace mk {
typedef unsigned short bf16;
typedef short bf16x8 __attribute__((ext_vector_type(8)));
typedef float f32x4 __attribute__((ext_vector_type(4)));
typedef unsigned u32x4 __attribute__((ext_vector_type(4)));
typedef unsigned u32x2 __attribute__((ext_vector_type(2)));
#define LAS __attribute__((address_space(3)))
#define XB_TMO      128
#define XB_XCNT(j)  (256  + 64 * (j))
#define XB_XSUB(j)  (1280 + 64 * (j))
#define XB_XGEN(j)  (2304 + 64 * (j))
#define XB_TOP      3328
#define XB_TOPGEN   3392
#define XCD_BAR_WORDS 3456
#define XB_SPIN_CAP (1u << 18)

__device__ __forceinline__ unsigned xb_ld(unsigned* p)              { return __hip_atomic_load(p, __ATOMIC_RELAXED, __HIP_MEMORY_SCOPE_AGENT); }
__device__ __forceinline__ unsigned xb_add(unsigned* p, unsigned v) { return __hip_atomic_fetch_add(p, v, __ATOMIC_RELAXED, __HIP_MEMORY_SCOPE_AGENT); }
__device__ __forceinline__ unsigned xb_xcc_id() { return (unsigned)__builtin_amdgcn_s_getreg((3 << 11) | 20) & 0xFu; }
#define XB_SPIN(cond, bar) do { unsigned _sp = 0; while (cond) { __builtin_amdgcn_s_sleep(1); \
    if ((++_sp & 255u) == 0u) { if (xb_ld(&(bar)[XB_TMO])) break; if (_sp > XB_SPIN_CAP) { atomicAdd(&(bar)[XB_TMO], 1u); break; } } } } while (0)

struct XcdBarrier {
    unsigned* bar; unsigned x;
    volatile LAS unsigned* st;
};

__device__ __forceinline__ XcdBarrier xcd_barrier_post(unsigned* bar, volatile LAS unsigned* st) {
    XcdBarrier b; b.bar = bar; b.x = xb_xcc_id(); b.st = st;
    if (threadIdx.x == 0) (void)xb_add(&bar[XB_XCNT(b.x)], 1u);
    return b;
}
__device__ __forceinline__ void xcd_barrier_complete(unsigned* bar, unsigned x, unsigned& nloc, unsigned& nx) {
    const unsigned G = gridDim.x * gridDim.y * gridDim.z;
    unsigned sum, cnt, mine, sp = 0u;
    for (;;) {
        sum = 0u; cnt = 0u; mine = 0u;
#pragma unroll
        for (unsigned j = 0; j < 16; ++j) { const unsigned c = xb_ld(&bar[XB_XCNT(j)]); sum += c; cnt += (c > 0u) ? 1u : 0u; mine = (j == x) ? c : mine; }
        if (sum == G) break;
        __builtin_amdgcn_s_sleep(1);
        if ((++sp & 255u) == 0u) { if (xb_ld(&bar[XB_TMO])) break; if (sp > XB_SPIN_CAP) { atomicAdd(&bar[XB_TMO], 1u); break; } }
    }
    nloc = mine > 0u ? mine : 1u; nx = cnt > 0u ? cnt : 1u;
}

__device__ __forceinline__ void xcd_barrier(const XcdBarrier& b) {
    asm volatile("s_waitcnt vmcnt(0)" ::: "memory");
    __syncthreads();
    if (threadIdx.x == 0) {
        unsigned* bar = b.bar;
        __builtin_amdgcn_s_waitcnt(0);
        unsigned nloc = b.st[0], nx = b.st[1];
        if (nloc == 0u) { xcd_barrier_complete(bar, b.x, nloc, nx); b.st[0] = nloc; b.st[1] = nx; }
        const unsigned old = xb_add(&bar[XB_XSUB(b.x)], 1u);
        const unsigned gen = old / nloc;
        if (old + 1u == (gen + 1u) * nloc) {
            __builtin_amdgcn_fence(__ATOMIC_RELEASE, "agent");
            asm volatile("s_waitcnt vmcnt(0)" ::: "memory");
            const unsigned og = xb_add(&bar[XB_TOP], 1u);
            const unsigned tg = og / nx;
            if (og + 1u == (tg + 1u) * nx) xb_add(&bar[XB_TOPGEN], 1u);
            else XB_SPIN(xb_ld(&bar[XB_TOPGEN]) == tg, bar);
            __builtin_amdgcn_fence(__ATOMIC_ACQUIRE, "agent");
            xb_add(&bar[XB_XGEN(b.x)], 1u);
            asm volatile("s_waitcnt vmcnt(0)" ::: "memory");
        } else {
            XB_SPIN(xb_ld(&bar[XB_XGEN(b.x)]) == gen, bar);
            __builtin_amdgcn_fence(__ATOMIC_ACQUIRE, "agent");
            asm volatile("s_waitcnt vmcnt(0)" ::: "memory");
        }
    }
    __syncthreads();
}


constexpr int NBATCH = 2, SEQ = 8192, PADL = 112, LP = 8320, M = NBATCH * LP, MA = 17024, D = 1024, DFF = 2816;
constexpr int NCH = 65, NCB = NBATCH * NCH;
constexpr int EVEN_IN = 8240, NIN_PAD = 8448, LPC = 8448;
constexpr float ALPHA = 1.4142135623730951f;
constexpr float LOG2E = 1.4426950408889634f;
constexpr float LAM_INIT = 0.35550906759f;
constexpr float QSCALE = 0.125f * LOG2E;
constexpr int NPH = 26;
constexpr int LDS_BYTES = 132096;

constexpr size_t MiB = 1048576;
constexpr size_t SZ_GU = (size_t)5632 * 1024 * 2, SZ_DN = (size_t)1024 * 2816 * 2;
constexpr size_t WS_GU = 1 * MiB;
constexpr size_t WS_DN = 45 * MiB;
constexpr size_t WS_WIN = 67 * MiB;
constexpr size_t WS_WOUT = WS_WIN + (size_t)NIN_PAD * 1024 * 2;
constexpr size_t WS_WQKV = WS_WOUT + 6 * MiB;
constexpr size_t WS_WO = WS_WQKV + 6 * MiB;
constexpr size_t WS_HS = WS_WO + 2 * MiB;
constexpr size_t WS_HB = WS_HS + 1 * MiB;
constexpr size_t SZ_R1024 = (size_t)MA * 1024 * 2;
constexpr size_t WS_ACT = WS_HB + SZ_R1024;
constexpr size_t WS_K = WS_ACT, WS_VT = WS_ACT + SZ_R1024;
constexpr size_t WS_XT = WS_ACT, WS_BT = WS_ACT + (size_t)MA * 2048 * 2;
constexpr size_t WS_DTF = WS_ACT + (size_t)MA * DFF * 2 + 65536;
constexpr size_t SZ_PERL = (size_t)NCB * 32 * 128 * 4;
constexpr size_t WS_ACUM = WS_DTF + (size_t)MA * 64 * 4;
constexpr size_t WS_SCV = WS_ACUM + SZ_PERL;
constexpr size_t WS_DTV = WS_SCV + SZ_PERL;
constexpr size_t WS_C2 = WS_DTV + SZ_PERL;
constexpr size_t WS_CNAT = WS_C2 + (size_t)32 * LPC * 4;
constexpr size_t WS_END = WS_CNAT + (size_t)MA * 512 * 2;
static_assert(WS_BT + (size_t)NCB * 4 * 128 * 128 * 2 <= WS_DTF, "XT/BT fit in the act region");
constexpr size_t WS_NRM = WS_END;
constexpr size_t WS_END2 = WS_NRM + 4096;
static_assert(WS_END2 <= 256 * MiB, "d_ws map");
constexpr size_t G_YMIX = 0;
constexpr size_t G_XBC = (size_t)MA * 3072 * 2;
constexpr size_t G_ST = G_XBC;
constexpr size_t G_BNAT = G_XBC + (size_t)MA * 3072 * 2;
constexpr size_t G_END = G_BNAT + (size_t)MA * 512 * 2;
constexpr size_t G_DQ = 0, G_DK = SZ_R1024, G_DVT = 2 * SZ_R1024;
static_assert((size_t)NCB * 32 * 64 * 128 * 2 <= (size_t)MA * 3072 * 2, "states fit");
__device__ unsigned char g_scratch[G_END];

__device__ __forceinline__ unsigned f2bf(float f) { unsigned u = __float_as_uint(f); return (u + 0x7fffu + ((u >> 16) & 1u)) >> 16; }
__device__ __forceinline__ float bf2f(unsigned h) { return __uint_as_float(h << 16); }
typedef float f32x2_t __attribute__((ext_vector_type(2))); typedef __bf16 bf16x2_t __attribute__((ext_vector_type(2)));
__device__ __forceinline__ unsigned pk2(float lo, float hi) { f32x2_t v = {lo, hi}; bf16x2_t b = __builtin_convertvector(v, bf16x2_t); return __builtin_bit_cast(unsigned, b); }
__device__ __forceinline__ float bflo(unsigned w) { return __uint_as_float(w << 16); }
__device__ __forceinline__ float bfhi(unsigned w) { return __uint_as_float(w & 0xffff0000u); }
__device__ __forceinline__ float ex2(float x) { return __builtin_amdgcn_exp2f(x); }
__device__ __forceinline__ float siluf(float x) { return x * __builtin_amdgcn_rcpf(1.0f + ex2(-x * LOG2E)); }
__device__ __forceinline__ float wave_sum(float v) {
#pragma unroll
    for (int o = 1; o < 64; o <<= 1) v += __shfl_xor(v, o);
    return v;
}
__device__ __forceinline__ int bidx() { int b = __builtin_amdgcn_workgroup_id_x(); asm volatile("" : "+s"(b)); return b; }
__device__ __forceinline__ int gdim() { int g = (int)__ockl_get_num_groups(0); asm volatile("" : "+s"(g)); return g; }
constexpr float FOX_SKIP_T = 44.0f;
constexpr float ATT_THR = 12.0f;
__device__ __forceinline__ float rowmax4(float m) {
    auto a = __builtin_amdgcn_permlane16_swap(__float_as_uint(m), __float_as_uint(m), false, false);
    m = fmaxf(__uint_as_float(a[0]), __uint_as_float(a[1]));
    auto b = __builtin_amdgcn_permlane32_swap(__float_as_uint(m), __float_as_uint(m), false, false);
    return fmaxf(__uint_as_float(b[0]), __uint_as_float(b[1]));
}
__device__ __forceinline__ bf16x8 mk8(u32x4 v) { return __builtin_bit_cast(bf16x8, v); }
__device__ __forceinline__ f32x4 mfma16(bf16x8 a, bf16x8 b, f32x4 c) { return __builtin_amdgcn_mfma_f32_16x16x32_bf16(a, b, c, 0, 0, 0); }

struct P {
    const float* in[27]; float* out; unsigned char* ws; int ph_lo, ph_hi;
};
__device__ __forceinline__ float* hptr(float* dout, float* hs, int row) {
    const int b = row >= LP ? 1 : 0, p = row - b * LP;
    return p >= 128 ? dout + ((size_t)(b * SEQ + p - 128) << 10) : hs + ((size_t)(b * 128 + p) << 10);
}

struct EpiSwiGLU {
    static constexpr bool PERM = true, AFTER_DRAIN = false;
    bf16* O;
    __device__ __forceinline__ void operator()(const f32x4 (&acc)[2][2][4][2], const pg8::Unit& u, int wr, int wc, int fr, int fq) const {
        const int row0 = u.pm * 256 + wr * 64 + fr, col0 = u.pn * 128 + wc * 32 + 8 * fq;
#pragma unroll
        for (int ai = 0; ai < 2; ++ai)
#pragma unroll
            for (int m = 0; m < 4; ++m) {
                bf16* rowp = O + (size_t)(row0 + ai * 128 + m * 16) * DFF + col0;
                const f32x4 g0 = acc[ai][0][m][0], g1 = acc[ai][0][m][1], u0 = acc[ai][1][m][0], u1 = acc[ai][1][m][1];
                u32x4 w;
                w.x = pk2(siluf(g0[0]) * u0[0], siluf(g0[1]) * u0[1]); w.y = pk2(siluf(g0[2]) * u0[2], siluf(g0[3]) * u0[3]);
                w.z = pk2(siluf(g1[0]) * u1[0], siluf(g1[1]) * u1[1]); w.w = pk2(siluf(g1[2]) * u1[2], siluf(g1[3]) * u1[3]);
                *(u32x4*)rowp = w;
                asm volatile("" ::: "memory");
            }
    }
};
__device__ __forceinline__ u32x4 pack8(const f32x4 a, const f32x4 b, float sc) {
    u32x4 w; w.x = pk2(a[0] * sc, a[1] * sc); w.y = pk2(a[2] * sc, a[3] * sc); w.z = pk2(b[0] * sc, b[1] * sc); w.w = pk2(b[2] * sc, b[3] * sc); return w;
}

struct EpiBranch {
    static constexpr bool PERM = true, AFTER_DRAIN = false;
    bf16* O; float scale;
    __device__ __forceinline__ void operator()(const f32x4 (&acc)[2][2][4][2], const pg8::Unit& u, int wr, int wc, int fr, int fq) const {
        const int row0 = u.pm * 256 + wr * 64 + fr, col0 = u.pn * 256 + wc * 32 + 8 * fq;
#pragma unroll
        for (int ai = 0; ai < 2; ++ai)
#pragma unroll
            for (int m = 0; m < 4; ++m) {
                bf16* rowp = O + (size_t)(row0 + ai * 128 + m * 16) * 1024 + col0;
#pragma unroll
                for (int bj = 0; bj < 2; ++bj) *(u32x4*)(rowp + bj * 128) = pack8(acc[ai][bj][m][0], acc[ai][bj][m][1], scale);
                asm volatile("" ::: "memory");
            }
    }
};
struct EpiSplit {
    static constexpr bool PERM = true, AFTER_DRAIN = false;
    bf16 *A, *B, *C, *Dd, *VT; float* dtf;
    int t_a, t_b, t_c, t_d, t_e; int lda, ldb, ldc, ldd; int ca, cb, cc, cd; int hd_shift, nheads; float qs;
    __device__ __forceinline__ void operator()(const f32x4 (&acc)[2][2][4][2], const pg8::Unit& u, int wr, int wc, int fr, int fq) const {
        const int pn = u.pn, row0 = u.pm * 256 + wr * 64 + fr, cl = wc * 32 + 8 * fq;
        if (pn < t_d) {
            bf16* base; int ld, colt; float sc = 1.f;
            if (pn < t_a) { base = A; ld = lda; colt = ca + pn * 256; }
            else if (pn < t_b) { base = B; ld = ldb; colt = cb + (pn - t_a) * 256; }
            else if (pn < t_c) { base = C; ld = ldc; colt = cc + (pn - t_b) * 256; sc = qs; }
            else { base = Dd; ld = ldd; colt = cd + (pn - t_c) * 256; }
#pragma unroll
            for (int ai = 0; ai < 2; ++ai)
#pragma unroll
                for (int m = 0; m < 4; ++m) {
                    bf16* rowp = base + (size_t)(row0 + ai * 128 + m * 16) * ld + colt + cl;
#pragma unroll
                    for (int bj = 0; bj < 2; ++bj) *(u32x4*)(rowp + bj * 128) = pack8(acc[ai][bj][m][0], acc[ai][bj][m][1], sc);
                    asm volatile("" ::: "memory");
                }
        } else if (pn < t_e) {
            const int hd = 1 << hd_shift;
#pragma unroll
            for (int ai = 0; ai < 2; ++ai)
#pragma unroll
                for (int m = 0; m < 4; ++m) {
                    const int row = row0 + ai * 128 + m * 16, b = row >= LP ? 1 : 0, p = row - b * LP;
#pragma unroll
                    for (int bj = 0; bj < 2; ++bj) {
                        const int c0 = (pn - t_d) * 256 + bj * 128 + cl;
                        bf16* vp = VT + ((size_t)((b * nheads + (c0 >> hd_shift)) * hd + (c0 & (hd - 1)))) * LP + p;
                        const f32x4 v0 = acc[ai][bj][m][0], v1 = acc[ai][bj][m][1];
#pragma unroll
                        for (int i = 0; i < 8; i += 2) {
                            const unsigned ha = f2bf(i < 4 ? v0[i] : v1[i - 4]), hb2 = f2bf(i < 4 ? v0[i + 1] : v1[i - 3]);
                            const bool odd = (fr & 1) != 0;
                            const unsigned recv = (unsigned)__builtin_amdgcn_update_dpp(0, (int)(odd ? ha : hb2), 0xB1, 0xF, 0xF, true);
                            unsigned* dst = (unsigned*)(odd ? vp + (size_t)(i + 1) * LP - 1 : vp + (size_t)i * LP);
                            *dst = odd ? (recv | (hb2 << 16)) : (ha | (recv << 16));
                        }
                    }
                }
        } else {
            if (wc < 2) {
#pragma unroll
                for (int ai = 0; ai < 2; ++ai)
#pragma unroll
                    for (int m = 0; m < 4; ++m) {
                        float* dp = dtf + (size_t)(row0 + ai * 128 + m * 16) * 64 + cl;
                        *(f32x4*)dp = acc[ai][0][m][0]; *(f32x4*)(dp + 4) = acc[ai][0][m][1];
                    }
            }
        }
    }
};

struct TItem { const float* src; bf16* dst; int K, N, n0, k0, drow0, nvalid; };
__device__ __forceinline__ void t_decode(const P& a, unsigned char* ws, int it, TItem& d) {
    constexpr int I_FF = 16 * 88, I_IN = 16 * 258, I_OUT = 48 * 32, I_QKV = 16 * 96;
    int r = it; d.nvalid = 32;
    if (r < 12 * I_FF) {
        const int f = r / (3 * I_FF); r -= f * 3 * I_FF; const int which = r / I_FF; r -= which * I_FF;
        const int layer = f >> 1, ffn = f & 1;
        d.src = a.in[4 + ffn * 3 + which] + (size_t)layer * 1024 * DFF;
        if (which < 2) { const int kb = r / 88, nb = r % 88, c = 32 * nb; d.K = 1024; d.N = DFF; d.n0 = c; d.k0 = 64 * kb; d.dst = (bf16*)(ws + WS_GU + f * SZ_GU); d.drow0 = (c >> 7) * 256 + (c & 127) + which * 128; }
        else { const int kb = r / 32, nb = r % 32; d.K = DFF; d.N = 1024; d.n0 = 32 * nb; d.k0 = 64 * kb; d.dst = (bf16*)(ws + WS_DN + f * SZ_DN); d.drow0 = 32 * nb; }
        return;
    }
    r -= 12 * I_FF;
    if (r < I_IN) { const int kb = r / 258, nb = r % 258, n0 = 32 * nb; int dr;
        if (n0 < 5120) dr = n0; else if (n0 == 5120) dr = 8192; else if (n0 < 8224) dr = n0 - 32; else { dr = 8224; d.nvalid = 16; }
        d.src = a.in[10]; d.K = 1024; d.N = EVEN_IN; d.n0 = n0; d.k0 = 64 * kb; d.dst = (bf16*)(ws + WS_WIN); d.drow0 = dr; return; }
    r -= I_IN;
    if (r < I_OUT) { const int kb = r / 32, nb = r % 32; d.src = a.in[18]; d.K = 3072; d.N = 1024; d.n0 = 32 * nb; d.k0 = 64 * kb; d.dst = (bf16*)(ws + WS_WOUT); d.drow0 = 32 * nb; return; }
    r -= I_OUT;
    if (r < I_QKV) { const int kb = r / 96, nb = r % 96; d.src = a.in[19]; d.K = 1024; d.N = 3072; d.n0 = 32 * nb; d.k0 = 64 * kb; d.dst = (bf16*)(ws + WS_WQKV); d.drow0 = 32 * nb; return; }
    r -= I_QKV;
    { const int kb = r / 32, nb = r % 32; d.src = a.in[25]; d.K = 1024; d.N = 1024; d.n0 = 32 * nb; d.k0 = 64 * kb; d.dst = (bf16*)(ws + WS_WO); d.drow0 = 32 * nb; }
}
__device__ __forceinline__ void t_load(const TItem& d, int lane, float (&v)[32]) {
    const int col = d.n0 + (lane & 31); const bool ok = col < d.N; const float* p = d.src + (size_t)(d.k0 + (lane >> 5)) * d.N + (ok ? col : 0);
#pragma unroll
    for (int i = 0; i < 32; ++i) { const float x = p[(size_t)(2 * i) * d.N]; v[i] = ok ? x : 0.f; }
}
__device__ __forceinline__ void t_store(const TItem& d, int lane, LAS float* scr, const float (&v)[32]) {
#pragma unroll
    for (int i = 0; i < 32; ++i) scr[(2 * i + (lane >> 5)) * 33 + (lane & 31)] = v[i];
    asm volatile("s_waitcnt lgkmcnt(0)" ::: "memory");
    const int c = lane & 7;
#pragma unroll
    for (int j = 0; j < 4; ++j) { const int n = (lane >> 3) + 8 * j; const LAS float* s = scr + (8 * c) * 33 + n;
        u32x4 o; o.x = pk2(s[0 * 33], s[1 * 33]); o.y = pk2(s[2 * 33], s[3 * 33]); o.z = pk2(s[4 * 33], s[5 * 33]); o.w = pk2(s[6 * 33], s[7 * 33]);
        if (n < d.nvalid) *(u32x4*)(d.dst + (size_t)(d.drow0 + n) * d.K + d.k0 + 8 * c) = o; }
    asm volatile("s_waitcnt lgkmcnt(0)" ::: "memory");
}
__device__ __forceinline__ void prologue_phase(const P& a, LAS unsigned char* lds, int wave, int lane) {
    LAS float* scr = (LAS float*)(lds + wave * 16384);
    const int gw = bidx() * 8 + wave, NGW = gdim() * 8;
    unsigned char* ws = a.ws;
    constexpr int NIT = 12 * (16 * 88) + 16 * 258 + 48 * 32 + 16 * 96 + 16 * 32;
    {
        TItem da, db; float va[32], vb[32]; int it = gw;
        if (it < NIT) { t_decode(a, ws, it, da); t_load(da, lane, va); }
        while (it < NIT) {
            if (it + NGW < NIT) { t_decode(a, ws, it + NGW, db); t_load(db, lane, vb); }
            t_store(da, lane, scr, va); it += NGW; if (it >= NIT) break;
            if (it + NGW < NIT) { t_decode(a, ws, it + NGW, da); t_load(da, lane, va); }
            t_store(db, lane, scr, vb); it += NGW;
        }
    }
    { u32x4* z = (u32x4*)(ws + WS_WIN + (size_t)EVEN_IN * 1024 * 2); const int n16 = (NIN_PAD - EVEN_IN) * 1024 * 2 / 16;
      for (int i = gw * 64 + lane; i < n16; i += NGW * 64) z[i] = (u32x4){0u, 0u, 0u, 0u}; }
    float* hs = (float*)(ws + WS_HS); bf16* hb = (bf16*)(ws + WS_HB);
    for (int row = gw; row < M; row += NGW) {
        const int b = row >= LP ? 1 : 0, p = row - b * LP;
        float* hp = hptr(a.out, hs, row); unsigned long long* o8 = (unsigned long long*)(hb + (size_t)row * 1024) + lane;
        if (p < PADL) {
#pragma unroll
            for (int j = 0; j < 4; ++j) { ((f32x4*)hp)[lane + 64 * j] = (f32x4){0.f, 0.f, 0.f, 0.f}; o8[64 * j] = 0ull; }
        } else {
            const float* src = p < 128 ? a.in[1] + (size_t)(p - PADL) * 1024 : a.in[0] + ((size_t)(b * SEQ + p - 128) << 10);
#pragma unroll
            for (int j = 0; j < 4; ++j) { const f32x4 v = ((const f32x4*)src)[lane + 64 * j]; ((f32x4*)hp)[lane + 64 * j] = v * ALPHA;
                o8[64 * j] = (unsigned long long)pk2(v[0], v[1]) | ((unsigned long long)pk2(v[2], v[3]) << 32); }
        }
    }
}

__device__ __forceinline__ void ln_phase(const P& a, const float* gain, const float* bias, bool final_, int wave, int lane, bool dry) {
    const int gw = bidx() * 8 + wave, NGW = gdim() * 8;
    float* hs = (float*)(a.ws + WS_HS); bf16* hb = (bf16*)(a.ws + WS_HB);
    f32x4 g[4], bb[4];
#pragma unroll
    for (int j = 0; j < 4; ++j) { g[j] = ((const f32x4*)gain)[lane + 64 * j]; bb[j] = ((const f32x4*)bias)[lane + 64 * j]; }
    (void)dry;
    for (int r0 = gw; r0 < M; r0 += 2 * NGW) {
        f32x4 v[2][4]; float* hp[2]; bool ok[2];
#pragma unroll
        for (int t = 0; t < 2; ++t) {
            const int row = r0 + t * NGW; const bool in = row < M; const int rr = in ? row : r0;
            const int b = rr >= LP ? 1 : 0, p = rr - b * LP;
            hp[t] = hptr(a.out, hs, rr); ok[t] = in && p >= PADL && !(final_ && p < 128);
            if (in && p < PADL && !final_) {
                unsigned long long* o8 = (unsigned long long*)(hb + (size_t)rr * 1024) + lane;
#pragma unroll
                for (int j = 0; j < 4; ++j) { ((f32x4*)hp[t])[lane + 64 * j] = (f32x4){0.f, 0.f, 0.f, 0.f}; o8[64 * j] = 0ull; }
            }
            { const unsigned long long* m8 = (const unsigned long long*)(hb + (size_t)rr * 1024) + lane;
#pragma unroll
              for (int j = 0; j < 4; ++j) { const unsigned long long mw = m8[64 * j]; const unsigned lo = (unsigned)mw, hi = (unsigned)(mw >> 32);
                  v[t][j] = ((const f32x4*)hp[t])[lane + 64 * j] + (f32x4){bflo(lo), bfhi(lo), bflo(hi), bfhi(hi)}; } }
        }
#pragma unroll
        for (int t = 0; t < 2; ++t) {
            float s = 0.f;
#pragma unroll
            for (int j = 0; j < 4; ++j) s += (v[t][j][0] + v[t][j][1]) + (v[t][j][2] + v[t][j][3]);
            const float mean = wave_sum(s) * (1.f / 1024.f); float s2 = 0.f;
#pragma unroll
            for (int j = 0; j < 4; ++j) { v[t][j] = v[t][j] - mean; s2 += (v[t][j][0] * v[t][j][0] + v[t][j][1] * v[t][j][1]) + (v[t][j][2] * v[t][j][2] + v[t][j][3] * v[t][j][3]); }
            const float rstd = 1.0f / sqrtf(wave_sum(s2) * (1.f / 1024.f) + 1e-5f);
            if (ok[t]) {
                const int row = r0 + t * NGW; unsigned long long* o8 = (unsigned long long*)(hb + (size_t)row * 1024) + lane;
#pragma unroll
                for (int j = 0; j < 4; ++j) { const f32x4 o = v[t][j] * rstd * g[j] + bb[j]; ((f32x4*)hp[t])[lane + 64 * j] = final_ ? o : o * ALPHA;
                    if (!final_) o8[64 * j] = (unsigned long long)pk2(o[0], o[1]) | ((unsigned long long)pk2(o[2], o[3]) << 32); }
            }
        }
    }
}

__device__ __forceinline__ float logsig(float x) { return fminf(x, 0.f) - log1pf(expf(-fabsf(x))); }
__device__ __forceinline__ void c2_phase(const P& a, LAS unsigned char* lds, int tid, int wave, int lane) {
    LAS float* wtot = (LAS float*)lds;
    for (int blk = bidx(); blk < 256; blk += gdim()) {
        const int bh = blk & 31, part = blk >> 5, b = bh >> 4, h = bh & 15;
        const bf16* Yq = (const bf16*)(g_scratch + G_YMIX); const bf16* Kk = (const bf16*)(a.ws + WS_K);
        float mq = 0.f, mkk = 0.f;
        for (int p = part * 1040 + tid; p < (part + 1) * 1040 && p < LP; p += 512) {
            const size_t row = (size_t)b * LP + p;
            const u32x4* qp = (const u32x4*)(Yq + row * 3072 + 2048 + h * 64); const u32x4* kp = (const u32x4*)(Kk + row * 1024 + h * 64);
            float sq = 0.f, sk = 0.f;
#pragma unroll
            for (int i = 0; i < 8; ++i) { const u32x4 v = qp[i], w = kp[i];
                sq += (bflo(v.x) * bflo(v.x) + bfhi(v.x) * bfhi(v.x)) + (bflo(v.y) * bflo(v.y) + bfhi(v.y) * bfhi(v.y)) + (bflo(v.z) * bflo(v.z) + bfhi(v.z) * bfhi(v.z)) + (bflo(v.w) * bflo(v.w) + bfhi(v.w) * bfhi(v.w));
                sk += (bflo(w.x) * bflo(w.x) + bfhi(w.x) * bfhi(w.x)) + (bflo(w.y) * bflo(w.y) + bfhi(w.y) * bfhi(w.y)) + (bflo(w.z) * bflo(w.z) + bfhi(w.z) * bfhi(w.z)) + (bflo(w.w) * bflo(w.w) + bfhi(w.w) * bfhi(w.w)); }
            mq = fmaxf(mq, sq); mkk = fmaxf(mkk, sk);
        }
#pragma unroll
        for (int o = 1; o < 64; o <<= 1) { mq = fmaxf(mq, __shfl_xor(mq, o)); mkk = fmaxf(mkk, __shfl_xor(mkk, o)); }
        __syncthreads();
        if (lane == 0) { wtot[16 + wave] = mq; wtot[32 + wave] = mkk; }
        __syncthreads();
        if (tid == 0) { float x = 0.f, y = 0.f; for (int w = 0; w < 8; ++w) { x = fmaxf(x, wtot[16 + w]); y = fmaxf(y, wtot[32 + w]); }
            float* nr = (float*)(a.ws + WS_NRM) + (bh * 8 + part) * 2; nr[0] = sqrtf(x) * 1.0001f; nr[1] = sqrtf(y) * 1.0001f; }
    }
    __syncthreads();
    if (bidx() >= 32) return;
    const int b = bidx() >> 4, h = bidx() & 15; const float fb = a.in[17][h];
    const float* dtf = (const float*)(a.ws + WS_DTF) + (size_t)b * LP * 64 + 32 + h; float* c2 = (float*)(a.ws + WS_C2) + (size_t)bidx() * LPC;
    const int p0 = tid * 17; float s = 0.f;
    for (int i = 0; i < 17; ++i) { const int p = p0 + i; if (p >= PADL && p < LP) s += logsig(dtf[(size_t)p * 64] + fb); }
    float v = s;
#pragma unroll
    for (int o = 1; o < 64; o <<= 1) { const float t = __shfl_up(v, o); if (lane >= o) v += t; }
    if (lane == 63) wtot[wave] = v;
    __syncthreads();
    float run = v - s; for (int w = 0; w < wave; ++w) run += wtot[w];
    for (int i = 0; i < 17; ++i) { const int p = p0 + i; if (p < LP) { if (p >= PADL) run += logsig(dtf[(size_t)p * 64] + fb); c2[p] = run * LOG2E; } }
}

constexpr int FOX_BUF = 8192 + 8192 + 256;
__device__ __forceinline__ void fox_unit(const P& a, LAS unsigned char* lds, int b, int h, int j, int tid, int wave, int lane, bool dry) {
    const int q0 = 256 * j + 32 * wave;
    const bool active = (q0 < LP) && (q0 + 31 >= PADL);
    const int li = lane & 15, gq = lane >> 4, xr = (li >> 1) & 7;
    bf16* Y = (bf16*)(g_scratch + G_YMIX); const bf16* Kp = (const bf16*)(a.ws + WS_K); const bf16* Vt = (const bf16*)(a.ws + WS_VT);
    const size_t rb = (size_t)b * LP;
    const int srow = tid >> 3, sch = tid & 7;
    const bf16* kg = Kp + (rb + srow) * 1024 + h * 64 + 8 * sch;
    const bf16* vg = Vt + ((size_t)(b * 16 + h) * 64 + srow) * LP + 8 * sch;
    const float* cg = (const float*)(a.ws + WS_C2) + (size_t)(b * 16 + h) * LPC + 4 * (tid & 15);
    const int sof = srow * 128 + ((sch ^ ((srow >> 1) & 7)) << 4);
    bf16x8 bq[2][2];
    if (active) {
#pragma unroll
        for (int qt = 0; qt < 2; ++qt)
#pragma unroll
            for (int ks = 0; ks < 2; ++ks) bq[qt][ks] = *(const bf16x8*)(Y + (rb + q0 + 16 * qt + li) * 3072 + 2048 + h * 64 + 32 * ks + 8 * gq);
    }
    f32x4 O[5][2];
#pragma unroll
    for (int dt = 0; dt < 5; ++dt) { O[dt][0] = (f32x4){0.f, 0.f, 0.f, 0.f}; O[dt][1] = (f32x4){0.f, 0.f, 0.f, 0.f}; }
    float mref[2] = {-1e30f, -1e30f};
    const bf16x8 ones8 = mk8((u32x4){0x3f803f80u, 0x3f803f80u, 0x3f803f80u, 0x3f803f80u});
    int kt_last = 4 * j + 3; kt_last = kt_last > 129 ? 129 : kt_last;
    int kt_first;
    {
        const float* nr = (const float*)(a.ws + WS_NRM) + (b * 16 + h) * 16; float mq = 0.f, mkk = 0.f;
#pragma unroll
        for (int i = 0; i < 8; ++i) { mq = fmaxf(mq, nr[2 * i]); mkk = fmaxf(mkk, nr[2 * i + 1]); }
        const float lim = -(FOX_SKIP_T + 2.0f * mq * mkk);
        const float* c2p = (const float*)(a.ws + WS_C2) + (size_t)(b * 16 + h) * LPC;
        const int q0v = 256 * j > PADL ? 256 * j : PADL; const float cq = c2p[q0v];
        int first = kt_last;
        for (int base = 0; base < 192; base += 64) {
            const int t = base + lane; const int idx = 64 * t + 63 < LP ? 64 * t + 63 : LP - 1;
            const bool okk = (t >= 1) && (t <= kt_last) && (cq - c2p[idx] >= lim);
            const unsigned long long m = __ballot(okk);
            if (m) { first = base + (int)__ffsll((long long)m) - 1; break; }
        }
        kt_first = __builtin_amdgcn_readfirstlane(first);
    }
    u32x4 rk0, rk1, rk2, rv0, rv1, rv2; f32x4 rc0, rc1, rc2;
    const float* cgl = (const float*)(a.ws + WS_C2) + (size_t)(b * 16 + h) * LPC + 4 * (tid & 15);
#define FOX_LOAD(T, RK, RV, RC) do { const int t_ = (T) < kt_last ? (T) : kt_last; RK = *(const u32x4*)(kg + (size_t)(t_ * 64) * 1024); RV = *(const u32x4*)(vg + t_ * 64); RC = *(const f32x4*)(cgl + t_ * 64); } while (0)
#define FOX_WRITE(BUF, RK, RV, RC) do { *(LAS u32x4*)((BUF) + sof) = RK; *(LAS u32x4*)((BUF) + 8192 + sof) = (srow & 1) ? (u32x4){RV.z, RV.w, RV.x, RV.y} : RV; *(LAS f32x4*)((BUF) + 16384 + (tid & 15) * 16) = -(RC); } while (0)
#define FOX_COMPUTE(kt, B) do { \
        const int key0 = kt * 64; \
        if (active && key0 <= q0 + 31) { \
            f32x4 S[4][2]; __builtin_amdgcn_s_setprio(1); \
_Pragma("unroll") \
            for (int k2 = 0; k2 < 4; ++k2) { \
                const LAS unsigned char* kr = B + (16 * k2 + li) * 128; \
                const bf16x8 a0 = *(const LAS bf16x8*)(kr + (((gq) ^ xr) << 4)), a1 = *(const LAS bf16x8*)(kr + (((4 + gq) ^ xr) << 4)); \
                const f32x4 cbn = *(const LAS f32x4*)(B + 16384 + (16 * k2 + 4 * gq) * 4); \
_Pragma("unroll") \
                for (int qt = 0; qt < 2; ++qt) { f32x4 t = mfma16(a0, bq[qt][0], cbn); S[k2][qt] = mfma16(a1, bq[qt][1], t); } \
            } \
            if (kt == 1 || key0 + 63 > q0) { \
_Pragma("unroll") \
                for (int k2 = 0; k2 < 4; ++k2) \
_Pragma("unroll") \
                    for (int qt = 0; qt < 2; ++qt) \
_Pragma("unroll") \
                        for (int r = 0; r < 4; ++r) { const int key = key0 + 16 * k2 + 4 * gq + r, q = q0 + 16 * qt + li; if (key < PADL || key > q) S[k2][qt][r] = -1e30f; } \
            } \
            __builtin_amdgcn_s_setprio(0); float mxq[2]; \
_Pragma("unroll") \
            for (int qt = 0; qt < 2; ++qt) { \
                float mx = fmaxf(fmaxf(S[0][qt][0], S[0][qt][1]), fmaxf(S[0][qt][2], S[0][qt][3])); \
_Pragma("unroll") \
                for (int k2 = 1; k2 < 4; ++k2) mx = fmaxf(mx, fmaxf(fmaxf(S[k2][qt][0], S[k2][qt][1]), fmaxf(S[k2][qt][2], S[k2][qt][3]))); \
                mxq[qt] = rowmax4(mx); \
            } \
            if (__any((mxq[0] > mref[0] + ATT_THR) || (mxq[1] > mref[1] + ATT_THR))) { \
_Pragma("unroll") \
                for (int qt = 0; qt < 2; ++qt) { \
                    const float mn = (mxq[qt] > mref[qt] + ATT_THR) ? mxq[qt] : mref[qt], al = ex2(mref[qt] - mn); mref[qt] = mn; \
_Pragma("unroll") \
                    for (int dt = 0; dt < 5; ++dt) O[dt][qt] = O[dt][qt] * al; \
                } \
            } \
            u32x4 bp[2][2]; \
_Pragma("unroll") \
            for (int qt = 0; qt < 2; ++qt) { \
                const float mn = mref[qt]; \
_Pragma("unroll") \
                for (int k2 = 0; k2 < 4; ++k2) { \
                    const unsigned w0 = pk2(ex2(S[k2][qt][0] - mn), ex2(S[k2][qt][1] - mn)), w1 = pk2(ex2(S[k2][qt][2] - mn), ex2(S[k2][qt][3] - mn)); \
                    if (k2 & 1) { bp[k2 >> 1][qt].z = w0; bp[k2 >> 1][qt].w = w1; } else { bp[k2 >> 1][qt].x = w0; bp[k2 >> 1][qt].y = w1; } } \
            } \
_Pragma("unroll") \
            for (int dt = 0; dt < 4; ++dt) { \
                const LAS unsigned char* vr = B + 8192 + (16 * dt + li) * 128 + 8 * ((gq ^ li) & 1); \
_Pragma("unroll") \
                for (int kh = 0; kh < 2; ++kh) { \
                    const int c = 4 * kh + (gq >> 1); \
                    const u32x2 x0 = *(const LAS u32x2*)(vr + ((c ^ xr) << 4)), x1 = *(const LAS u32x2*)(vr + (((c + 2) ^ xr) << 4)); \
                    const bf16x8 av = mk8((u32x4){x0.x, x0.y, x1.x, x1.y}); \
                    O[dt][0] = mfma16(av, mk8(bp[kh][0]), O[dt][0]); O[dt][1] = mfma16(av, mk8(bp[kh][1]), O[dt][1]); \
                } \
            } \
_Pragma("unroll") \
            for (int kh = 0; kh < 2; ++kh) { O[4][0] = mfma16(ones8, mk8(bp[kh][0]), O[4][0]); O[4][1] = mfma16(ones8, mk8(bp[kh][1]), O[4][1]); } \
        } \
} while (0)
#define FOX_STEP(RK, RV, RC) do { LAS unsigned char* B_ = lds + cur * FOX_BUF; LAS unsigned char* Bn_ = lds + (cur ^ 1) * FOX_BUF; \
        FOX_WRITE(Bn_, RK, RV, RC); FOX_LOAD(kt + 4, RK, RV, RC); FOX_COMPUTE(kt, B_); __syncthreads(); cur ^= 1; } while (0)
    FOX_LOAD(kt_first, rk0, rv0, rc0); FOX_LOAD(kt_first + 1, rk1, rv1, rc1); FOX_LOAD(kt_first + 2, rk2, rv2, rc2);
    FOX_WRITE(lds, rk0, rv0, rc0);
    __syncthreads();
    FOX_LOAD(kt_first + 3, rk0, rv0, rc0);
    { int kt = kt_first, cur = 0;
      for (;;) {
        FOX_STEP(rk1, rv1, rc1); if (++kt > kt_last) break;
        FOX_STEP(rk2, rv2, rc2); if (++kt > kt_last) break;
        FOX_STEP(rk0, rv0, rc0); if (++kt > kt_last) break;
      } }
#undef FOX_STEP
#undef FOX_COMPUTE
#undef FOX_LOAD
#undef FOX_WRITE
    if (active) {
#pragma unroll
        for (int qt = 0; qt < 2; ++qt) {
            const float inv = 1.0f / O[4][qt][0];
            const int q = q0 + 16 * qt + li;
            if (q >= PADL) {
                bf16* op = dry ? (bf16*)(g_scratch + G_BNAT) + ((rb + q) & 8191) * 1024 + h * 64 + 4 * gq : Y + (rb + q) * 3072 + 2048 + h * 64 + 4 * gq;
#pragma unroll
                for (int dt = 0; dt < 4; ++dt) { u32x2 w; w.x = pk2(O[dt][qt][0] * inv, O[dt][qt][1] * inv); w.y = pk2(O[dt][qt][2] * inv, O[dt][qt][3] * inv); *(u32x2*)(op + 16 * dt) = w; }
            }
        }
    }
}
__device__ __forceinline__ void fox_phase(const P& a, LAS unsigned char* lds, int tid, int wave, int lane, bool dry) {
    constexpr int NU = 33 * 32;
    unsigned* counter = (unsigned*)a.ws + 8192;
    volatile LAS unsigned* ctrl = (volatile LAS unsigned*)(lds + 131072);
    for (;;) {
        if (tid == 0) ctrl[32] = atomicAdd(counter, 1u);
        __syncthreads();
        const int u = (int)ctrl[32];
        __syncthreads();
        if (u >= NU) break;
        const int j = 32 - u / 32, bh = u % 32;
        fox_unit(a, lds, bh >> 4, bh & 15, j, tid, wave, lane, dry);
    }
}

constexpr int DIF_BUF = 16384 + 16384;
__device__ __forceinline__ void diff_unit(const P& a, LAS unsigned char* lds, int b, int h, int j, int tid, int wave, int lane, float lam, bool dry) {
    const LAS float* tab = (const LAS float*)(lds + 2 * DIF_BUF);
    const int q0 = 128 * j + 16 * wave;
    const bool active = q0 + 15 >= PADL;
    const int li = lane & 15, gq = lane >> 4, xr = (li >> 1) & 7;
    bf16* Q = (bf16*)(g_scratch + G_DQ); const bf16* Kp = (const bf16*)(g_scratch + G_DK); const bf16* Vt = (const bf16*)(g_scratch + G_DVT);
    const size_t rb = (size_t)b * LP; const int q = q0 + li;
    const int srow = tid >> 3, sch = tid & 7;
    const bf16* kg = Kp + (rb + srow) * 1024 + h * 128 + 8 * sch;
    const bf16* vg = Vt + ((size_t)(b * 8 + h) * 128 + srow) * LP + 8 * sch;
    const int kof0 = srow * 256 + ((sch ^ (srow & 15)) << 4), kof1 = srow * 256 + (((sch + 8) ^ (srow & 15)) << 4);
    const int vof0 = 16384 + srow * 128 + ((sch ^ ((srow >> 1) & 7)) << 4), vof1 = vof0 + 64 * 128;
    bf16x8 bq[2][2];
    if (active) {
#pragma unroll
        for (int cp = 0; cp < 2; ++cp)
#pragma unroll
            for (int ks = 0; ks < 2; ++ks) bq[cp][ks] = *(const bf16x8*)(Q + (rb + q) * 1024 + h * 128 + cp * 64 + 32 * ks + 8 * gq);
    }
    f32x4 O[2][9];
#pragma unroll
    for (int dt = 0; dt < 9; ++dt) { O[0][dt] = (f32x4){0.f, 0.f, 0.f, 0.f}; O[1][dt] = (f32x4){0.f, 0.f, 0.f, 0.f}; }
    float mref[2] = {-1e30f, -1e30f};
    const bf16x8 ones8 = mk8((u32x4){0x3f803f80u, 0x3f803f80u, 0x3f803f80u, 0x3f803f80u});
    const int kt_first = 1, kt_last = 2 * j + 1;
    u32x4 ak0, ak1, av0, av1, bk0, bk1, bv0, bv1;
#define DIF_LOAD(T, K0, K1, V0, V1) do { const int t_ = (T) < kt_last ? (T) : kt_last; const size_t ko_ = (size_t)(t_ * 64) * 1024; K0 = *(const u32x4*)(kg + ko_); K1 = *(const u32x4*)(kg + ko_ + 64); \
        V0 = *(const u32x4*)(vg + t_ * 64); V1 = *(const u32x4*)(vg + (size_t)64 * LP + t_ * 64); } while (0)
#define DIF_WRITE(BUF, K0, K1, V0, V1) do { *(LAS u32x4*)((BUF) + kof0) = K0; *(LAS u32x4*)((BUF) + kof1) = K1; *(LAS u32x4*)((BUF) + vof0) = (srow & 1) ? (u32x4){V0.z, V0.w, V0.x, V0.y} : V0; *(LAS u32x4*)((BUF) + vof1) = (srow & 1) ? (u32x4){V1.z, V1.w, V1.x, V1.y} : V1; } while (0)
#define DIF_COMPUTE(kt, B) do { \
        const int key0 = kt * 64; \
        if (active && key0 <= q0 + 15) { \
            f32x4 S[2][4]; __builtin_amdgcn_s_setprio(1); \
_Pragma("unroll") \
            for (int k2 = 0; k2 < 4; ++k2) { \
                const LAS unsigned char* kr = B + (16 * k2 + li) * 256; \
_Pragma("unroll") \
                for (int cp = 0; cp < 2; ++cp) { \
                    const bf16x8 a0 = *(const LAS bf16x8*)(kr + (((8 * cp + gq) ^ li) << 4)), a1 = *(const LAS bf16x8*)(kr + (((8 * cp + 4 + gq) ^ li) << 4)); \
                    f32x4 t = mfma16(a0, bq[cp][0], (f32x4){0.f, 0.f, 0.f, 0.f}); S[cp][k2] = mfma16(a1, bq[cp][1], t); \
                } \
            } \
            if (kt == 1 || key0 + 63 + 113 > q0) { \
_Pragma("unroll") \
                for (int k2 = 0; k2 < 4; ++k2) \
_Pragma("unroll") \
                    for (int r = 0; r < 4; ++r) { \
                        const int key = key0 + 16 * k2 + 4 * gq + r, n = q - key; \
                        if (n < 0 || key < PADL) { S[0][k2][r] = -1e30f; S[1][k2][r] = -1e30f; } \
                        else { const float bv = tab[n < 127 ? n : 127]; S[0][k2][r] += bv; S[1][k2][r] += bv; } \
                    } \
            } \
            __builtin_amdgcn_s_setprio(0); float mxq[2]; \
_Pragma("unroll") \
            for (int cp = 0; cp < 2; ++cp) { \
                float mx = fmaxf(fmaxf(S[cp][0][0], S[cp][0][1]), fmaxf(S[cp][0][2], S[cp][0][3])); \
_Pragma("unroll") \
                for (int k2 = 1; k2 < 4; ++k2) mx = fmaxf(mx, fmaxf(fmaxf(S[cp][k2][0], S[cp][k2][1]), fmaxf(S[cp][k2][2], S[cp][k2][3]))); \
                mxq[cp] = rowmax4(mx); \
            } \
            if (__any((mxq[0] > mref[0] + ATT_THR) || (mxq[1] > mref[1] + ATT_THR))) { \
_Pragma("unroll") \
                for (int cp = 0; cp < 2; ++cp) { \
                    const float mn = (mxq[cp] > mref[cp] + ATT_THR) ? mxq[cp] : mref[cp], al = ex2(mref[cp] - mn); mref[cp] = mn; \
_Pragma("unroll") \
                    for (int dt = 0; dt < 9; ++dt) O[cp][dt] = O[cp][dt] * al; \
                } \
            } \
            u32x4 bp[2][2]; \
_Pragma("unroll") \
            for (int cp = 0; cp < 2; ++cp) { \
                const float mn = mref[cp]; \
_Pragma("unroll") \
                for (int k2 = 0; k2 < 4; ++k2) { \
                    const unsigned w0 = pk2(ex2(S[cp][k2][0] - mn), ex2(S[cp][k2][1] - mn)), w1 = pk2(ex2(S[cp][k2][2] - mn), ex2(S[cp][k2][3] - mn)); \
                    if (k2 & 1) { bp[cp][k2 >> 1].z = w0; bp[cp][k2 >> 1].w = w1; } else { bp[cp][k2 >> 1].x = w0; bp[cp][k2 >> 1].y = w1; } } \
            } \
_Pragma("unroll") \
            for (int dt = 0; dt < 8; ++dt) { \
                const LAS unsigned char* vr = B + 16384 + (16 * dt + li) * 128 + 8 * ((gq ^ li) & 1); \
_Pragma("unroll") \
                for (int kh = 0; kh < 2; ++kh) { \
                    const int c = 4 * kh + (gq >> 1); \
                    const u32x2 x0 = *(const LAS u32x2*)(vr + ((c ^ xr) << 4)), x1 = *(const LAS u32x2*)(vr + (((c + 2) ^ xr) << 4)); \
                    const bf16x8 av = mk8((u32x4){x0.x, x0.y, x1.x, x1.y}); \
                    O[0][dt] = mfma16(av, mk8(bp[0][kh]), O[0][dt]); O[1][dt] = mfma16(av, mk8(bp[1][kh]), O[1][dt]); \
                } \
            } \
_Pragma("unroll") \
            for (int kh = 0; kh < 2; ++kh) { O[0][8] = mfma16(ones8, mk8(bp[0][kh]), O[0][8]); O[1][8] = mfma16(ones8, mk8(bp[1][kh]), O[1][8]); } \
        } \
} while (0)
#define DIF_STEP(K0, K1, V0, V1) do { LAS unsigned char* B_ = lds + cur * DIF_BUF; LAS unsigned char* Bn_ = lds + (cur ^ 1) * DIF_BUF; \
        DIF_WRITE(Bn_, K0, K1, V0, V1); DIF_LOAD(kt + 3, K0, K1, V0, V1); DIF_COMPUTE(kt, B_); __syncthreads(); cur ^= 1; } while (0)
    DIF_LOAD(kt_first, ak0, ak1, av0, av1); DIF_LOAD(kt_first + 1, bk0, bk1, bv0, bv1);
    DIF_WRITE(lds, ak0, ak1, av0, av1);
    __syncthreads();
    DIF_LOAD(kt_first + 2, ak0, ak1, av0, av1);
    { int kt = kt_first, cur = 0;
      for (;;) {
        DIF_STEP(bk0, bk1, bv0, bv1); if (++kt > kt_last) break;
        DIF_STEP(ak0, ak1, av0, av1); if (++kt > kt_last) break;
      } }
#undef DIF_STEP
#undef DIF_COMPUTE
#undef DIF_LOAD
#undef DIF_WRITE
    if (active) {
        const float i0 = 1.0f / O[0][8][0], i1 = lam / O[1][8][0]; float ss = 0.f;
#pragma unroll
        for (int dt = 0; dt < 8; ++dt) { O[0][dt] = O[0][dt] * i0 - O[1][dt] * i1; ss += (O[0][dt][0] * O[0][dt][0] + O[0][dt][1] * O[0][dt][1]) + (O[0][dt][2] * O[0][dt][2] + O[0][dt][3] * O[0][dt][3]); }
        ss += __shfl_xor(ss, 16); ss += __shfl_xor(ss, 32);
        const float rstd = (1.0f - LAM_INIT) / sqrtf(ss * (1.f / 128.f) + 1e-5f);
        if (q >= PADL) {
            bf16* op = (dry ? (bf16*)(a.ws + WS_ACT) : Q) + (rb + q) * 1024 + h * 128 + 4 * gq; const float* sw = a.in[24] + 4 * gq;
#pragma unroll
            for (int dt = 0; dt < 8; ++dt) { const f32x4 w4 = *(const f32x4*)(sw + 16 * dt); u32x2 w;
                w.x = pk2(O[0][dt][0] * rstd * w4[0], O[0][dt][1] * rstd * w4[1]); w.y = pk2(O[0][dt][2] * rstd * w4[2], O[0][dt][3] * rstd * w4[3]); *(u32x2*)(op + 16 * dt) = w; }
        }
    }
}
__device__ __forceinline__ void diff_phase(const P& a, LAS unsigned char* lds, int tid, int wave, int lane, bool dry) {
    LAS float* tab = (LAS float*)(lds + 2 * DIF_BUF);
    const float s1 = wave_sum(a.in[20][lane] * a.in[21][lane]), s2 = wave_sum(a.in[22][lane] * a.in[23][lane]);
    const float lam = expf(s1) - expf(s2) + LAM_INIT;
    const int G = gdim(), c = bidx(); constexpr int NU = 65 * 16;
    for (int r = 0;; ++r) {
        const int u = (r & 1) ? r * G + (G - 1 - c) : r * G + c;
        if (r * G >= NU) break;
        if (u >= NU) continue;
        const int j = 64 - u / 16, bh = u % 16, h = bh & 7;
        if (tid < 128) { const int n = tid; int bk = n; if (n >= 16) { bk = 16 + (int)(logf((float)n / 16.0f) / 2.0794415416798357f * 16.0f); bk = bk > 31 ? 31 : bk; }
            tab[n] = (a.in[26][bk * 8 + h] - a.in[26][31 * 8 + h]) * LOG2E; }
        diff_unit(a, lds, bh >> 3, h, j, tid, wave, lane, lam, dry);
    }
}


__device__ __forceinline__ void ssd_prep_phase(const P& a, LAS unsigned char* lds, int tid, int wave, int lane) {
    LAS unsigned short* tin = (LAS unsigned short*)lds;
    LAS float* sdt = (LAS float*)(lds + 20480); LAS float* sac = sdt + 128;
    const bf16* xbc = (const bf16*)(g_scratch + G_XBC);
    bf16* XT = (bf16*)(a.ws + WS_XT); bf16* BT = (bf16*)(a.ws + WS_BT); bf16* Bn = (bf16*)(g_scratch + G_BNAT); bf16* Cn = (bf16*)(a.ws + WS_CNAT);
    const float* dtf = (const float*)(a.ws + WS_DTF);
    float* acum = (float*)(a.ws + WS_ACUM); float* scv = (float*)(a.ws + WS_SCV); float* dtv = (float*)(a.ws + WS_DTV);
    const float* cw = a.in[11]; const float* cbias = a.in[12];
    for (int it = bidx(); it < NCB * 48; it += gdim()) {
        const int cbi = it / 48, hb = it % 48, b = cbi / NCH, c = cbi % NCH, row0 = b * LP + c * 128;
        for (int i = tid; i < 131 * 8; i += 512) { const int r = i >> 3, pc = i & 7, prow = c * 128 - 3 + r;
            u32x4 v = (u32x4){0u, 0u, 0u, 0u}; if (prow >= 0) v = *(const u32x4*)(xbc + (size_t)(b * LP + prow) * 3072 + hb * 64 + pc * 8);
            LAS unsigned* d = (LAS unsigned*)(tin + r * 66 + pc * 8); d[0] = v.x; d[1] = v.y; d[2] = v.z; d[3] = v.w; }
        if (hb < 32 && tid < 128) {
            const float raw = dtf[(size_t)(row0 + tid) * 64 + hb] + a.in[13][hb];
            float dt = raw > 20.f ? raw : log1pf(expf(raw));
            if (c == 0 && tid < PADL) dt = 0.f;
            sdt[tid] = dt; sac[tid] = -expf(a.in[14][hb]) * dt;
        }
        __syncthreads();
        if (hb < 32 && wave == 0) {
            const float v0 = sac[2 * lane], v1 = sac[2 * lane + 1], s = v0 + v1; float v = s;
#pragma unroll
            for (int o = 1; o < 64; o <<= 1) { const float t = __shfl_up(v, o); if (lane >= o) v += t; }
            sac[2 * lane] = v - s + v0; sac[2 * lane + 1] = v;
        }
        __syncthreads();
        if (hb < 32 && tid < 128) { const size_t idx = ((size_t)cbi * 32 + hb) * 128 + tid; const float ac = sac[tid], dt = sdt[tid];
            acum[idx] = ac; dtv[idx] = dt; scv[idx] = dt * expf(sac[127] - ac); }
        const int l = tid & 127, cg_ = tid >> 7;
        unsigned pk[8];
#pragma unroll
        for (int cc = 0; cc < 16; cc += 2) {
            float vv[2];
#pragma unroll
            for (int e = 0; e < 2; ++e) { const int ch = cg_ * 16 + cc + e, gch = hb * 64 + ch;
                float acc = cbias[gch];
#pragma unroll
                for (int k = 0; k < 4; ++k) acc += cw[k * 3072 + gch] * bf2f(tin[(l + k) * 66 + ch]);
                vv[e] = siluf(acc); }
            pk[cc >> 1] = pk2(vv[0], vv[1]);
        }
        if (hb < 32) {
            bf16* xt = XT + (((size_t)cbi * 32 + hb) * 64 + cg_ * 16) * 128 + l;
#pragma unroll
            for (int cc = 0; cc < 16; ++cc) xt[(size_t)cc * 128] = (bf16)((cc & 1) ? (pk[cc >> 1] >> 16) : (pk[cc >> 1] & 0xffffu));
        } else {
            const int g = ((hb - 32) & 7) >> 1, n0 = ((hb - 32) & 1) * 64 + cg_ * 16;
            bf16* nat = (hb < 40 ? Bn : Cn) + (size_t)(row0 + l) * 512 + g * 128 + n0;
            *(u32x4*)nat = (u32x4){pk[0], pk[1], pk[2], pk[3]}; *(u32x4*)(nat + 8) = (u32x4){pk[4], pk[5], pk[6], pk[7]};
            if (hb < 40) { bf16* bt = BT + (((size_t)cbi * 4 + g) * 128 + n0) * 128 + l;
#pragma unroll
                for (int cc = 0; cc < 16; ++cc) bt[(size_t)cc * 128] = (bf16)((cc & 1) ? (pk[cc >> 1] >> 16) : (pk[cc >> 1] & 0xffffu)); }
        }
        __syncthreads();
    }
}

__device__ __forceinline__ void ssd_s1_phase(const P& a, int wave, int lane) {
    const int li = lane & 15, gq = lane >> 4;
    const bf16* XT = (const bf16*)(a.ws + WS_XT); const bf16* BT = (const bf16*)(a.ws + WS_BT); const float* scv = (const float*)(a.ws + WS_SCV);
    bf16* ST = (bf16*)(g_scratch + G_ST);
    for (int it = bidx(); it < NCB * 4; it += gdim()) {
        const int cbi = it >> 2, g = it & 3, h = 8 * g + wave;
        const bf16* xth = XT + ((size_t)cbi * 32 + h) * 8192 + li * 128 + 8 * gq; const bf16* btg = BT + ((size_t)cbi * 4 + g) * 16384 + li * 128 + 8 * gq;
        const float* sc = scv + ((size_t)cbi * 32 + h) * 128 + 8 * gq;
        f32x4 acc[4][8];
#pragma unroll
        for (int pt = 0; pt < 4; ++pt)
#pragma unroll
            for (int nt = 0; nt < 8; ++nt) acc[pt][nt] = (f32x4){0.f, 0.f, 0.f, 0.f};
#pragma unroll 1
        for (int ks = 0; ks < 4; ++ks) {
            const f32x4 s0 = *(const f32x4*)(sc + 32 * ks), s1 = *(const f32x4*)(sc + 32 * ks + 4);
            bf16x8 af[4];
#pragma unroll
            for (int pt = 0; pt < 4; ++pt) { const u32x4 w = *(const u32x4*)(xth + pt * 2048 + 32 * ks); u32x4 o;
                o.x = pk2(bflo(w.x) * s0[0], bfhi(w.x) * s0[1]); o.y = pk2(bflo(w.y) * s0[2], bfhi(w.y) * s0[3]);
                o.z = pk2(bflo(w.z) * s1[0], bfhi(w.z) * s1[1]); o.w = pk2(bflo(w.w) * s1[2], bfhi(w.w) * s1[3]); af[pt] = mk8(o); }
#pragma unroll
            for (int nt = 0; nt < 8; ++nt) { const bf16x8 bf = *(const bf16x8*)(btg + nt * 2048 + 32 * ks);
#pragma unroll
                for (int pt = 0; pt < 4; ++pt) acc[pt][nt] = mfma16(af[pt], bf, acc[pt][nt]); }
        }
        bf16* st = ST + ((size_t)cbi * 32 + h) * 8192 + (4 * gq) * 128 + li;
#pragma unroll
        for (int pt = 0; pt < 4; ++pt)
#pragma unroll
            for (int nt = 0; nt < 8; ++nt)
#pragma unroll
                for (int r = 0; r < 4; ++r) st[(16 * pt + r) * 128 + 16 * nt] = (bf16)f2bf(acc[pt][nt][r]);
    }
}
__device__ __forceinline__ void ssd_scan_phase(const P& a, int tid, bool dry) {
    bf16* ST = (bf16*)(g_scratch + G_ST); const float* acum = (const float*)(a.ws + WS_ACUM);
    for (int e = bidx() * 512 + tid; e < 131072; e += gdim() * 512) {
        const int b = e >> 16, r = e & 65535, h = r >> 11, off = (r & 2047) * 4;
        float r0 = 0.f, r1 = 0.f, r2 = 0.f, r3 = 0.f;
        u32x2 nx = *(const u32x2*)(ST + ((size_t)(b * NCH) * 32 + h) * 8192 + off); float nd = acum[((size_t)(b * NCH) * 32 + h) * 128 + 127];
        for (int c = 0; c < NCH; ++c) {
            const size_t cbh = (size_t)(b * NCH + c) * 32 + h; u32x2* p = (u32x2*)(ST + cbh * 8192 + off);
            const u32x2 v = nx; const float dec = expf(nd); if (c + 1 < NCH) { nx = *(const u32x2*)(ST + (cbh + 32) * 8192 + off); nd = acum[(cbh + 32) * 128 + 127]; }
            u32x2 o; o.x = pk2(r0, r1); o.y = pk2(r2, r3); if (!dry) *p = o;
            r0 = r0 * dec + bflo(v.x); r1 = r1 * dec + bfhi(v.x); r2 = r2 * dec + bflo(v.y); r3 = r3 * dec + bfhi(v.y);
        }
    }
}
__device__ __forceinline__ void ssd_s3_phase(const P& a, LAS unsigned char* lds, int wave, int lane, bool dry) {
    LAS float* cbl = (LAS float*)lds;
    LAS float* ssum = (LAS float*)(lds + 69632);
    LAS float* sad = (LAS float*)(lds + 73728) + wave * 256;
    const int li = lane & 15, gq = lane >> 4;
    const bf16* XT = (const bf16*)(a.ws + WS_XT); const bf16* Bn = (const bf16*)(g_scratch + G_BNAT); const bf16* Cn = (const bf16*)(a.ws + WS_CNAT);
    const bf16* ST = (const bf16*)(g_scratch + G_ST); bf16* Y = (bf16*)(g_scratch + G_YMIX);
    const float* acum = (const float*)(a.ws + WS_ACUM); const float* dtv = (const float*)(a.ws + WS_DTV);
    for (int it = bidx(); it < NCB * 8; it += gdim()) {
        const int half = it < NCB * 4 ? 1 : 0, idx = it < NCB * 4 ? it : it - NCB * 4;
        const int cbi = idx >> 2, g = idx & 3, h = 8 * g + wave, b = cbi / NCH, c = cbi % NCH, row0 = b * LP + c * 128;
        const bf16* xth = XT + ((size_t)cbi * 32 + h) * 8192; const bf16* pv = ST + ((size_t)cbi * 32 + h) * 8192 + li * 128 + 8 * gq;
        const bf16* bn = Bn + (size_t)row0 * 512 + g * 128 + 8 * gq; const bf16* cn = Cn + (size_t)row0 * 512 + g * 128 + 8 * gq;
        const float Dh = a.in[15][h];
        { const float* ac = acum + ((size_t)cbi * 32 + h) * 128; const float* dtp = dtv + ((size_t)cbi * 32 + h) * 128;
          sad[lane] = ac[lane]; sad[64 + lane] = ac[64 + lane]; sad[128 + lane] = dtp[lane]; sad[192 + lane] = dtp[64 + lane]; }
        bf16x8 pf[4][4];
#pragma unroll
        for (int pt = 0; pt < 4; ++pt)
#pragma unroll
            for (int ks = 0; ks < 4; ++ks) pf[pt][ks] = *(const bf16x8*)(pv + pt * 2048 + 32 * ks);
        {
            const int lcol = 16 * (4 * half + (wave >> 1)) + li; bf16x8 cf[4];
#pragma unroll
            for (int ks = 0; ks < 4; ++ks) cf[ks] = *(const bf16x8*)(cn + (size_t)lcol * 512 + 32 * ks);
#pragma unroll
            for (int sq = 0; sq < 4; ++sq) { const int st = (wave & 1) * 4 + sq;
                f32x4 acc = (f32x4){0.f, 0.f, 0.f, 0.f};
#pragma unroll
                for (int ks = 0; ks < 4; ++ks) acc = mfma16(*(const bf16x8*)(bn + (size_t)(16 * st + li) * 512 + 32 * ks), cf[ks], acc);
                *(LAS f32x4*)(cbl + lcol * 132 + 16 * st + 4 * gq) = acc;
            }
        }
        __syncthreads();
#pragma unroll 1
        for (int lt = 4 * half; lt < 4 * half + 4; ++lt) {
            const int lcol = 16 * lt + li; const float al = sad[lcol];
            f32x4 yo[4], yd[4];
            {
                bf16x8 cf[4];
#pragma unroll
                for (int ks = 0; ks < 4; ++ks) cf[ks] = *(const bf16x8*)(cn + (size_t)lcol * 512 + 32 * ks);
#pragma unroll
                for (int pt = 0; pt < 4; ++pt) { yo[pt] = (f32x4){0.f, 0.f, 0.f, 0.f}; yd[pt] = (f32x4){0.f, 0.f, 0.f, 0.f};
#pragma unroll
                    for (int ks = 0; ks < 4; ++ks) yo[pt] = mfma16(pf[pt][ks], cf[ks], yo[pt]); }
            }
#pragma unroll 1
            for (int sp = 0; sp <= (lt >> 1); ++sp) {
                const int s0 = 32 * sp + 8 * gq;
                bf16x8 xa[4];
#pragma unroll
                for (int pt = 0; pt < 4; ++pt) xa[pt] = *(const bf16x8*)(xth + (size_t)(16 * pt + li) * 128 + s0);
                const f32x4 c0 = *(const LAS f32x4*)(cbl + lcol * 132 + s0), c1 = *(const LAS f32x4*)(cbl + lcol * 132 + s0 + 4);
                const f32x4 a0 = *(const LAS f32x4*)(sad + s0), a1 = *(const LAS f32x4*)(sad + s0 + 4), d0 = *(const LAS f32x4*)(sad + 128 + s0), d1 = *(const LAS f32x4*)(sad + 128 + s0 + 4);
                float mv[8];
#pragma unroll
                for (int r = 0; r < 4; ++r) { mv[r] = (s0 + r <= lcol) ? c0[r] * ex2((al - a0[r]) * LOG2E) * d0[r] : 0.f; mv[4 + r] = (s0 + 4 + r <= lcol) ? c1[r] * ex2((al - a1[r]) * LOG2E) * d1[r] : 0.f; }
                u32x4 bp; bp.x = pk2(mv[0], mv[1]); bp.y = pk2(mv[2], mv[3]); bp.z = pk2(mv[4], mv[5]); bp.w = pk2(mv[6], mv[7]);
#pragma unroll
                for (int pt = 0; pt < 4; ++pt) yd[pt] = mfma16(xa[pt], mk8(bp), yd[pt]);
            }
            const float eal = ex2(al * LOG2E); float ss = 0.f;
            bf16* yrow = Y + (size_t)(row0 + lcol) * 3072 + h * 64 + 4 * gq;
#pragma unroll
            for (int pt = 0; pt < 4; ++pt) {
                const u32x2 zw = *(const u32x2*)(yrow + 16 * pt); const float z[4] = {bflo(zw.x), bfhi(zw.x), bflo(zw.y), bfhi(zw.y)}; float yg[4];
#pragma unroll
                for (int r = 0; r < 4; ++r) { const float xs = bf2f(xth[(size_t)(16 * pt + 4 * gq + r) * 128 + lcol]);
                    yg[r] = (yd[pt][r] + eal * yo[pt][r] + Dh * xs) * siluf(z[r]); ss += yg[r] * yg[r]; }
                u32x2 w; w.x = pk2(yg[0], yg[1]); w.y = pk2(yg[2], yg[3]); if (!dry) *(u32x2*)(yrow + 16 * pt) = w;
            }
            ss += __shfl_xor(ss, 16); ss += __shfl_xor(ss, 32);
            if (gq == 0) ssum[wave * 128 + lcol] = ss;
        }
        __syncthreads();
#pragma unroll 1
        for (int lt = 4 * half; lt < 4 * half + 4; ++lt) {
            const int lcol = 16 * lt + li; float tot = 0.f;
#pragma unroll
            for (int w = 0; w < 8; ++w) tot += ssum[w * 128 + lcol];
            const float rstd = 1.0f / sqrtf(tot * (1.f / 512.f) + 1e-5f);
            bf16* yrow = Y + (size_t)(row0 + lcol) * 3072 + h * 64 + 4 * gq; const float* nw = a.in[16] + h * 64 + 4 * gq;
#pragma unroll
            for (int pt = 0; pt < 4; ++pt) { const u32x2 yw = *(const u32x2*)(yrow + 16 * pt); const f32x4 w4 = *(const f32x4*)(nw + 16 * pt); u32x2 w;
                w.x = pk2(bflo(yw.x) * rstd * w4[0], bfhi(yw.x) * rstd * w4[1]); w.y = pk2(bflo(yw.y) * rstd * w4[2], bfhi(yw.y) * rstd * w4[3]); if (!dry) *(u32x2*)(yrow + 16 * pt) = w; }
        }
        __syncthreads();
    }
}

template <class Epi> __device__ __forceinline__ void run_gemm(LAS unsigned char* lds, const bf16* A, const bf16* Bt, int N, int K, const Epi& E) {
    pg8::Gemm g{A, Bt, M, N, K, K}; pg8::StaticOrder S; S.init(M, N, gdim(), bidx());
    pg8::gemm_phase<Epi, pg8::StaticOrder, true, true>(lds, g, S, E);
}
__device__ __forceinline__ void thin_resid_tail(LAS unsigned char* lds, const bf16* A, const bf16* Bt, int K, bf16* mout, float scale) {
    int tid = threadIdx.x; asm volatile("" : "+v"(tid));
    const int lane = tid & 63, wave = __builtin_amdgcn_readfirstlane(tid >> 6), li = lane & 15, gq = lane >> 4;
    for (int c = bidx(); c < 256; c += gdim()) {
    const int rt = c >> 4, cgp = c & 15, kw = K >> 3;
    const bf16* xa = A + (size_t)(16 * rt + li) * K + wave * kw + 8 * gq;
    const bf16* wb = Bt + (size_t)(64 * cgp + li) * K + wave * kw + 8 * gq;
    f32x4 acc[4];
#pragma unroll
    for (int nt = 0; nt < 4; ++nt) acc[nt] = (f32x4){0.f, 0.f, 0.f, 0.f};
#pragma unroll 4
    for (int ks = 0; ks < kw; ks += 32) {
        const bf16x8 xf = *(const bf16x8*)(xa + ks);
#pragma unroll
        for (int nt = 0; nt < 4; ++nt) acc[nt] = mfma16(*(const bf16x8*)(wb + (size_t)(16 * nt) * K + ks), xf, acc[nt]);
    }
    LAS f32x4* red = (LAS f32x4*)lds;
#pragma unroll
    for (int nt = 0; nt < 4; ++nt) red[(wave * 4 + nt) * 64 + lane] = acc[nt];
    __syncthreads();
    if (wave < 4) {
        f32x4 sum = red[wave * 64 + lane];
#pragma unroll
        for (int w = 1; w < 8; ++w) sum = sum + red[(w * 4 + wave) * 64 + lane];
        u32x2 w; w.x = pk2(sum[0] * scale, sum[1] * scale); w.y = pk2(sum[2] * scale, sum[3] * scale);
        *(u32x2*)(mout + (size_t)(16384 + 16 * rt + li) * 1024 + 64 * cgp + 16 * wave + 4 * gq) = w;
    }
    __syncthreads();
    }
}
__device__ __forceinline__ void thin_qkv_tail(LAS unsigned char* lds, const bf16* A, const bf16* Bt, bf16* dq, bf16* dk, bf16* dvt) {
    int tid = threadIdx.x; asm volatile("" : "+v"(tid));
    const int lane = tid & 63, wave = __builtin_amdgcn_readfirstlane(tid >> 6), li = lane & 15, gq = lane >> 4;
    for (int c = bidx(); c < 256; c += gdim()) {
        const int rt = c >> 4, cgp = c & 15;
        const bf16* xa = A + (size_t)(16 * rt + li) * 1024 + wave * 128 + 8 * gq;
        const bf16* wb = Bt + (size_t)(192 * cgp + li) * 1024 + wave * 128 + 8 * gq;
        f32x4 acc[12];
#pragma unroll
        for (int nt = 0; nt < 12; ++nt) acc[nt] = (f32x4){0.f, 0.f, 0.f, 0.f};
#pragma unroll 2
        for (int ks = 0; ks < 128; ks += 32) {
            const bf16x8 xf = *(const bf16x8*)(xa + ks);
#pragma unroll
            for (int nt = 0; nt < 12; ++nt) acc[nt] = mfma16(*(const bf16x8*)(wb + (size_t)(16 * nt) * 1024 + ks), xf, acc[nt]);
        }
        LAS f32x4* red = (LAS f32x4*)lds;
#pragma unroll
        for (int nt = 0; nt < 12; ++nt) red[(wave * 12 + nt) * 64 + lane] = acc[nt];
        __syncthreads();
        const int row = 16384 + 16 * rt + li, p = row - LP;
        for (int nt = wave; nt < 12; nt += 8) {
            f32x4 sum = red[nt * 64 + lane];
#pragma unroll
            for (int w = 1; w < 8; ++w) sum = sum + red[(w * 12 + nt) * 64 + lane];
            const int col = 192 * cgp + 16 * nt + 4 * gq;
            if (col < 1024) { u32x2 o; o.x = pk2(sum[0] * QSCALE, sum[1] * QSCALE); o.y = pk2(sum[2] * QSCALE, sum[3] * QSCALE); *(u32x2*)(dq + (size_t)row * 1024 + col) = o; }
            else if (col < 2048) { u32x2 o; o.x = pk2(sum[0], sum[1]); o.y = pk2(sum[2], sum[3]); *(u32x2*)(dk + (size_t)row * 1024 + col - 1024) = o; }
            else { const int cv = col - 2048; bf16* vp = dvt + ((size_t)((8 + (cv >> 7)) * 128 + (cv & 127))) * LP + p;
#pragma unroll
                for (int i = 0; i < 4; i += 2) {
                    const unsigned ha = f2bf(sum[i]), hb2 = f2bf(sum[i + 1]); const bool odd = (li & 1) != 0;
                    const unsigned recv = (unsigned)__builtin_amdgcn_update_dpp(0, (int)(odd ? ha : hb2), 0xB1, 0xF, 0xF, true);
                    unsigned* dst = (unsigned*)(odd ? vp + (size_t)(i + 1) * LP - 1 : vp + (size_t)i * LP);
                    *dst = odd ? (recv | (hb2 << 16)) : (ha | (recv << 16)); } }
        }
        __syncthreads();
    }
}
__device__ __forceinline__ void run_resid_gemm(LAS unsigned char* lds, const bf16* A, const bf16* Bt, int K, bf16* mout, float scale) {
    { EpiBranch E{mout, scale}; pg8::Gemm g{A, Bt, 16384, 1024, K, K}; pg8::StaticOrder S; S.init(16384, 1024, gdim(), bidx());
      pg8::gemm_phase<EpiBranch, pg8::StaticOrder, false, true>(lds, g, S, E); }
    thin_resid_tail(lds, A + (size_t)16384 * K, Bt, K, mout, scale);
}
#define PH_BEGIN(k) if (lo <= (k) && (k) < hi) { \
        const __attribute__((address_space(4))) P* ap_ = (const __attribute__((address_space(4))) P*)__builtin_amdgcn_kernarg_segment_ptr(); asm volatile("" : "+s"(ap_)); \
        const P& a = *(const P*)ap_; int tid = threadIdx.x; asm volatile("" : "+v"(tid)); \
        const int lane = tid & 63, wave = __builtin_amdgcn_readfirstlane(tid >> 6); (void)lane; (void)wave; \
        unsigned char* ws = a.ws; asm volatile("" : "+s"(ws)); unsigned char* gs = g_scratch; asm volatile("" : "+s"(gs)); \
        bf16* hb = (bf16*)(ws + WS_HB); bf16* act = (bf16*)(ws + WS_ACT); float* hs = (float*)(ws + WS_HS); bf16* ymix = (bf16*)(gs + G_YMIX); (void)hb; (void)act; (void)hs; (void)ymix;
#define PH_END(k) if ((k) + 1 < hi) { \
            if (USE_XB) { XcdBarrier xbar; xbar.bar = (unsigned*)ws; xbar.x = xb_xcc_id(); xbar.st = (volatile LAS unsigned*)(lds + 131072) + 8; xcd_barrier(xbar); } \
            else { cg::this_grid().sync(); } } }
#define FFN3(base, f, lnidx, fin) \
    PH_BEGIN(base) { EpiSwiGLU E{act}; run_gemm(lds, hb, (const bf16*)(ws + WS_GU + (f) * SZ_GU), 5632, 1024, E); } PH_END(base) \
    PH_BEGIN((base) + 1) run_resid_gemm(lds, act, (const bf16*)(ws + WS_DN + (f) * SZ_DN), DFF, hb, 0.5f); PH_END((base) + 1) \
    PH_BEGIN((base) + 2) ln_phase(a, a.in[2] + (lnidx) * 1024, a.in[3] + (lnidx) * 1024, fin, wave, lane, false); PH_END((base) + 2)
__global__ void __launch_bounds__(512, 2) mk_fwd(P a_) {
    extern __shared__ __attribute__((aligned(16))) unsigned char lds_raw[];
    LAS unsigned char* lds = (LAS unsigned char*)lds_raw;
    if (threadIdx.x < 64) ((LAS unsigned*)(lds + 131072))[threadIdx.x] = 0u;
    __syncthreads();
    (void)xcd_barrier_post((unsigned*)a_.ws, (volatile LAS unsigned*)(lds + 131072) + 8);
    const int lo = a_.ph_lo, hi = a_.ph_hi;
    if (lo < 0) cg::this_grid().sync();
    PH_BEGIN(0) prologue_phase(a, lds, wave, lane); PH_END(0)
    FFN3(1, 0, 0, false)
    PH_BEGIN(4) {
        EpiSplit E{}; E.A = ymix; E.lda = 3072; E.ca = 0; E.t_a = 8; E.B = (bf16*)(gs + G_XBC); E.ldb = 3072; E.cb = 0; E.t_b = 20;
        E.C = ymix; E.ldc = 3072; E.cc = 2048; E.t_c = 24; E.qs = QSCALE; E.Dd = (bf16*)(ws + WS_K); E.ldd = 1024; E.cd = 0; E.t_d = 28;
        E.VT = (bf16*)(ws + WS_VT); E.t_e = 32; E.hd_shift = 6; E.nheads = 16; E.dtf = (float*)(ws + WS_DTF);
        run_gemm(lds, hb, (const bf16*)(ws + WS_WIN), NIN_PAD, 1024, E); } PH_END(4)
    PH_BEGIN(5) c2_phase(a, lds, tid, wave, lane); PH_END(5)
    PH_BEGIN(6) fox_phase(a, lds, tid, wave, lane, false); PH_END(6)
    PH_BEGIN(7) ssd_prep_phase(a, lds, tid, wave, lane); PH_END(7)
    PH_BEGIN(8) ssd_s1_phase(a, wave, lane); PH_END(8)
    PH_BEGIN(9) ssd_scan_phase(a, tid, false); PH_END(9)
    PH_BEGIN(10) ssd_s3_phase(a, lds, wave, lane, false); PH_END(10)
    PH_BEGIN(11) run_resid_gemm(lds, ymix, (const bf16*)(ws + WS_WOUT), 3072, hb, 1.0f); PH_END(11)
    PH_BEGIN(12) ln_phase(a, a.in[2] + 1 * 1024, a.in[3] + 1 * 1024, false, wave, lane, false); PH_END(12)
    FFN3(13, 1, 2, false)
    FFN3(16, 2, 3, false)
    PH_BEGIN(19) {
        EpiSplit E{}; E.t_a = 0; E.t_b = 0; E.A = E.B = nullptr; E.lda = E.ldb = 0; E.ca = E.cb = 0;
        E.C = (bf16*)(gs + G_DQ); E.ldc = 1024; E.cc = 0; E.t_c = 4; E.qs = QSCALE; E.Dd = (bf16*)(gs + G_DK); E.ldd = 1024; E.cd = 0; E.t_d = 8;
        E.VT = (bf16*)(gs + G_DVT); E.t_e = 12; E.hd_shift = 7; E.nheads = 8; E.dtf = nullptr;
        { pg8::Gemm g{hb, (const bf16*)(ws + WS_WQKV), 16384, 3072, 1024, 1024}; pg8::StaticOrder S; S.init(16384, 3072, gdim(), bidx());
          pg8::gemm_phase<EpiSplit, pg8::StaticOrder, true, true>(lds, g, S, E); }
        thin_qkv_tail(lds, hb + (size_t)16384 * 1024, (const bf16*)(ws + WS_WQKV), (bf16*)(gs + G_DQ), (bf16*)(gs + G_DK), (bf16*)(gs + G_DVT)); } PH_END(19)
    PH_BEGIN(20) diff_phase(a, lds, tid, wave, lane, false); PH_END(20)
    PH_BEGIN(21) run_resid_gemm(lds, (const bf16*)(gs + G_DQ), (const bf16*)(ws + WS_WO), 1024, hb, 1.0f); PH_END(21)
    PH_BEGIN(22) ln_phase(a, a.in[2] + 4 * 1024, a.in[3] + 4 * 1024, false, wave, lane, false); PH_END(22)
    FFN3(23, 3, 5, true)
}
}

extern "C" void kernel_launch(void* const* d_in, const int* in_sizes, int n_in, void* d_out, int out_size, void* d_ws, size_t ws_size, hipStream_t stream) {
    static int grid = 0;
    if (grid == 0) {
        if (n_in != 27 || ws_size < mk::WS_END2) { fprintf(stderr, "kernel_launch: unexpected n_in %d / ws_size %zu (need %zu)\n", n_in, ws_size, (size_t)mk::WS_END2); grid = -1; return; }
        int dev = 0, cus = 0, per_cu = 0;
        hipGetDevice(&dev); hipDeviceGetAttribute(&cus, hipDeviceAttributeMultiprocessorCount, dev);
        if (hipFuncSetAttribute((const void*)mk::mk_fwd, hipFuncAttributeMaxDynamicSharedMemorySize, mk::LDS_BYTES) != hipSuccess) { fprintf(stderr, "kernel_launch: hipFuncSetAttribute failed\n"); grid = -1; return; }
        hipOccupancyMaxActiveBlocksPerMultiprocessor(&per_cu, (const void*)mk::mk_fwd, 512, mk::LDS_BYTES);
        (void)hipGetLastError();
        if (per_cu < 1) fprintf(stderr, "kernel_launch: occupancy query says %d blocks/CU\n", per_cu);
        grid = cus > 0 ? cus : 256;
    }
    if (grid < 0) return;
    if (hipMemsetAsync(d_ws, 0, 65536, stream) != hipSuccess) { fprintf(stderr, "kernel_launch: memset of barrier words failed\n"); return; }
    mk::P a{};
    for (int i = 0; i < 27; ++i) a.in[i] = (const float*)d_in[i];
    a.out = (float*)d_out; a.ws = (unsigned char*)d_ws;
#if MK_MULTI
    for (int ph = 0; ph < mk::NPH; ++ph) { a.ph_lo = ph; a.ph_hi = ph + 1; hipLaunchKernelGGL(mk::mk_fwd, dim3(grid), dim3(512), mk::LDS_BYTES, stream, a); }
#else
    a.ph_lo = 0; a.ph_hi = mk::NPH;
    void* args[] = {&a};
    hipError_t e = hipLaunchCooperativeKernel((const void*)mk::mk_fwd, dim3(grid), dim3(512), args, mk::LDS_BYTES, stream);
    if (e != hipSuccess) fprintf(stderr, "cooperative launch failed: %s (grid %d)\n", hipGetErrorString(e), grid);
#endif
}
```

```cpp
#include <hip/hip_runtime.h>
#include <hip/hip_cooperative_groups.h>
#include <cstdio>
#include <cstdint>
namespace cg = cooperative_groups;
namespace pg8 {
#define PG8_LAS __attribute__((address_space(3)))
typedef unsigned short bf16_t;
typedef short bf16x8 __attribute__((ext_vector_type(8)));
typedef float f32x4 __attribute__((ext_vector_type(4)));
typedef unsigned u32x4 __attribute__((ext_vector_type(4)));
constexpr int BM = 256, BK = 64, HALF = 128, HTB = HALF * BK * 2  , STAGE_BYTES = 8 * HTB, NXCD = 8, WGM = 8;

__host__ __device__ __forceinline__ int lds_byte(int r, int c) { const int st = (r >> 4) * 2 + (c >> 5), rr = r & 15, cc = c & 31, ob = rr * 64 + cc * 2; return st * 1024 + (ob ^ (((ob >> 9) & 1) << 5)); }
__host__ __device__ __forceinline__ void stage_rc(int b, int& R, int& C) { const int st = b / 1024, sb = b % 1024, swz = sb ^ (((sb >> 9) & 1) << 5); R = (st >> 1) * 16 + swz / 64; C = (st & 1) * 32 + (swz % 64) / 2; }
__host__ __device__ __forceinline__ int perm32(int rho) { const int n = rho >> 4, i = rho & 15; return 8 * (i >> 2) + 4 * n + (i & 3); }

struct Unit { int pm, pn; };
struct Gemm { const bf16_t* A; const bf16_t* Bt; int M, N, K, ld; };

struct StaticOrder {
    int nM, nN, nwg, G, c;
    __host__ __device__ void init(int M, int N, int G_, int c_) { nM = M / BM; nN = N / BM; nwg = nM * nN; G = G_; c = c_; }
    __host__ __device__ bool next(int i, Unit& u) const {
        const long L = (long)i * G + c; if (L >= nwg) return false;
        int wgid = (int)L; { const int q = nwg / NXCD, r = nwg % NXCD, xcd = wgid % NXCD, off = wgid / NXCD; wgid = (xcd < r ? xcd * (q + 1) : r * (q + 1) + (xcd - r) * q) + off; }
        const int nig = WGM * nN, gid = wgid / nig, fm = gid * WGM, gsz = (nM - fm) < WGM ? (nM - fm) : WGM;
        u.pm = fm + ((wgid % nig) % gsz); u.pn = (wgid % nig) / gsz; return true;
    }
    __device__ __forceinline__ void a_ready(const Unit&) const {}
    __device__ __forceinline__ void done(const Unit&) const {}
};

__device__ __forceinline__ unsigned cvt_pk_bf16(float lo, float hi) { unsigned r; asm volatile("v_cvt_pk_bf16_f32 %0, %1, %2" : "=v"(r) : "v"(lo), "v"(hi)); return r; }
typedef float f32x2 __attribute__((ext_vector_type(2)));
__device__ __forceinline__ f32x2 gelu_pk(f32x2 v) {
    const f32x2 av = __builtin_elementwise_abs(v), d = av * 0.2316418882f + 1.0f;
    f32x2 t; t.x = __builtin_amdgcn_rcpf(d.x); t.y = __builtin_amdgcn_rcpf(d.y);
    f32x2 q = t * 0.5307027145f + (-0.7265760135f); q = q * t + 0.7107068705f; q = q * t + (-0.142248368f); q = q * t + 0.127414796f; q = q * t;
    const f32x2 s = (v * v) * (-0.72134752044f);
    f32x2 e; e.x = __builtin_amdgcn_exp2f(s.x); e.y = __builtin_amdgcn_exp2f(s.y);
    const f32x2 m = v * (q * e), r = v - m;
    f32x2 o; o.x = v.x < 0.f ? m.x : r.x; o.y = v.y < 0.f ? m.y : r.y; return o;
}

template <int ACT  > struct EpiBf16 {
    static constexpr bool PERM = true, AFTER_DRAIN = false; static_assert(ACT == 0 || ACT == 1, "EpiBf16: ACT is 0 (none) or 1 (gelu_pk)");
    bf16_t* O; int ldc; const float* bias; int split_cols; size_t split_stride; float scale0;
    __device__ __forceinline__ void operator()(const f32x4 (&acc)[2][2][4][2], const Unit& u, int wr, int wc, int fr, int fq) const {
        const int row0 = u.pm * BM + wr * 64 + fr; int colt = u.pn * BM; bf16_t* base = O;
        float sc = 1.f; if (split_cols) { const int t = colt / split_cols; base += (size_t)t * split_stride; colt -= t * split_cols; if (t == 0) sc = scale0; }
        const int col0 = colt + wc * 32 + 8 * fq, bcol0 = u.pn * BM + wc * 32 + 8 * fq;
        f32x4 bv[2][2];
#pragma unroll
        for (int bj = 0; bj < 2; ++bj)
#pragma unroll
            for (int n = 0; n < 2; ++n) bv[bj][n] = bias ? *(const f32x4*)(bias + bcol0 + bj * HALF + 4 * n) : (f32x4){0.f, 0.f, 0.f, 0.f};
#pragma unroll
        for (int ai = 0; ai < 2; ++ai)
#pragma unroll
            for (int m = 0; m < 4; ++m) { bf16_t* rowp = base + (size_t)(row0 + ai * HALF + m * 16) * ldc + col0;
#pragma unroll
                for (int bj = 0; bj < 2; ++bj) { f32x4 v0 = acc[ai][bj][m][0] + bv[bj][0], v1 = acc[ai][bj][m][1] + bv[bj][1];
                    if (ACT == 1) { f32x2 a = gelu_pk((f32x2){v0[0], v0[1]}), b = gelu_pk((f32x2){v0[2], v0[3]}), c = gelu_pk((f32x2){v1[0], v1[1]}), d = gelu_pk((f32x2){v1[2], v1[3]});
                        v0 = (f32x4){a.x, a.y, b.x, b.y}; v1 = (f32x4){c.x, c.y, d.x, d.y}; }
                    v0 = v0 * sc; v1 = v1 * sc; u32x4 w; w.x = cvt_pk_bf16(v0[0], v0[1]); w.y = cvt_pk_bf16(v0[2], v0[3]); w.z = cvt_pk_bf16(v1[0], v1[1]); w.w = cvt_pk_bf16(v1[2], v1[3]);
                    *(u32x4*)(rowp + bj * HALF) = w; } }
    }
};

struct PanelStats {
    unsigned* xbuf;
    unsigned* cnt;
    unsigned* tmo;
    int ntn; float eps;
    unsigned code;
    __device__ __forceinline__ bool run(const f32x4 (&v)[2][2][4][2], const Unit& u, int wr, int wc, int fr, int fq, PG8_LAS unsigned char* lds, int wid, int lane) const {
        typedef float f32x2v __attribute__((ext_vector_type(2)));
        PG8_LAS f32x2v* P = (PG8_LAS f32x2v*)lds;
        PG8_LAS f32x2v* S = (PG8_LAS f32x2v*)(lds + 8192);
        PG8_LAS unsigned* flag = (PG8_LAS unsigned*)(lds + 8192 + 2048);
#pragma unroll
        for (int ai = 0; ai < 2; ++ai)
#pragma unroll
            for (int m = 0; m < 4; ++m) {
                float s = 0.f;
#pragma unroll
                for (int bj = 0; bj < 2; ++bj)
#pragma unroll
                    for (int n = 0; n < 2; ++n) { const f32x4 x = v[ai][bj][m][n]; s += (x[0] + x[1]) + (x[2] + x[3]); }
                s += __shfl_xor(s, 16); s += __shfl_xor(s, 32);
                const float mw = s * (1.0f / 64.0f); float q = 0.f;
#pragma unroll
                for (int bj = 0; bj < 2; ++bj)
#pragma unroll
                    for (int n = 0; n < 2; ++n) { const f32x4 d = v[ai][bj][m][n] - mw; q += (d[0] * d[0] + d[1] * d[1]) + (d[2] * d[2] + d[3] * d[3]); }
                q += __shfl_xor(q, 16); q += __shfl_xor(q, 32);
                if (fq == 0) P[(ai * HALF + wr * 64 + m * 16 + fr) * 4 + wc] = (f32x2v){mw, q};
            }
        asm volatile("s_waitcnt lgkmcnt(0)" ::: "memory"); __builtin_amdgcn_s_barrier(); asm volatile("" ::: "memory");
#if defined(BROKEN_EXCHANGE_NO_WAIT)
#warning BROKEN CONTROL BUILD: the row-statistics exchange does not wait; results are wrong by design
        if (blockIdx.x >= 64) { const long long t0_ = clock64(); while (clock64() - t0_ < 60000) __builtin_amdgcn_s_sleep(8); }
#endif
        const int row = wid * 32 + (lane & 31);
        if (lane < 32) {
            const f32x2v a = P[row * 4 + 0], b = P[row * 4 + 1], c = P[row * 4 + 2], d = P[row * 4 + 3];
            const float mt = (a.x + b.x + c.x + d.x) * 0.25f;
            const float da = a.x - mt, db = b.x - mt, dc = c.x - mt, dd = d.x - mt;
            const float m2 = (a.y + b.y) + (c.y + d.y) + 64.0f * ((da * da + db * db) + (dc * dc + dd * dd));
            unsigned long long* slot = (unsigned long long*)xbuf + ((size_t)(u.pm * BM + row) * 4 + u.pn);
            __hip_atomic_store(slot, ((unsigned long long)__float_as_uint(m2) << 32) | __float_as_uint(mt), __ATOMIC_RELAXED, __HIP_MEMORY_SCOPE_AGENT);
        }
        asm volatile("s_waitcnt vmcnt(0)" ::: "memory");
        if (lane == 0) __hip_atomic_fetch_add(cnt + 64 * u.pm, 1u, __ATOMIC_RELAXED, __HIP_MEMORY_SCOPE_AGENT);
        if (wid == 0) {
            bool dead = false; const unsigned long long t0 = __builtin_amdgcn_s_memrealtime(); const unsigned want = 8u * (unsigned)ntn;
            for (;;) {
#if defined(BROKEN_EXCHANGE_NO_WAIT)
                break;
#endif
                if ((unsigned)__builtin_amdgcn_readfirstlane(__hip_atomic_load(cnt + 64 * u.pm, __ATOMIC_RELAXED, __HIP_MEMORY_SCOPE_AGENT)) >= want) break;
                if (__builtin_amdgcn_s_memrealtime() - t0 > 2000000ull) {
                    if (lane == 0) { unsigned expect = 0u; __hip_atomic_compare_exchange_strong(tmo + 1, &expect, code | (unsigned)(u.pm & 0xff), __ATOMIC_RELAXED, __ATOMIC_RELAXED, __HIP_MEMORY_SCOPE_AGENT);
                                     __hip_atomic_store(tmo, 1u, __ATOMIC_RELAXED, __HIP_MEMORY_SCOPE_AGENT); }
                    dead = true; break; }
                __builtin_amdgcn_s_sleep(2);
            }
            __builtin_amdgcn_fence(__ATOMIC_ACQUIRE, "agent");
            if (lane == 0) flag[0] = dead ? 1u : 0u;
        }
        asm volatile("s_waitcnt vmcnt(0) lgkmcnt(0)" ::: "memory"); __builtin_amdgcn_s_barrier(); asm volatile("" ::: "memory");
        const bool bad = flag[0] != 0u;
        if (lane < 32) {
            const unsigned long long* slot = (const unsigned long long*)xbuf + (size_t)(u.pm * BM + row) * 4; float mt[4], m2[4]; float ms = 0.f;
#pragma unroll
            for (int t = 0; t < 4; ++t) { if (t < ntn) { const unsigned long long w = __hip_atomic_load(slot + t, __ATOMIC_RELAXED, __HIP_MEMORY_SCOPE_AGENT); mt[t] = __uint_as_float((unsigned)w); m2[t] = __uint_as_float((unsigned)(w >> 32)); } else { mt[t] = 0.f; m2[t] = 0.f; } ms += mt[t]; }
            const float mean = ms / (float)ntn; float q = 0.f;
#pragma unroll
            for (int t = 0; t < 4; ++t) if (t < ntn) { const float dm = mt[t] - mean; q += m2[t] + 256.0f * dm * dm; }
            S[row] = (f32x2v){mean, 1.0f / sqrtf(q / (256.0f * (float)ntn) + eps)};
        }
        asm volatile("s_waitcnt lgkmcnt(0)" ::: "memory"); __builtin_amdgcn_s_barrier(); asm volatile("" ::: "memory");
        return bad;
    }
};
struct EpiLnRes {
    static constexpr bool PERM = false, AFTER_DRAIN = true;
    const float* base; float* out; int ldc; const float* bias; PanelStats st; unsigned poison;
    __device__ __forceinline__ void fused(f32x4 (&acc)[2][2][4][2], const Unit& u, int wr, int wc, int fr, int fq, PG8_LAS unsigned char* lds, int wid, int lane) const {
        typedef float f32x2v __attribute__((ext_vector_type(2)));
        const PG8_LAS f32x2v* S = (const PG8_LAS f32x2v*)(lds + 8192);
        const int col0 = u.pn * BM + wc * 32 + 4 * fq;
#pragma unroll
        for (int bj = 0; bj < 2; ++bj)
#pragma unroll
            for (int n = 0; n < 2; ++n) { const f32x4 bv = bias ? *(const f32x4*)(bias + col0 + bj * HALF + n * 16) : (f32x4){0.f, 0.f, 0.f, 0.f};
#pragma unroll
                for (int ai = 0; ai < 2; ++ai)
#pragma unroll
                    for (int m = 0; m < 4; ++m) acc[ai][bj][m][n] += bv; }
        f32x4 pre[4][2][2];
#pragma unroll
        for (int m = 0; m < 4; ++m) { const size_t off = (size_t)(u.pm * BM + wr * 64 + m * 16 + fr) * ldc + col0;
#pragma unroll
            for (int bj = 0; bj < 2; ++bj)
#pragma unroll
                for (int n = 0; n < 2; ++n) pre[m][bj][n] = *(const f32x4*)(base + off + bj * HALF + n * 16); }
        const bool bad = st.run(acc, u, wr, wc, fr, fq, lds, wid, lane) || poison != 0u;
        const float qnan = __builtin_nanf("");
#pragma unroll
        for (int ai = 0; ai < 2; ++ai)
#pragma unroll
            for (int m = 0; m < 4; ++m) { const int r = ai * HALF + wr * 64 + m * 16 + fr; const f32x2v sr = S[r]; const size_t off = (size_t)(u.pm * BM + r) * ldc + col0;
#pragma unroll
                for (int bj = 0; bj < 2; ++bj)
#pragma unroll
                    for (int n = 0; n < 2; ++n) { const f32x4 bs = ai == 0 ? pre[m][bj][n] : *(const f32x4*)(base + off + bj * HALF + n * 16); f32x4 o = bs + (acc[ai][bj][m][n] - sr.x) * sr.y;
                        if (bad) o = (f32x4){qnan, qnan, qnan, qnan}; *(f32x4*)(out + off + bj * HALF + n * 16) = o; }
                if (m & 1) asm volatile("" ::: "memory"); }
    }
};
struct EpiLnResLn {
    static constexpr bool PERM = false, AFTER_DRAIN = true;
    const float* base; float* out; bf16_t* xn; int ldc; const float* bias; PanelStats st1, st2; unsigned poison;
    __device__ __forceinline__ void fused(f32x4 (&acc)[2][2][4][2], const Unit& u, int wr, int wc, int fr, int fq, PG8_LAS unsigned char* lds, int wid, int lane) const {
        typedef float f32x2v __attribute__((ext_vector_type(2))); typedef unsigned u32x2v __attribute__((ext_vector_type(2)));
        const PG8_LAS f32x2v* S = (const PG8_LAS f32x2v*)(lds + 8192);
        const int col0 = u.pn * BM + wc * 32 + 4 * fq;
#pragma unroll
        for (int bj = 0; bj < 2; ++bj)
#pragma unroll
            for (int n = 0; n < 2; ++n) { const f32x4 bv = bias ? *(const f32x4*)(bias + col0 + bj * HALF + n * 16) : (f32x4){0.f, 0.f, 0.f, 0.f};
#pragma unroll
                for (int ai = 0; ai < 2; ++ai)
#pragma unroll
                    for (int m = 0; m < 4; ++m) acc[ai][bj][m][n] += bv; }
        bool bad = st1.run(acc, u, wr, wc, fr, fq, lds, wid, lane) || poison != 0u;
        const float qnan = __builtin_nanf("");
#pragma unroll
        for (int ai = 0; ai < 2; ++ai)
#pragma unroll
            for (int m = 0; m < 4; ++m) { const int r = ai * HALF + wr * 64 + m * 16 + fr; const f32x2v sr = S[r]; const size_t off = (size_t)(u.pm * BM + r) * ldc + col0;
#pragma unroll
                for (int bj = 0; bj < 2; ++bj)
#pragma unroll
                    for (int n = 0; n < 2; ++n) { const f32x4 bs = *(const f32x4*)(base + off + bj * HALF + n * 16); acc[ai][bj][m][n] = bs + (acc[ai][bj][m][n] - sr.x) * sr.y; }
                asm volatile("" : "+v"(acc[ai][0][m][0]), "+v"(acc[ai][0][m][1]), "+v"(acc[ai][1][m][0]), "+v"(acc[ai][1][m][1]));
                if (m & 1) asm volatile("" ::: "memory"); }
        const bool bad1 = bad;
        bad = st2.run(acc, u, wr, wc, fr, fq, lds, wid, lane) || bad;
#pragma unroll
        for (int ai = 0; ai < 2; ++ai)
#pragma unroll
            for (int m = 0; m < 4; ++m) { const int r = ai * HALF + wr * 64 + m * 16 + fr; const f32x2v sr = S[r]; const size_t off = (size_t)(u.pm * BM + r) * ldc + col0;
#pragma unroll
                for (int bj = 0; bj < 2; ++bj)
#pragma unroll
                    for (int n = 0; n < 2; ++n) { const f32x4 x1 = acc[ai][bj][m][n]; *(f32x4*)(out + off + bj * HALF + n * 16) = bad1 ? (f32x4){qnan, qnan, qnan, qnan} : x1;
                        const f32x4 o = (x1 - sr.x) * sr.y; u32x2v w; w.x = cvt_pk_bf16(o[0], o[1]); w.y = cvt_pk_bf16(o[2], o[3]);
                        if (bad) { w.x = 0x7fc07fc0u; w.y = 0x7fc07fc0u; } *(u32x2v*)(xn + off + bj * HALF + n * 16) = w; }
                asm volatile("" ::: "memory"); }
    }
};

template <class Epi, class Sched, bool ALIGN_EPI = false, bool SP2 = false>
__device__ __forceinline__ void gemm_phase(PG8_LAS unsigned char* lds, const Gemm g, const Sched& S, const Epi& E) {
    int tid_raw_ = threadIdx.x; asm volatile("" : "+v"(tid_raw_));
    const int tid = tid_raw_, wid = __builtin_amdgcn_readfirstlane(tid >> 6), lane = tid & 63, wr = wid >> 2, wc = wid & 3, fr = lane & 15, fq = lane >> 4;
    const int K = g.K, nt = K / BK, LD = g.ld;
    unsigned voffA[2], voffB[2];
#pragma unroll
    for (int i = 0; i < 2; ++i) { int R, C; stage_rc(tid * 16 + i * 8192, R, C); const int Rb = Epi::PERM ? ((R & ~31) + perm32(R & 31)) : R;
        voffA[i] = (unsigned)(R * LD + C) * 2u; voffB[i] = (unsigned)(Rb * LD + C) * 2u; }
    const size_t kstep = (size_t)(BK * 2);
    const size_t hstep = (size_t)HALF * LD * 2;
    const size_t tstep = 2 * hstep;
    const unsigned ldsw = (unsigned)wid * 1024u;
    const int aoff = lds_byte(wr * 64 + fr, fq * 8), boff = lds_byte(wc * 32 + fr, fq * 8);
#define PG8_SA(b, h) (((b) * 2 + (h)) * HTB)
#define PG8_SB(b, h) ((4 + (b) * 2 + (h)) * HTB)
#define PG8_STAGE(bufoff, gbase, voff) do { _Pragma("unroll") for (int _i = 0; _i < 2; ++_i) \
        __builtin_amdgcn_global_load_lds((const unsigned*)((const char*)(gbase) + (voff)[_i]), (PG8_LAS unsigned*)(lds + (bufoff) + ldsw + _i * 8192), 16, 0, 0); } while (0)
#define PG8_LDA(dst, b, h) do { _Pragma("unroll") for (int m = 0; m < 4; ++m) _Pragma("unroll") for (int k = 0; k < 2; ++k) dst[m][k] = *(const PG8_LAS bf16x8*)(lds + PG8_SA(b, h) + aoff + m * 2048 + k * 1024); } while (0)
#define PG8_LDB(dst, b, h) do { _Pragma("unroll") for (int n = 0; n < 2; ++n) _Pragma("unroll") for (int k = 0; k < 2; ++k) dst[n][k] = *(const PG8_LAS bf16x8*)(lds + PG8_SB(b, h) + boff + n * 2048 + k * 1024); } while (0)
#define PG8_MMA(ai, bj, At, Bt) do { __builtin_amdgcn_s_setprio(1); _Pragma("unroll") for (int m = 0; m < 4; ++m) _Pragma("unroll") for (int n = 0; n < 2; ++n) _Pragma("unroll") for (int k = 0; k < 2; ++k) \
        acc[ai][bj][m][n] = __builtin_amdgcn_mfma_f32_16x16x32_bf16(Bt[n][k], At[m][k], acc[ai][bj][m][n], 0, 0, 0); __builtin_amdgcn_s_setprio(0); } while (0)
#define PG8_WAIT_V(n) asm volatile("s_waitcnt vmcnt(" #n ")" ::: "memory")
#define PG8_WAIT_L(n) asm volatile("s_waitcnt lgkmcnt(" #n ")" ::: "memory")
#define PG8_BAR __builtin_amdgcn_s_barrier()
#define PG8_SCHED __builtin_amdgcn_sched_barrier(0)
    Unit cur, nxt; int ui = 0;
    if (!S.next(0, cur)) return;
    f32x4 acc[2][2][4][2];
#pragma unroll
    for (int a = 0; a < 2; ++a)
#pragma unroll
        for (int b = 0; b < 2; ++b)
#pragma unroll
            for (int m = 0; m < 4; ++m)
#pragma unroll
                for (int n = 0; n < 2; ++n) acc[a][b][m][n] = (f32x4){0.f, 0.f, 0.f, 0.f};
    bf16x8 At[4][2], B0[2][2], B1[2][2];
    const char* cA = (const char*)g.A + (size_t)cur.pm * tstep; const char* cB = (const char*)g.Bt + (size_t)cur.pn * tstep;
    S.a_ready(cur);
    if constexpr (SP2) {
        PG8_STAGE(PG8_SB(0, 0), cB, voffB); PG8_STAGE(PG8_SB(0, 1), cB + hstep, voffB); PG8_STAGE(PG8_SA(0, 0), cA, voffA); PG8_STAGE(PG8_SA(0, 1), cA + hstep, voffA);
        if (wr == 1) PG8_BAR;
        PG8_WAIT_V(2); PG8_BAR;
        PG8_STAGE(PG8_SB(1, 0), cB + kstep, voffB); PG8_STAGE(PG8_SA(1, 0), cA + kstep, voffA); PG8_STAGE(PG8_SB(1, 1), cB + hstep + kstep, voffB);
        PG8_WAIT_V(6); PG8_BAR;
    } else {
        PG8_STAGE(PG8_SB(0, 0), cB, voffB); PG8_STAGE(PG8_SA(0, 0), cA, voffA); PG8_STAGE(PG8_SB(0, 1), cB + hstep, voffB); PG8_STAGE(PG8_SA(0, 1), cA + hstep, voffA);
        if (wr == 1) PG8_BAR;
        PG8_WAIT_V(4); PG8_BAR;
        PG8_STAGE(PG8_SB(1, 0), cB + kstep, voffB); PG8_STAGE(PG8_SA(1, 0), cA + kstep, voffA); PG8_STAGE(PG8_SB(1, 1), cB + hstep + kstep, voffB);
        PG8_WAIT_V(6); PG8_BAR;
    }
    for (;;) {
        const bool has_next = S.next(ui + 1, nxt);
        const char* nA = has_next ? (const char*)g.A + (size_t)nxt.pm * tstep : cA; const char* nB = has_next ? (const char*)g.Bt + (size_t)nxt.pn * tstep : cB;
        for (int t = 0; t < nt; t += 2) {
            const bool last = (t == nt - 2);
            const char* a1 = cA + (size_t)(t + 1) * kstep;
            const char* a2 = last ? nA : cA + (size_t)(t + 2) * kstep; const char* b2 = last ? nB : cB + (size_t)(t + 2) * kstep;
            const char* a3 = a2 + kstep; const char* b3 = b2 + kstep;
            if (last && has_next) S.a_ready(nxt);
            if constexpr (SP2) {
            PG8_LDB(B0, 0, 0); PG8_LDB(B1, 0, 1); PG8_SCHED; PG8_LDA(At, 0, 0); PG8_STAGE(PG8_SA(1, 1), a1 + hstep, voffA);
            PG8_WAIT_V(8); PG8_WAIT_L(0); PG8_BAR; PG8_MMA(0, 0, At, B0); PG8_MMA(0, 1, At, B1); PG8_BAR; PG8_SCHED;
            PG8_LDA(At, 0, 1); PG8_STAGE(PG8_SB(0, 0), b2, voffB); PG8_STAGE(PG8_SB(0, 1), b2 + hstep, voffB); PG8_STAGE(PG8_SA(0, 0), a2, voffA);
            PG8_WAIT_V(8); PG8_WAIT_L(0); PG8_BAR; PG8_MMA(1, 0, At, B0); PG8_MMA(1, 1, At, B1); PG8_BAR; PG8_SCHED;
            PG8_LDB(B0, 1, 0); PG8_LDB(B1, 1, 1); PG8_SCHED; PG8_LDA(At, 1, 0); PG8_STAGE(PG8_SA(0, 1), a2 + hstep, voffA);
            PG8_WAIT_V(8); PG8_WAIT_L(0); PG8_BAR; PG8_MMA(0, 0, At, B0); PG8_MMA(0, 1, At, B1); PG8_BAR; PG8_SCHED;
            PG8_LDA(At, 1, 1); PG8_STAGE(PG8_SB(1, 0), b3, voffB); PG8_STAGE(PG8_SB(1, 1), b3 + hstep, voffB); PG8_STAGE(PG8_SA(1, 0), a3, voffA);
            PG8_WAIT_V(8); PG8_WAIT_L(0); PG8_BAR; PG8_MMA(1, 0, At, B0); PG8_MMA(1, 1, At, B1); PG8_BAR; PG8_SCHED;
            } else {
            PG8_LDB(B0, 0, 0); PG8_SCHED; PG8_LDA(At, 0, 0); PG8_STAGE(PG8_SA(1, 1), a1 + hstep, voffA);
            PG8_WAIT_L(8); PG8_BAR; PG8_WAIT_L(0); PG8_MMA(0, 0, At, B0); PG8_BAR; PG8_SCHED;
            PG8_LDB(B1, 0, 1); PG8_STAGE(PG8_SB(0, 0), b2, voffB);
            PG8_BAR; PG8_WAIT_L(0); PG8_MMA(0, 1, At, B1); PG8_BAR;
            PG8_LDA(At, 0, 1); PG8_STAGE(PG8_SA(0, 0), a2, voffA);
            PG8_BAR; PG8_WAIT_L(0); PG8_MMA(1, 0, At, B0); PG8_BAR; PG8_SCHED;
            PG8_STAGE(PG8_SB(0, 1), b2 + hstep, voffB);
            PG8_WAIT_V(6); PG8_BAR; PG8_MMA(1, 1, At, B1); PG8_BAR;
            PG8_LDB(B0, 1, 0); PG8_SCHED; PG8_LDA(At, 1, 0); PG8_STAGE(PG8_SA(0, 1), a2 + hstep, voffA);
            PG8_WAIT_L(8); PG8_BAR; PG8_WAIT_L(0); PG8_MMA(0, 0, At, B0); PG8_BAR; PG8_SCHED;
            PG8_LDB(B1, 1, 1); PG8_STAGE(PG8_SB(1, 0), b3, voffB);
            PG8_BAR; PG8_WAIT_L(0); PG8_MMA(0, 1, At, B1); PG8_BAR;
            PG8_LDA(At, 1, 1); PG8_STAGE(PG8_SA(1, 0), a3, voffA);
            PG8_BAR; PG8_WAIT_L(0); PG8_MMA(1, 0, At, B0); PG8_BAR; PG8_SCHED;
            PG8_STAGE(PG8_SB(1, 1), b3 + hstep, voffB);
            PG8_WAIT_V(6); PG8_BAR; PG8_MMA(1, 1, At, B1); PG8_BAR;
            }
        }
        if constexpr (ALIGN_EPI) { if (wr == 0) PG8_BAR; }
        if constexpr (!Epi::AFTER_DRAIN) { E(acc, cur, wr, wc, fr, fq); S.done(cur); }
        if (!has_next) break;
#pragma unroll
        for (int a = 0; a < 2; ++a)
#pragma unroll
            for (int b = 0; b < 2; ++b)
#pragma unroll
                for (int m = 0; m < 4; ++m)
#pragma unroll
                    for (int n = 0; n < 2; ++n) acc[a][b][m][n] = (f32x4){0.f, 0.f, 0.f, 0.f};
        cur = nxt; cA = nA; cB = nB; ++ui;
        if constexpr (ALIGN_EPI) { if (wr == 1) PG8_BAR; }
    }
    PG8_WAIT_V(0);
    if constexpr (!ALIGN_EPI) { if (wr == 0) PG8_BAR; }
    PG8_BAR;
    if constexpr (Epi::AFTER_DRAIN) { E.fused(acc, cur, wr, wc, fr, fq, lds, wid, lane); S.done(cur); }
#undef PG8_SA
#undef PG8_SB
#undef PG8_STAGE
#undef PG8_LDA
#undef PG8_LDB
#undef PG8_MMA
#undef PG8_WAIT_V
#undef PG8_WAIT_L
#undef PG8_BAR
#undef PG8_SCHED
}
}

#ifndef USE_XB
#define USE_XB 1
#endif
#ifndef MK_MULTI
#define MK_MULTI 0
#endif
namespace mk {
typedef unsigned short bf16;
typedef short bf16x8 __attribute__((ext_vector_type(8)));
typedef float f32x4 __attribute__((ext_vector_type(4)));
typedef unsigned u32x4 __attribute__((ext_vector_type(4)));
typedef unsigned u32x2 __attribute__((ext_vector_type(2)));
#define LAS __attribute__((address_space(3)))
#define XB_TMO      128
#define XB_XCNT(j)  (256  + 64 * (j))
#define XB_XSUB(j)  (1280 + 64 * (j))
#define XB_XGEN(j)  (2304 + 64 * (j))
#define XB_TOP      3328
#define XB_TOPGEN   3392
#define XCD_BAR_WORDS 3456
#define XB_SPIN_CAP (1u << 18)

__device__ __forceinline__ unsigned xb_ld(unsigned* p)              { return __hip_atomic_load(p, __ATOMIC_RELAXED, __HIP_MEMORY_SCOPE_AGENT); }
__device__ __forceinline__ unsigned xb_add(unsigned* p, unsigned v) { return __hip_atomic_fetch_add(p, v, __ATOMIC_RELAXED, __HIP_MEMORY_SCOPE_AGENT); }
__device__ __forceinline__ unsigned xb_xcc_id() { return (unsigned)__builtin_amdgcn_s_getreg((3 << 11) | 20) & 0xFu; }
#define XB_SPIN(cond, bar) do { unsigned _sp = 0; while (cond) { __builtin_amdgcn_s_sleep(1); \
    if ((++_sp & 255u) == 0u) { if (xb_ld(&(bar)[XB_TMO])) break; if (_sp > XB_SPIN_CAP) { atomicAdd(&(bar)[XB_TMO], 1u); break; } } } } while (0)

struct XcdBarrier {
    unsigned* bar; unsigned x;
    volatile LAS unsigned* st;
};

__device__ __forceinline__ XcdBarrier xcd_barrier_post(unsigned* bar, volatile LAS unsigned* st) {
    XcdBarrier b; b.bar = bar; b.x = xb_xcc_id(); b.st = st;
    if (threadIdx.x == 0) (void)xb_add(&bar[XB_XCNT(b.x)], 1u);
    return b;
}
__device__ __forceinline__ void xcd_barrier_complete(unsigned* bar, unsigned x, unsigned& nloc, unsigned& nx) {
    const unsigned G = gridDim.x * gridDim.y * gridDim.z;
    unsigned sum, cnt, mine, sp = 0u;
    for (;;) {
        sum = 0u; cnt = 0u; mine = 0u;
#pragma unroll
        for (unsigned j = 0; j < 16; ++j) { const unsigned c = xb_ld(&bar[XB_XCNT(j)]); sum += c; cnt += (c > 0u) ? 1u : 0u; mine = (j == x) ? c : mine; }
        if (sum == G) break;
        __builtin_amdgcn_s_sleep(1);
        if ((++sp & 255u) == 0u) { if (xb_ld(&bar[XB_TMO])) break; if (sp > XB_SPIN_CAP) { atomicAdd(&bar[XB_TMO], 1u); break; } }
    }
    nloc = mine > 0u ? mine : 1u; nx = cnt > 0u ? cnt : 1u;
}

__device__ __forceinline__ void xcd_barrier(const XcdBarrier& b) {
    asm volatile("s_waitcnt vmcnt(0)" ::: "memory");
    __syncthreads();
    if (threadIdx.x == 0) {
        unsigned* bar = b.bar;
        __builtin_amdgcn_s_waitcnt(0);
        unsigned nloc = b.st[0], nx = b.st[1];
        if (nloc == 0u) { xcd_barrier_complete(bar, b.x, nloc, nx); b.st[0] = nloc; b.st[1] = nx; }
        const unsigned old = xb_add(&bar[XB_XSUB(b.x)], 1u);
        const unsigned gen = old / nloc;
        if (old + 1u == (gen + 1u) * nloc) {
            __builtin_amdgcn_fence(__ATOMIC_RELEASE, "agent");
            asm volatile("s_waitcnt vmcnt(0)" ::: "memory");
            const unsigned og = xb_add(&bar[XB_TOP], 1u);
            const unsigned tg = og / nx;
            if (og + 1u == (tg + 1u) * nx) xb_add(&bar[XB_TOPGEN], 1u);
            else XB_SPIN(xb_ld(&bar[XB_TOPGEN]) == tg, bar);
            __builtin_amdgcn_fence(__ATOMIC_ACQUIRE, "agent");
            xb_add(&bar[XB_XGEN(b.x)], 1u);
            asm volatile("s_waitcnt vmcnt(0)" ::: "memory");
        } else {
            XB_SPIN(xb_ld(&bar[XB_XGEN(b.x)]) == gen, bar);
            __builtin_amdgcn_fence(__ATOMIC_ACQUIRE, "agent");
            asm volatile("s_waitcnt vmcnt(0)" ::: "memory");
        }
    }
    __syncthreads();
}


constexpr int NBATCH = 2, SEQ = 8192, PADL = 112, LP = 8320, M = NBATCH * LP, MA = 17024, D = 1024, DFF = 2816;
constexpr int NCH = 65, NCB = NBATCH * NCH;
constexpr int EVEN_IN = 8240, NIN_PAD = 8448, LPC = 8448;
constexpr float ALPHA = 1.4142135623730951f;
constexpr float LOG2E = 1.4426950408889634f;
constexpr float LAM_INIT = 0.35550906759f;
constexpr float QSCALE = 0.125f * LOG2E;
constexpr int NPH = 26;
constexpr int LDS_BYTES = 132096;

constexpr size_t MiB = 1048576;
constexpr size_t SZ_GU = (size_t)5632 * 1024 * 2, SZ_DN = (size_t)1024 * 2816 * 2;
constexpr size_t WS_GU = 1 * MiB;
constexpr size_t WS_DN = 45 * MiB;
constexpr size_t WS_WIN = 67 * MiB;
constexpr size_t WS_WOUT = WS_WIN + (size_t)NIN_PAD * 1024 * 2;
constexpr size_t WS_WQKV = WS_WOUT + 6 * MiB;
constexpr size_t WS_WO = WS_WQKV + 6 * MiB;
constexpr size_t WS_HS = WS_WO + 2 * MiB;
constexpr size_t WS_HB = WS_HS + 1 * MiB;
constexpr size_t SZ_R1024 = (size_t)MA * 1024 * 2;
constexpr size_t WS_ACT = WS_HB + SZ_R1024;
constexpr size_t WS_K = WS_ACT, WS_VT = WS_ACT + SZ_R1024;
constexpr size_t WS_XT = WS_ACT, WS_BT = WS_ACT + (size_t)MA * 2048 * 2;
constexpr size_t WS_DTF = WS_ACT + (size_t)MA * DFF * 2 + 65536;
constexpr size_t SZ_PERL = (size_t)NCB * 32 * 128 * 4;
constexpr size_t WS_ACUM = WS_DTF + (size_t)MA * 64 * 4;
constexpr size_t WS_SCV = WS_ACUM + SZ_PERL;
constexpr size_t WS_DTV = WS_SCV + SZ_PERL;
constexpr size_t WS_C2 = WS_DTV + SZ_PERL;
constexpr size_t WS_CNAT = WS_C2 + (size_t)32 * LPC * 4;
constexpr size_t WS_END = WS_CNAT + (size_t)MA * 512 * 2;
static_assert(WS_BT + (size_t)NCB * 4 * 128 * 128 * 2 <= WS_DTF, "XT/BT fit in the act region");
constexpr size_t WS_NRM = WS_END;
constexpr size_t WS_END2 = WS_NRM + 4096;
static_assert(WS_END2 <= 256 * MiB, "d_ws map");
constexpr size_t G_YMIX = 0;
constexpr size_t G_XBC = (size_t)MA * 3072 * 2;
constexpr size_t G_ST = G_XBC;
constexpr size_t G_BNAT = G_XBC + (size_t)MA * 3072 * 2;
constexpr size_t G_END = G_BNAT + (size_t)MA * 512 * 2;
constexpr size_t G_DQ = 0, G_DK = SZ_R1024, G_DVT = 2 * SZ_R1024;
static_assert((size_t)NCB * 32 * 64 * 128 * 2 <= (size_t)MA * 3072 * 2, "states fit");
__device__ unsigned char g_scratch[G_END];

__device__ __forceinline__ unsigned f2bf(float f) { unsigned u = __float_as_uint(f); return (u + 0x7fffu + ((u >> 16) & 1u)) >> 16; }
__device__ __forceinline__ float bf2f(unsigned h) { return __uint_as_float(h << 16); }
typedef float f32x2_t __attribute__((ext_vector_type(2))); typedef __bf16 bf16x2_t __attribute__((ext_vector_type(2)));
__device__ __forceinline__ unsigned pk2(float lo, float hi) { f32x2_t v = {lo, hi}; bf16x2_t b = __builtin_convertvector(v, bf16x2_t); return __builtin_bit_cast(unsigned, b); }
__device__ __forceinline__ float bflo(unsigned w) { return __uint_as_float(w << 16); }
__device__ __forceinline__ float bfhi(unsigned w) { return __uint_as_float(w & 0xffff0000u); }
__device__ __forceinline__ float ex2(float x) { return __builtin_amdgcn_exp2f(x); }
__device__ __forceinline__ float siluf(float x) { return x * __builtin_amdgcn_rcpf(1.0f + ex2(-x * LOG2E)); }
__device__ __forceinline__ float wave_sum(float v) {
#pragma unroll
    for (int o = 1; o < 64; o <<= 1) v += __shfl_xor(v, o);
    return v;
}
__device__ __forceinline__ int bidx() { int b = __builtin_amdgcn_workgroup_id_x(); asm volatile("" : "+s"(b)); return b; }
__device__ __forceinline__ int gdim() { int g = (int)__ockl_get_num_groups(0); asm volatile("" : "+s"(g)); return g; }
constexpr float FOX_SKIP_T = 44.0f;
constexpr float ATT_THR = 12.0f;
__device__ __forceinline__ float rowmax4(float m) {
    auto a = __builtin_amdgcn_permlane16_swap(__float_as_uint(m), __float_as_uint(m), false, false);
    m = fmaxf(__uint_as_float(a[0]), __uint_as_float(a[1]));
    auto b = __builtin_amdgcn_permlane32_swap(__float_as_uint(m), __float_as_uint(m), false, false);
    return fmaxf(__uint_as_float(b[0]), __uint_as_float(b[1]));
}
__device__ __forceinline__ bf16x8 mk8(u32x4 v) { return __builtin_bit_cast(bf16x8, v); }
__device__ __forceinline__ f32x4 mfma16(bf16x8 a, bf16x8 b, f32x4 c) { return __builtin_amdgcn_mfma_f32_16x16x32_bf16(a, b, c, 0, 0, 0); }

struct P {
    const float* in[27]; float* out; unsigned char* ws; int ph_lo, ph_hi;
};
__device__ __forceinline__ float* hptr(float* dout, float* hs, int row) {
    const int b = row >= LP ? 1 : 0, p = row - b * LP;
    return p >= 128 ? dout + ((size_t)(b * SEQ + p - 128) << 10) : hs + ((size_t)(b * 128 + p) << 10);
}

struct EpiSwiGLU {
    static constexpr bool PERM = true, AFTER_DRAIN = false;
    bf16* O;
    __device__ __forceinline__ void operator()(const f32x4 (&acc)[2][2][4][2], const pg8::Unit& u, int wr, int wc, int fr, int fq) const {
        const int row0 = u.pm * 256 + wr * 64 + fr, col0 = u.pn * 128 + wc * 32 + 8 * fq;
#pragma unroll
        for (int ai = 0; ai < 2; ++ai)
#pragma unroll
            for (int m = 0; m < 4; ++m) {
                bf16* rowp = O + (size_t)(row0 + ai * 128 + m * 16) * DFF + col0;
                const f32x4 g0 = acc[ai][0][m][0], g1 = acc[ai][0][m][1], u0 = acc[ai][1][m][0], u1 = acc[ai][1][m][1];
                u32x4 w;
                w.x = pk2(siluf(g0[0]) * u0[0], siluf(g0[1]) * u0[1]); w.y = pk2(siluf(g0[2]) * u0[2], siluf(g0[3]) * u0[3]);
                w.z = pk2(siluf(g1[0]) * u1[0], siluf(g1[1]) * u1[1]); w.w = pk2(siluf(g1[2]) * u1[2], siluf(g1[3]) * u1[3]);
                *(u32x4*)rowp = w;
                asm volatile("" ::: "memory");
            }
    }
};
__device__ __forceinline__ u32x4 pack8(const f32x4 a, const f32x4 b, float sc) {
    u32x4 w; w.x = pk2(a[0] * sc, a[1] * sc); w.y = pk2(a[2] * sc, a[3] * sc); w.z = pk2(b[0] * sc, b[1] * sc); w.w = pk2(b[2] * sc, b[3] * sc); return w;
}

struct EpiBranch {
    static constexpr bool PERM = true, AFTER_DRAIN = false;
    bf16* O; float scale;
    __device__ __forceinline__ void operator()(const f32x4 (&acc)[2][2][4][2], const pg8::Unit& u, int wr, int wc, int fr, int fq) const {
        const int row0 = u.pm * 256 + wr * 64 + fr, col0 = u.pn * 256 + wc * 32 + 8 * fq;
#pragma unroll
        for (int ai = 0; ai < 2; ++ai)
#pragma unroll
            for (int m = 0; m < 4; ++m) {
                bf16* rowp = O + (size_t)(row0 + ai * 128 + m * 16) * 1024 + col0;
#pragma unroll
                for (int bj = 0; bj < 2; ++bj) *(u32x4*)(rowp + bj * 128) = pack8(acc[ai][bj][m][0], acc[ai][bj][m][1], scale);
                asm volatile("" ::: "memory");
            }
    }
};
struct EpiSplit {
    static constexpr bool PERM = true, AFTER_DRAIN = false;
    bf16 *A, *B, *C, *Dd, *VT; float* dtf;
    int t_a, t_b, t_c, t_d, t_e; int lda, ldb, ldc, ldd; int ca, cb, cc, cd; int hd_shift, nheads; float qs;
    __device__ __forceinline__ void operator()(const f32x4 (&acc)[2][2][4][2], const pg8::Unit& u, int wr, int wc, int fr, int fq) const {
        const int pn = u.pn, row0 = u.pm * 256 + wr * 64 + fr, cl = wc * 32 + 8 * fq;
        if (pn < t_d) {
            bf16* base; int ld, colt; float sc = 1.f;
            if (pn < t_a) { base = A; ld = lda; colt = ca + pn * 256; }
            else if (pn < t_b) { base = B; ld = ldb; colt = cb + (pn - t_a) * 256; }
            else if (pn < t_c) { base = C; ld = ldc; colt = cc + (pn - t_b) * 256; sc = qs; }
            else { base = Dd; ld = ldd; colt = cd + (pn - t_c) * 256; }
#pragma unroll
            for (int ai = 0; ai < 2; ++ai)
#pragma unroll
                for (int m = 0; m < 4; ++m) {
                    bf16* rowp = base + (size_t)(row0 + ai * 128 + m * 16) * ld + colt + cl;
#pragma unroll
                    for (int bj = 0; bj < 2; ++bj) *(u32x4*)(rowp + bj * 128) = pack8(acc[ai][bj][m][0], acc[ai][bj][m][1], sc);
                    asm volatile("" ::: "memory");
                }
        } else if (pn < t_e) {
            const int hd = 1 << hd_shift;
#pragma unroll
            for (int ai = 0; ai < 2; ++ai)
#pragma unroll
                for (int m = 0; m < 4; ++m) {
                    const int row = row0 + ai * 128 + m * 16, b = row >= LP ? 1 : 0, p = row - b * LP;
#pragma unroll
                    for (int bj = 0; bj < 2; ++bj) {
                        const int c0 = (pn - t_d) * 256 + bj * 128 + cl;
                        bf16* vp = VT + ((size_t)((b * nheads + (c0 >> hd_shift)) * hd + (c0 & (hd - 1)))) * LP + p;
                        const f32x4 v0 = acc[ai][bj][m][0], v1 = acc[ai][bj][m][1];
#pragma unroll
                        for (int i = 0; i < 4; ++i) { vp[(size_t)i * LP] = (bf16)f2bf(v0[i]); vp[(size_t)(i + 4) * LP] = (bf16)f2bf(v1[i]); }
                    }
                }
        } else {
            if (wc < 2) {
#pragma unroll
                for (int ai = 0; ai < 2; ++ai)
#pragma unroll
                    for (int m = 0; m < 4; ++m) {
                        float* dp = dtf + (size_t)(row0 + ai * 128 + m * 16) * 64 + cl;
                        *(f32x4*)dp = acc[ai][0][m][0]; *(f32x4*)(dp + 4) = acc[ai][0][m][1];
                    }
            }
        }
    }
};

struct TItem { const float* src; bf16* dst; int K, N, n0, k0, drow0, nvalid; };
__device__ __forceinline__ void t_decode(const P& a, unsigned char* ws, int it, TItem& d) {
    constexpr int I_FF = 16 * 88, I_IN = 16 * 258, I_OUT = 48 * 32, I_QKV = 16 * 96;
    int r = it; d.nvalid = 32;
    if (r < 12 * I_FF) {
        const int f = r / (3 * I_FF); r -= f * 3 * I_FF; const int which = r / I_FF; r -= which * I_FF;
        const int layer = f >> 1, ffn = f & 1;
        d.src = a.in[4 + ffn * 3 + which] + (size_t)layer * 1024 * DFF;
        if (which < 2) { const int kb = r / 88, nb = r % 88, c = 32 * nb; d.K = 1024; d.N = DFF; d.n0 = c; d.k0 = 64 * kb; d.dst = (bf16*)(ws + WS_GU + f * SZ_GU); d.drow0 = (c >> 7) * 256 + (c & 127) + which * 128; }
        else { const int kb = r / 32, nb = r % 32; d.K = DFF; d.N = 1024; d.n0 = 32 * nb; d.k0 = 64 * kb; d.dst = (bf16*)(ws + WS_DN + f * SZ_DN); d.drow0 = 32 * nb; }
        return;
    }
    r -= 12 * I_FF;
    if (r < I_IN) { const int kb = r / 258, nb = r % 258, n0 = 32 * nb; int dr;
        if (n0 < 5120) dr = n0; else if (n0 == 5120) dr = 8192; else if (n0 < 8224) dr = n0 - 32; else { dr = 8224; d.nvalid = 16; }
        d.src = a.in[10]; d.K = 1024; d.N = EVEN_IN; d.n0 = n0; d.k0 = 64 * kb; d.dst = (bf16*)(ws + WS_WIN); d.drow0 = dr; return; }
    r -= I_IN;
    if (r < I_OUT) { const int kb = r / 32, nb = r % 32; d.src = a.in[18]; d.K = 3072; d.N = 1024; d.n0 = 32 * nb; d.k0 = 64 * kb; d.dst = (bf16*)(ws + WS_WOUT); d.drow0 = 32 * nb; return; }
    r -= I_OUT;
    if (r < I_QKV) { const int kb = r / 96, nb = r % 96; d.src = a.in[19]; d.K = 1024; d.N = 3072; d.n0 = 32 * nb; d.k0 = 64 * kb; d.dst = (bf16*)(ws + WS_WQKV); d.drow0 = 32 * nb; return; }
    r -= I_QKV;
    { const int kb = r / 32, nb = r % 32; d.src = a.in[25]; d.K = 1024; d.N = 1024; d.n0 = 32 * nb; d.k0 = 64 * kb; d.dst = (bf16*)(ws + WS_WO); d.drow0 = 32 * nb; }
}
__device__ __forceinline__ void t_load(const TItem& d, int lane, float (&v)[32]) {
    const int col = d.n0 + (lane & 31); const bool ok = col < d.N; const float* p = d.src + (size_t)(d.k0 + (lane >> 5)) * d.N + (ok ? col : 0);
#pragma unroll
    for (int i = 0; i < 32; ++i) { const float x = p[(size_t)(2 * i) * d.N]; v[i] = ok ? x : 0.f; }
}
__device__ __forceinline__ void t_store(const TItem& d, int lane, LAS float* scr, const float (&v)[32]) {
#pragma unroll
    for (int i = 0; i < 32; ++i) scr[(2 * i + (lane >> 5)) * 33 + (lane & 31)] = v[i];
    asm volatile("s_waitcnt lgkmcnt(0)" ::: "memory");
    const int c = lane & 7;
#pragma unroll
    for (int j = 0; j < 4; ++j) { const int n = (lane >> 3) + 8 * j; const LAS float* s = scr + (8 * c) * 33 + n;
        u32x4 o; o.x = pk2(s[0 * 33], s[1 * 33]); o.y = pk2(s[2 * 33], s[3 * 33]); o.z = pk2(s[4 * 33], s[5 * 33]); o.w = pk2(s[6 * 33], s[7 * 33]);
        if (n < d.nvalid) *(u32x4*)(d.dst + (size_t)(d.drow0 + n) * d.K + d.k0 + 8 * c) = o; }
    asm volatile("s_waitcnt lgkmcnt(0)" ::: "memory");
}
__device__ __forceinline__ void prologue_phase(const P& a, LAS unsigned char* lds, int wave, int lane) {
    LAS float* scr = (LAS float*)(lds + wave * 16384);
    const int gw = bidx() * 8 + wave, NGW = gdim() * 8;
    unsigned char* ws = a.ws;
    constexpr int NIT = 12 * (16 * 88) + 16 * 258 + 48 * 32 + 16 * 96 + 16 * 32;
    {
        TItem da, db; float va[32], vb[32]; int it = gw;
        if (it < NIT) { t_decode(a, ws, it, da); t_load(da, lane, va); }
        while (it < NIT) {
            if (it + NGW < NIT) { t_decode(a, ws, it + NGW, db); t_load(db, lane, vb); }
            t_store(da, lane, scr, va); it += NGW; if (it >= NIT) break;
            if (it + NGW < NIT) { t_decode(a, ws, it + NGW, da); t_load(da, lane, va); }
            t_store(db, lane, scr, vb); it += NGW;
        }
    }
    { u32x4* z = (u32x4*)(ws + WS_WIN + (size_t)EVEN_IN * 1024 * 2); const int n16 = (NIN_PAD - EVEN_IN) * 1024 * 2 / 16;
      for (int i = gw * 64 + lane; i < n16; i += NGW * 64) z[i] = (u32x4){0u, 0u, 0u, 0u}; }
    float* hs = (float*)(ws + WS_HS); bf16* hb = (bf16*)(ws + WS_HB);
    for (int row = gw; row < M; row += NGW) {
        const int b = row >= LP ? 1 : 0, p = row - b * LP;
        float* hp = hptr(a.out, hs, row); unsigned long long* o8 = (unsigned long long*)(hb + (size_t)row * 1024) + lane;
        if (p < PADL) {
#pragma unroll
            for (int j = 0; j < 4; ++j) { ((f32x4*)hp)[lane + 64 * j] = (f32x4){0.f, 0.f, 0.f, 0.f}; o8[64 * j] = 0ull; }
        } else {
            const float* src = p < 128 ? a.in[1] + (size_t)(p - PADL) * 1024 : a.in[0] + ((size_t)(b * SEQ + p - 128) << 10);
#pragma unroll
            for (int j = 0; j < 4; ++j) { const f32x4 v = ((const f32x4*)src)[lane + 64 * j]; ((f32x4*)hp)[lane + 64 * j] = v * ALPHA;
                o8[64 * j] = (unsigned long long)pk2(v[0], v[1]) | ((unsigned long long)pk2(v[2], v[3]) << 32); }
        }
    }
}

__device__ __forceinline__ void ln_phase(const P& a, const float* gain, const float* bias, bool final_, int wave, int lane, bool dry) {
    const int gw = bidx() * 8 + wave, NGW = gdim() * 8;
    float* hs = (float*)(a.ws + WS_HS); bf16* hb = (bf16*)(a.ws + WS_HB);
    f32x4 g[4], bb[4];
#pragma unroll
    for (int j = 0; j < 4; ++j) { g[j] = ((const f32x4*)gain)[lane + 64 * j]; bb[j] = ((const f32x4*)bias)[lane + 64 * j]; }
    (void)dry;
    for (int r0 = gw; r0 < M; r0 += 2 * NGW) {
        f32x4 v[2][4]; float* hp[2]; bool ok[2];
#pragma unroll
        for (int t = 0; t < 2; ++t) {
            const int row = r0 + t * NGW; const bool in = row < M; const int rr = in ? row : r0;
            const int b = rr >= LP ? 1 : 0, p = rr - b * LP;
            hp[t] = hptr(a.out, hs, rr); ok[t] = in && p >= PADL && !(final_ && p < 128);
            if (in && p < PADL && !final_) {
                unsigned long long* o8 = (unsigned long long*)(hb + (size_t)rr * 1024) + lane;
#pragma unroll
                for (int j = 0; j < 4; ++j) { ((f32x4*)hp[t])[lane + 64 * j] = (f32x4){0.f, 0.f, 0.f, 0.f}; o8[64 * j] = 0ull; }
            }
            { const unsigned long long* m8 = (const unsigned long long*)(hb + (size_t)rr * 1024) + lane;
#pragma unroll
              for (int j = 0; j < 4; ++j) { const unsigned long long mw = m8[64 * j]; const unsigned lo = (unsigned)mw, hi = (unsigned)(mw >> 32);
                  v[t][j] = ((const f32x4*)hp[t])[lane + 64 * j] + (f32x4){bflo(lo), bfhi(lo), bflo(hi), bfhi(hi)}; } }
        }
#pragma unroll
        for (int t = 0; t < 2; ++t) {
            float s = 0.f;
#pragma unroll
            for (int j = 0; j < 4; ++j) s += (v[t][j][0] + v[t][j][1]) + (v[t][j][2] + v[t][j][3]);
            const float mean = wave_sum(s) * (1.f / 1024.f); float s2 = 0.f;
#pragma unroll
            for (int j = 0; j < 4; ++j) { v[t][j] = v[t][j] - mean; s2 += (v[t][j][0] * v[t][j][0] + v[t][j][1] * v[t][j][1]) + (v[t][j][2] * v[t][j][2] + v[t][j][3] * v[t][j][3]); }
            const float rstd = 1.0f / sqrtf(wave_sum(s2) * (1.f / 1024.f) + 1e-5f);
            if (ok[t]) {
                const int row = r0 + t * NGW; unsigned long long* o8 = (unsigned long long*)(hb + (size_t)row * 1024) + lane;
#pragma unroll
                for (int j = 0; j < 4; ++j) { const f32x4 o = v[t][j] * rstd * g[j] + bb[j]; ((f32x4*)hp[t])[lane + 64 * j] = final_ ? o : o * ALPHA;
                    if (!final_) o8[64 * j] = (unsigned long long)pk2(o[0], o[1]) | ((unsigned long long)pk2(o[2], o[3]) << 32); }
            }
        }
    }
}

__device__ __forceinline__ float logsig(float x) { return fminf(x, 0.f) - log1pf(expf(-fabsf(x))); }
__device__ __forceinline__ void c2_phase(const P& a, LAS unsigned char* lds, int tid, int wave, int lane) {
    LAS float* wtot = (LAS float*)lds;
    for (int blk = bidx(); blk < 256; blk += gdim()) {
        const int bh = blk & 31, part = blk >> 5, b = bh >> 4, h = bh & 15;
        const bf16* Yq = (const bf16*)(g_scratch + G_YMIX); const bf16* Kk = (const bf16*)(a.ws + WS_K);
        float mq = 0.f, mkk = 0.f;
        for (int p = part * 1040 + tid; p < (part + 1) * 1040 && p < LP; p += 512) {
            const size_t row = (size_t)b * LP + p;
            const u32x4* qp = (const u32x4*)(Yq + row * 3072 + 2048 + h * 64); const u32x4* kp = (const u32x4*)(Kk + row * 1024 + h * 64);
            float sq = 0.f, sk = 0.f;
#pragma unroll
            for (int i = 0; i < 8; ++i) { const u32x4 v = qp[i], w = kp[i];
                sq += (bflo(v.x) * bflo(v.x) + bfhi(v.x) * bfhi(v.x)) + (bflo(v.y) * bflo(v.y) + bfhi(v.y) * bfhi(v.y)) + (bflo(v.z) * bflo(v.z) + bfhi(v.z) * bfhi(v.z)) + (bflo(v.w) * bflo(v.w) + bfhi(v.w) * bfhi(v.w));
                sk += (bflo(w.x) * bflo(w.x) + bfhi(w.x) * bfhi(w.x)) + (bflo(w.y) * bflo(w.y) + bfhi(w.y) * bfhi(w.y)) + (bflo(w.z) * bflo(w.z) + bfhi(w.z) * bfhi(w.z)) + (bflo(w.w) * bflo(w.w) + bfhi(w.w) * bfhi(w.w)); }
            mq = fmaxf(mq, sq); mkk = fmaxf(mkk, sk);
        }
#pragma unroll
        for (int o = 1; o < 64; o <<= 1) { mq = fmaxf(mq, __shfl_xor(mq, o)); mkk = fmaxf(mkk, __shfl_xor(mkk, o)); }
        __syncthreads();
        if (lane == 0) { wtot[16 + wave] = mq; wtot[32 + wave] = mkk; }
        __syncthreads();
        if (tid == 0) { float x = 0.f, y = 0.f; for (int w = 0; w < 8; ++w) { x = fmaxf(x, wtot[16 + w]); y = fmaxf(y, wtot[32 + w]); }
            float* nr = (float*)(a.ws + WS_NRM) + (bh * 8 + part) * 2; nr[0] = sqrtf(x) * 1.0001f; nr[1] = sqrtf(y) * 1.0001f; }
    }
    __syncthreads();
    if (bidx() >= 32) return;
    const int b = bidx() >> 4, h = bidx() & 15; const float fb = a.in[17][h];
    const float* dtf = (const float*)(a.ws + WS_DTF) + (size_t)b * LP * 64 + 32 + h; float* c2 = (float*)(a.ws + WS_C2) + (size_t)bidx() * LPC;
    const int p0 = tid * 17; float s = 0.f;
    for (int i = 0; i < 17; ++i) { const int p = p0 + i; if (p >= PADL && p < LP) s += logsig(dtf[(size_t)p * 64] + fb); }
    float v = s;
#pragma unroll
    for (int o = 1; o < 64; o <<= 1) { const float t = __shfl_up(v, o); if (lane >= o) v += t; }
    if (lane == 63) wtot[wave] = v;
    __syncthreads();
    float run = v - s; for (int w = 0; w < wave; ++w) run += wtot[w];
    for (int i = 0; i < 17; ++i) { const int p = p0 + i; if (p < LP) { if (p >= PADL) run += logsig(dtf[(size_t)p * 64] + fb); c2[p] = run * LOG2E; } }
}

constexpr int FOX_BUF = 8192 + 8192 + 256;
__device__ __forceinline__ void fox_unit(const P& a, LAS unsigned char* lds, int b, int h, int j, int tid, int wave, int lane, bool dry) {
    const int q0 = 256 * j + 32 * wave;
    const bool active = (q0 < LP) && (q0 + 31 >= PADL);
    const int li = lane & 15, gq = lane >> 4, xr = (li >> 1) & 7;
    bf16* Y = (bf16*)(g_scratch + G_YMIX); const bf16* Kp = (const bf16*)(a.ws + WS_K); const bf16* Vt = (const bf16*)(a.ws + WS_VT);
    const size_t rb = (size_t)b * LP;
    const int srow = tid >> 3, sch = tid & 7;
    const bf16* kg = Kp + (rb + srow) * 1024 + h * 64 + 8 * sch;
    const bf16* vg = Vt + ((size_t)(b * 16 + h) * 64 + srow) * LP + 8 * sch;
    const float* cg = (const float*)(a.ws + WS_C2) + (size_t)(b * 16 + h) * LPC + 4 * (tid & 15);
    const int sof = srow * 128 + ((sch ^ ((srow >> 1) & 7)) << 4);
    bf16x8 bq[2][2];
    if (active) {
#pragma unroll
        for (int qt = 0; qt < 2; ++qt)
#pragma unroll
            for (int ks = 0; ks < 2; ++ks) bq[qt][ks] = *(const bf16x8*)(Y + (rb + q0 + 16 * qt + li) * 3072 + 2048 + h * 64 + 32 * ks + 8 * gq);
    }
    f32x4 O[5][2];
#pragma unroll
    for (int dt = 0; dt < 5; ++dt) { O[dt][0] = (f32x4){0.f, 0.f, 0.f, 0.f}; O[dt][1] = (f32x4){0.f, 0.f, 0.f, 0.f}; }
    float mref[2] = {-1e30f, -1e30f};
    const bf16x8 ones8 = mk8((u32x4){0x3f803f80u, 0x3f803f80u, 0x3f803f80u, 0x3f803f80u});
    int kt_last = 4 * j + 3; kt_last = kt_last > 129 ? 129 : kt_last;
    int kt_first;
    {
        const float* nr = (const float*)(a.ws + WS_NRM) + (b * 16 + h) * 16; float mq = 0.f, mkk = 0.f;
#pragma unroll
        for (int i = 0; i < 8; ++i) { mq = fmaxf(mq, nr[2 * i]); mkk = fmaxf(mkk, nr[2 * i + 1]); }
        const float lim = -(FOX_SKIP_T + 2.0f * mq * mkk);
        const float* c2p = (const float*)(a.ws + WS_C2) + (size_t)(b * 16 + h) * LPC;
        const int q0v = 256 * j > PADL ? 256 * j : PADL; const float cq = c2p[q0v];
        int first = kt_last;
        for (int base = 0; base < 192; base += 64) {
            const int t = base + lane; const int idx = 64 * t + 63 < LP ? 64 * t + 63 : LP - 1;
            const bool okk = (t >= 1) && (t <= kt_last) && (cq - c2p[idx] >= lim);
            const unsigned long long m = __ballot(okk);
            if (m) { first = base + (int)__ffsll((long long)m) - 1; break; }
        }
        kt_first = __builtin_amdgcn_readfirstlane(first);
    }
    u32x4 rk0, rk1, rk2, rv0, rv1, rv2; f32x4 rc0, rc1, rc2;
    const float* cgl = (const float*)(a.ws + WS_C2) + (size_t)(b * 16 + h) * LPC + 4 * (tid & 15);
#define FOX_LOAD(T, RK, RV, RC) do { const int t_ = (T) < kt_last ? (T) : kt_last; RK = *(const u32x4*)(kg + (size_t)(t_ * 64) * 1024); RV = *(const u32x4*)(vg + t_ * 64); RC = *(const f32x4*)(cgl + t_ * 64); } while (0)
#define FOX_WRITE(BUF, RK, RV, RC) do { *(LAS u32x4*)((BUF) + sof) = RK; *(LAS u32x4*)((BUF) + 8192 + sof) = (srow & 1) ? (u32x4){RV.z, RV.w, RV.x, RV.y} : RV; *(LAS f32x4*)((BUF) + 16384 + (tid & 15) * 16) = -(RC); } while (0)
#define FOX_COMPUTE(kt, B) do { \
        const int key0 = kt * 64; \
        if (active && key0 <= q0 + 31) { \
            f32x4 S[4][2]; __builtin_amdgcn_s_setprio(1); \
_Pragma("unroll") \
            for (int k2 = 0; k2 < 4; ++k2) { \
                const LAS unsigned char* kr = B + (16 * k2 + li) * 128; \
                const bf16x8 a0 = *(const LAS bf16x8*)(kr + (((gq) ^ xr) << 4)), a1 = *(const LAS bf16x8*)(kr + (((4 + gq) ^ xr) << 4)); \
                const f32x4 cbn = *(const LAS f32x4*)(B + 16384 + (16 * k2 + 4 * gq) * 4); \
_Pragma("unroll") \
                for (int qt = 0; qt < 2; ++qt) { f32x4 t = mfma16(a0, bq[qt][0], cbn); S[k2][qt] = mfma16(a1, bq[qt][1], t); } \
            } \
            if (kt == 1 || key0 + 63 > q0) { \
_Pragma("unroll") \
                for (int k2 = 0; k2 < 4; ++k2) \
_Pragma("unroll") \
                    for (int qt = 0; qt < 2; ++qt) \
_Pragma("unroll") \
                        for (int r = 0; r < 4; ++r) { const int key = key0 + 16 * k2 + 4 * gq + r, q = q0 + 16 * qt + li; if (key < PADL || key > q) S[k2][qt][r] = -1e30f; } \
            } \
            __builtin_amdgcn_s_setprio(0); float mxq[2]; \
_Pragma("unroll") \
            for (int qt = 0; qt < 2; ++qt) { \
                float mx = fmaxf(fmaxf(S[0][qt][0], S[0][qt][1]), fmaxf(S[0][qt][2], S[0][qt][3])); \
_Pragma("unroll") \
                for (int k2 = 1; k2 < 4; ++k2) mx = fmaxf(mx, fmaxf(fmaxf(S[k2][qt][0], S[k2][qt][1]), fmaxf(S[k2][qt][2], S[k2][qt][3]))); \
                mxq[qt] = rowmax4(mx); \
            } \
            if (__any((mxq[0] > mref[0] + ATT_THR) || (mxq[1] > mref[1] + ATT_THR))) { \
_Pragma("unroll") \
                for (int qt = 0; qt < 2; ++qt) { \
                    const float mn = (mxq[qt] > mref[qt] + ATT_THR) ? mxq[qt] : mref[qt], al = ex2(mref[qt] - mn); mref[qt] = mn; \
_Pragma("unroll") \
                    for (int dt = 0; dt < 5; ++dt) O[dt][qt] = O[dt][qt] * al; \
                } \
            } \
            u32x4 bp[2][2]; \
_Pragma("unroll") \
            for (int qt = 0; qt < 2; ++qt) { \
                const float mn = mref[qt]; \
_Pragma("unroll") \
                for (int k2 = 0; k2 < 4; ++k2) { \
                    const unsigned w0 = pk2(ex2(S[k2][qt][0] - mn), ex2(S[k2][qt][1] - mn)), w1 = pk2(ex2(S[k2][qt][2] - mn), ex2(S[k2][qt][3] - mn)); \
                    if (k2 & 1) { bp[k2 >> 1][qt].z = w0; bp[k2 >> 1][qt].w = w1; } else { bp[k2 >> 1][qt].x = w0; bp[k2 >> 1][qt].y = w1; } } \
            } \
_Pragma("unroll") \
            for (int dt = 0; dt < 4; ++dt) { \
                const LAS unsigned char* vr = B + 8192 + (16 * dt + li) * 128 + 8 * ((gq ^ li) & 1); \
_Pragma("unroll") \
                for (int kh = 0; kh < 2; ++kh) { \
                    const int c = 4 * kh + (gq >> 1); \
                    const u32x2 x0 = *(const LAS u32x2*)(vr + ((c ^ xr) << 4)), x1 = *(const LAS u32x2*)(vr + (((c + 2) ^ xr) << 4)); \
                    const bf16x8 av = mk8((u32x4){x0.x, x0.y, x1.x, x1.y}); \
                    O[dt][0] = mfma16(av, mk8(bp[kh][0]), O[dt][0]); O[dt][1] = mfma16(av, mk8(bp[kh][1]), O[dt][1]); \
                } \
            } \
_Pragma("unroll") \
            for (int kh = 0; kh < 2; ++kh) { O[4][0] = mfma16(ones8, mk8(bp[kh][0]), O[4][0]); O[4][1] = mfma16(ones8, mk8(bp[kh][1]), O[4][1]); } \
        } \
} while (0)
#define FOX_STEP(RK, RV, RC) do { LAS unsigned char* B_ = lds + cur * FOX_BUF; LAS unsigned char* Bn_ = lds + (cur ^ 1) * FOX_BUF; \
        FOX_WRITE(Bn_, RK, RV, RC); FOX_LOAD(kt + 4, RK, RV, RC); FOX_COMPUTE(kt, B_); __syncthreads(); cur ^= 1; } while (0)
    FOX_LOAD(kt_first, rk0, rv0, rc0); FOX_LOAD(kt_first + 1, rk1, rv1, rc1); FOX_LOAD(kt_first + 2, rk2, rv2, rc2);
    FOX_WRITE(lds, rk0, rv0, rc0);
    __syncthreads();
    FOX_LOAD(kt_first + 3, rk0, rv0, rc0);
    { int kt = kt_first, cur = 0;
      for (;;) {
        FOX_STEP(rk1, rv1, rc1); if (++kt > kt_last) break;
        FOX_STEP(rk2, rv2, rc2); if (++kt > kt_last) break;
        FOX_STEP(rk0, rv0, rc0); if (++kt > kt_last) break;
      } }
#undef FOX_STEP
#undef FOX_COMPUTE
#undef FOX_LOAD
#undef FOX_WRITE
    if (active) {
#pragma unroll
        for (int qt = 0; qt < 2; ++qt) {
            const float inv = 1.0f / O[4][qt][0];
            const int q = q0 + 16 * qt + li;
            if (q >= PADL) {
                bf16* op = dry ? (bf16*)(g_scratch + G_BNAT) + ((rb + q) & 8191) * 1024 + h * 64 + 4 * gq : Y + (rb + q) * 3072 + 2048 + h * 64 + 4 * gq;
#pragma unroll
                for (int dt = 0; dt < 4; ++dt) { u32x2 w; w.x = pk2(O[dt][qt][0] * inv, O[dt][qt][1] * inv); w.y = pk2(O[dt][qt][2] * inv, O[dt][qt][3] * inv); *(u32x2*)(op + 16 * dt) = w; }
            }
        }
    }
}
__device__ __forceinline__ void fox_phase(const P& a, LAS unsigned char* lds, int tid, int wave, int lane, bool dry) {
    constexpr int NU = 33 * 32;
    unsigned* counter = (unsigned*)a.ws + 8192;
    volatile LAS unsigned* ctrl = (volatile LAS unsigned*)(lds + 131072);
    for (;;) {
        if (tid == 0) ctrl[32] = atomicAdd(counter, 1u);
        __syncthreads();
        const int u = (int)ctrl[32];
        __syncthreads();
        if (u >= NU) break;
        const int j = 32 - u / 32, bh = u % 32;
        fox_unit(a, lds, bh >> 4, bh & 15, j, tid, wave, lane, dry);
    }
}

constexpr int DIF_BUF = 16384 + 16384;
__device__ __forceinline__ void diff_unit(const P& a, LAS unsigned char* lds, int b, int h, int j, int tid, int wave, int lane, float lam, bool dry) {
    const LAS float* tab = (const LAS float*)(lds + 2 * DIF_BUF);
    const int q0 = 128 * j + 16 * wave;
    const bool active = q0 + 15 >= PADL;
    const int li = lane & 15, gq = lane >> 4, xr = (li >> 1) & 7;
    bf16* Q = (bf16*)(g_scratch + G_DQ); const bf16* Kp = (const bf16*)(g_scratch + G_DK); const bf16* Vt = (const bf16*)(g_scratch + G_DVT);
    const size_t rb = (size_t)b * LP; const int q = q0 + li;
    const int srow = tid >> 3, sch = tid & 7;
    const bf16* kg = Kp + (rb + srow) * 1024 + h * 128 + 8 * sch;
    const bf16* vg = Vt + ((size_t)(b * 8 + h) * 128 + srow) * LP + 8 * sch;
    const int kof0 = srow * 256 + ((sch ^ (srow & 15)) << 4), kof1 = srow * 256 + (((sch + 8) ^ (srow & 15)) << 4);
    const int vof0 = 16384 + srow * 128 + ((sch ^ ((srow >> 1) & 7)) << 4), vof1 = vof0 + 64 * 128;
    bf16x8 bq[2][2];
    if (active) {
#pragma unroll
        for (int cp = 0; cp < 2; ++cp)
#pragma unroll
            for (int ks = 0; ks < 2; ++ks) bq[cp][ks] = *(const bf16x8*)(Q + (rb + q) * 1024 + h * 128 + cp * 64 + 32 * ks + 8 * gq);
    }
    f32x4 O[2][9];
#pragma unroll
    for (int dt = 0; dt < 9; ++dt) { O[0][dt] = (f32x4){0.f, 0.f, 0.f, 0.f}; O[1][dt] = (f32x4){0.f, 0.f, 0.f, 0.f}; }
    float mref[2] = {-1e30f, -1e30f};
    const bf16x8 ones8 = mk8((u32x4){0x3f803f80u, 0x3f803f80u, 0x3f803f80u, 0x3f803f80u});
    const int kt_first = 1, kt_last = 2 * j + 1;
    u32x4 ak0, ak1, av0, av1, bk0, bk1, bv0, bv1;
#define DIF_LOAD(T, K0, K1, V0, V1) do { const int t_ = (T) < kt_last ? (T) : kt_last; const size_t ko_ = (size_t)(t_ * 64) * 1024; K0 = *(const u32x4*)(kg + ko_); K1 = *(const u32x4*)(kg + ko_ + 64); \
        V0 = *(const u32x4*)(vg + t_ * 64); V1 = *(const u32x4*)(vg + (size_t)64 * LP + t_ * 64); } while (0)
#define DIF_WRITE(BUF, K0, K1, V0, V1) do { *(LAS u32x4*)((BUF) + kof0) = K0; *(LAS u32x4*)((BUF) + kof1) = K1; *(LAS u32x4*)((BUF) + vof0) = (srow & 1) ? (u32x4){V0.z, V0.w, V0.x, V0.y} : V0; *(LAS u32x4*)((BUF) + vof1) = (srow & 1) ? (u32x4){V1.z, V1.w, V1.x, V1.y} : V1; } while (0)
#define DIF_COMPUTE(kt, B) do { \
        const int key0 = kt * 64; \
        if (active && key0 <= q0 + 15) { \
            f32x4 S[2][4]; __builtin_amdgcn_s_setprio(1); \
_Pragma("unroll") \
            for (int k2 = 0; k2 < 4; ++k2) { \
                const LAS unsigned char* kr = B + (16 * k2 + li) * 256; \
_Pragma("unroll") \
                for (int cp = 0; cp < 2; ++cp) { \
                    const bf16x8 a0 = *(const LAS bf16x8*)(kr + (((8 * cp + gq) ^ li) << 4)), a1 = *(const LAS bf16x8*)(kr + (((8 * cp + 4 + gq) ^ li) << 4)); \
                    f32x4 t = mfma16(a0, bq[cp][0], (f32x4){0.f, 0.f, 0.f, 0.f}); S[cp][k2] = mfma16(a1, bq[cp][1], t); \
                } \
            } \
            if (kt == 1 || key0 + 63 + 113 > q0) { \
_Pragma("unroll") \
                for (int k2 = 0; k2 < 4; ++k2) \
_Pragma("unroll") \
                    for (int r = 0; r < 4; ++r) { \
                        const int key = key0 + 16 * k2 + 4 * gq + r, n = q - key; \
                        if (n < 0 || key < PADL) { S[0][k2][r] = -1e30f; S[1][k2][r] = -1e30f; } \
                        else { const float bv = tab[n < 127 ? n : 127]; S[0][k2][r] += bv; S[1][k2][r] += bv; } \
                    } \
            } \
            __builtin_amdgcn_s_setprio(0); float mxq[2]; \
_Pragma("unroll") \
            for (int cp = 0; cp < 2; ++cp) { \
                float mx = fmaxf(fmaxf(S[cp][0][0], S[cp][0][1]), fmaxf(S[cp][0][2], S[cp][0][3])); \
_Pragma("unroll") \
                for (int k2 = 1; k2 < 4; ++k2) mx = fmaxf(mx, fmaxf(fmaxf(S[cp][k2][0], S[cp][k2][1]), fmaxf(S[cp][k2][2], S[cp][k2][3]))); \
                mxq[cp] = rowmax4(mx); \
            } \
            if (__any((mxq[0] > mref[0] + ATT_THR) || (mxq[1] > mref[1] + ATT_THR))) { \
_Pragma("unroll") \
                for (int cp = 0; cp < 2; ++cp) { \
                    const float mn = (mxq[cp] > mref[cp] + ATT_THR) ? mxq[cp] : mref[cp], al = ex2(mref[cp] - mn); mref[cp] = mn; \
_Pragma("unroll") \
                    for (int dt = 0; dt < 9; ++dt) O[cp][dt] = O[cp][dt] * al; \
                } \
            } \
            u32x4 bp[2][2]; \
_Pragma("unroll") \
            for (int cp = 0; cp < 2; ++cp) { \
                const float mn = mref[cp]; \
_Pragma("unroll") \
                for (int k2 = 0; k2 < 4; ++k2) { \
                    const unsigned w0 = pk2(ex2(S[cp][k2][0] - mn), ex2(S[cp][k2][1] - mn)), w1 = pk2(ex2(S[cp][k2][2] - mn), ex2(S[cp][k2][3] - mn)); \
                    if (k2 & 1) { bp[cp][k2 >> 1].z = w0; bp[cp][k2 >> 1].w = w1; } else { bp[cp][k2 >> 1].x = w0; bp[cp][k2 >> 1].y = w1; } } \
            } \
_Pragma("unroll") \
            for (int dt = 0; dt < 8; ++dt) { \
                const LAS unsigned char* vr = B + 16384 + (16 * dt + li) * 128 + 8 * ((gq ^ li) & 1); \
_Pragma("unroll") \
                for (int kh = 0; kh < 2; ++kh) { \
                    const int c = 4 * kh + (gq >> 1); \
                    const u32x2 x0 = *(const LAS u32x2*)(vr + ((c ^ xr) << 4)), x1 = *(const LAS u32x2*)(vr + (((c + 2) ^ xr) << 4)); \
                    const bf16x8 av = mk8((u32x4){x0.x, x0.y, x1.x, x1.y}); \
                    O[0][dt] = mfma16(av, mk8(bp[0][kh]), O[0][dt]); O[1][dt] = mfma16(av, mk8(bp[1][kh]), O[1][dt]); \
                } \
            } \
_Pragma("unroll") \
            for (int kh = 0; kh < 2; ++kh) { O[0][8] = mfma16(ones8, mk8(bp[0][kh]), O[0][8]); O[1][8] = mfma16(ones8, mk8(bp[1][kh]), O[1][8]); } \
        } \
} while (0)
#define DIF_STEP(K0, K1, V0, V1) do { LAS unsigned char* B_ = lds + cur * DIF_BUF; LAS unsigned char* Bn_ = lds + (cur ^ 1) * DIF_BUF; \
        DIF_WRITE(Bn_, K0, K1, V0, V1); DIF_LOAD(kt + 3, K0, K1, V0, V1); DIF_COMPUTE(kt, B_); __syncthreads(); cur ^= 1; } while (0)
    DIF_LOAD(kt_first, ak0, ak1, av0, av1); DIF_LOAD(kt_first + 1, bk0, bk1, bv0, bv1);
    DIF_WRITE(lds, ak0, ak1, av0, av1);
    __syncthreads();
    DIF_LOAD(kt_first + 2, ak0, ak1, av0, av1);
    { int kt = kt_first, cur = 0;
      for (;;) {
        DIF_STEP(bk0, bk1, bv0, bv1); if (++kt > kt_last) break;
        DIF_STEP(ak0, ak1, av0, av1); if (++kt > kt_last) break;
      } }
#undef DIF_STEP
#undef DIF_COMPUTE
#undef DIF_LOAD
#undef DIF_WRITE
    if (active) {
        const float i0 = 1.0f / O[0][8][0], i1 = lam / O[1][8][0]; float ss = 0.f;
#pragma unroll
        for (int dt = 0; dt < 8; ++dt) { O[0][dt] = O[0][dt] * i0 - O[1][dt] * i1; ss += (O[0][dt][0] * O[0][dt][0] + O[0][dt][1] * O[0][dt][1]) + (O[0][dt][2] * O[0][dt][2] + O[0][dt][3] * O[0][dt][3]); }
        ss += __shfl_xor(ss, 16); ss += __shfl_xor(ss, 32);
        const float rstd = (1.0f - LAM_INIT) / sqrtf(ss * (1.f / 128.f) + 1e-5f);
        if (q >= PADL) {
            bf16* op = (dry ? (bf16*)(a.ws + WS_ACT) : Q) + (rb + q) * 1024 + h * 128 + 4 * gq; const float* sw = a.in[24] + 4 * gq;
#pragma unroll
            for (int dt = 0; dt < 8; ++dt) { const f32x4 w4 = *(const f32x4*)(sw + 16 * dt); u32x2 w;
                w.x = pk2(O[0][dt][0] * rstd * w4[0], O[0][dt][1] * rstd * w4[1]); w.y = pk2(O[0][dt][2] * rstd * w4[2], O[0][dt][3] * rstd * w4[3]); *(u32x2*)(op + 16 * dt) = w; }
        }
    }
}
__device__ __forceinline__ void diff_phase(const P& a, LAS unsigned char* lds, int tid, int wave, int lane, bool dry) {
    LAS float* tab = (LAS float*)(lds + 2 * DIF_BUF);
    const float s1 = wave_sum(a.in[20][lane] * a.in[21][lane]), s2 = wave_sum(a.in[22][lane] * a.in[23][lane]);
    const float lam = expf(s1) - expf(s2) + LAM_INIT;
    const int G = gdim(), c = bidx(); constexpr int NU = 65 * 16;
    for (int r = 0;; ++r) {
        const int u = (r & 1) ? r * G + (G - 1 - c) : r * G + c;
        if (r * G >= NU) break;
        if (u >= NU) continue;
        const int j = 64 - u / 16, bh = u % 16, h = bh & 7;
        if (tid < 128) { const int n = tid; int bk = n; if (n >= 16) { bk = 16 + (int)(logf((float)n / 16.0f) / 2.0794415416798357f * 16.0f); bk = bk > 31 ? 31 : bk; }
            tab[n] = (a.in[26][bk * 8 + h] - a.in[26][31 * 8 + h]) * LOG2E; }
        diff_unit(a, lds, bh >> 3, h, j, tid, wave, lane, lam, dry);
    }
}


__device__ __forceinline__ void ssd_prep_phase(const P& a, LAS unsigned char* lds, int tid, int wave, int lane) {
    LAS unsigned short* tin = (LAS unsigned short*)lds;
    LAS float* sdt = (LAS float*)(lds + 20480); LAS float* sac = sdt + 128;
    const bf16* xbc = (const bf16*)(g_scratch + G_XBC);
    bf16* XT = (bf16*)(a.ws + WS_XT); bf16* BT = (bf16*)(a.ws + WS_BT); bf16* Bn = (bf16*)(g_scratch + G_BNAT); bf16* Cn = (bf16*)(a.ws + WS_CNAT);
    const float* dtf = (const float*)(a.ws + WS_DTF);
    float* acum = (float*)(a.ws + WS_ACUM); float* scv = (float*)(a.ws + WS_SCV); float* dtv = (float*)(a.ws + WS_DTV);
    const float* cw = a.in[11]; const float* cbias = a.in[12];
    for (int it = bidx(); it < NCB * 48; it += gdim()) {
        const int cbi = it / 48, hb = it % 48, b = cbi / NCH, c = cbi % NCH, row0 = b * LP + c * 128;
        for (int i = tid; i < 131 * 8; i += 512) { const int r = i >> 3, pc = i & 7, prow = c * 128 - 3 + r;
            u32x4 v = (u32x4){0u, 0u, 0u, 0u}; if (prow >= 0) v = *(const u32x4*)(xbc + (size_t)(b * LP + prow) * 3072 + hb * 64 + pc * 8);
            LAS unsigned* d = (LAS unsigned*)(tin + r * 66 + pc * 8); d[0] = v.x; d[1] = v.y; d[2] = v.z; d[3] = v.w; }
        if (hb < 32 && tid < 128) {
            const float raw = dtf[(size_t)(row0 + tid) * 64 + hb] + a.in[13][hb];
            float dt = raw > 20.f ? raw : log1pf(expf(raw));
            if (c == 0 && tid < PADL) dt = 0.f;
            sdt[tid] = dt; sac[tid] = -expf(a.in[14][hb]) * dt;
        }
        __syncthreads();
        if (hb < 32 && wave == 0) {
            const float v0 = sac[2 * lane], v1 = sac[2 * lane + 1], s = v0 + v1; float v = s;
#pragma unroll
            for (int o = 1; o < 64; o <<= 1) { const float t = __shfl_up(v, o); if (lane >= o) v += t; }
            sac[2 * lane] = v - s + v0; sac[2 * lane + 1] = v;
        }
        __syncthreads();
        if (hb < 32 && tid < 128) { const size_t idx = ((size_t)cbi * 32 + hb) * 128 + tid; const float ac = sac[tid], dt = sdt[tid];
            acum[idx] = ac; dtv[idx] = dt; scv[idx] = dt * expf(sac[127] - ac); }
        const int l = tid & 127, cg_ = tid >> 7;
        unsigned pk[8];
        f32x4 wv[4][4], bv[4];
        { const int gch0 = hb * 64 + cg_ * 16;
#pragma unroll
          for (int q = 0; q < 4; ++q) { bv[q] = *(const f32x4*)(cbias + gch0 + 4 * q);
#pragma unroll
            for (int k = 0; k < 4; ++k) wv[k][q] = *(const f32x4*)(cw + k * 3072 + gch0 + 4 * q); } }
#pragma unroll
        for (int cc = 0; cc < 16; cc += 2) {
            float vv[2];
#pragma unroll
            for (int e = 0; e < 2; ++e) { const int cl = cc + e, ch = cg_ * 16 + cl;
                float acc = bv[cl >> 2][cl & 3];
#pragma unroll
                for (int k = 0; k < 4; ++k) acc += wv[k][cl >> 2][cl & 3] * bf2f(tin[(l + k) * 66 + ch]);
                vv[e] = siluf(acc); }
            pk[cc >> 1] = pk2(vv[0], vv[1]);
        }
        if (hb < 32) {
            bf16* xt = XT + (((size_t)cbi * 32 + hb) * 64 + cg_ * 16) * 128 + l;
#pragma unroll
            for (int cc = 0; cc < 16; ++cc) xt[(size_t)cc * 128] = (bf16)((cc & 1) ? (pk[cc >> 1] >> 16) : (pk[cc >> 1] & 0xffffu));
        } else {
            const int g = ((hb - 32) & 7) >> 1, n0 = ((hb - 32) & 1) * 64 + cg_ * 16;
            bf16* nat = (hb < 40 ? Bn : Cn) + (size_t)(row0 + l) * 512 + g * 128 + n0;
            *(u32x4*)nat = (u32x4){pk[0], pk[1], pk[2], pk[3]}; *(u32x4*)(nat + 8) = (u32x4){pk[4], pk[5], pk[6], pk[7]};
            if (hb < 40) { bf16* bt = BT + (((size_t)cbi * 4 + g) * 128 + n0) * 128 + l;
#pragma unroll
                for (int cc = 0; cc < 16; ++cc) bt[(size_t)cc * 128] = (bf16)((cc & 1) ? (pk[cc >> 1] >> 16) : (pk[cc >> 1] & 0xffffu)); }
        }
        __syncthreads();
    }
}

__device__ __forceinline__ void ssd_s1_phase(const P& a, int wave, int lane) {
    const int li = lane & 15, gq = lane >> 4;
    const bf16* XT = (const bf16*)(a.ws + WS_XT); const bf16* BT = (const bf16*)(a.ws + WS_BT); const float* scv = (const float*)(a.ws + WS_SCV);
    bf16* ST = (bf16*)(g_scratch + G_ST);
    for (int it = bidx(); it < NCB * 4; it += gdim()) {
        const int cbi = it >> 2, g = it & 3, h = 8 * g + wave;
        const bf16* xth = XT + ((size_t)cbi * 32 + h) * 8192 + li * 128 + 8 * gq; const bf16* btg = BT + ((size_t)cbi * 4 + g) * 16384 + li * 128 + 8 * gq;
        const float* sc = scv + ((size_t)cbi * 32 + h) * 128 + 8 * gq;
        f32x4 acc[4][8];
#pragma unroll
        for (int pt = 0; pt < 4; ++pt)
#pragma unroll
            for (int nt = 0; nt < 8; ++nt) acc[pt][nt] = (f32x4){0.f, 0.f, 0.f, 0.f};
#pragma unroll 1
        for (int ks = 0; ks < 4; ++ks) {
            const f32x4 s0 = *(const f32x4*)(sc + 32 * ks), s1 = *(const f32x4*)(sc + 32 * ks + 4);
            bf16x8 af[4];
#pragma unroll
            for (int pt = 0; pt < 4; ++pt) { const u32x4 w = *(const u32x4*)(xth + pt * 2048 + 32 * ks); u32x4 o;
                o.x = pk2(bflo(w.x) * s0[0], bfhi(w.x) * s0[1]); o.y = pk2(bflo(w.y) * s0[2], bfhi(w.y) * s0[3]);
                o.z = pk2(bflo(w.z) * s1[0], bfhi(w.z) * s1[1]); o.w = pk2(bflo(w.w) * s1[2], bfhi(w.w) * s1[3]); af[pt] = mk8(o); }
#pragma unroll
            for (int nt = 0; nt < 8; ++nt) { const bf16x8 bf = *(const bf16x8*)(btg + nt * 2048 + 32 * ks);
#pragma unroll
                for (int pt = 0; pt < 4; ++pt) acc[pt][nt] = mfma16(af[pt], bf, acc[pt][nt]); }
        }
        bf16* st = ST + ((size_t)cbi * 32 + h) * 8192 + (4 * gq) * 128 + li;
#pragma unroll
        for (int pt = 0; pt < 4; ++pt)
#pragma unroll
            for (int nt = 0; nt < 8; ++nt)
#pragma unroll
                for (int r = 0; r < 4; ++r) st[(16 * pt + r) * 128 + 16 * nt] = (bf16)f2bf(acc[pt][nt][r]);
    }
}
__device__ __forceinline__ void ssd_scan_phase(const P& a, int tid, bool dry) {
    bf16* ST = (bf16*)(g_scratch + G_ST); const float* acum = (const float*)(a.ws + WS_ACUM);
    for (int e = bidx() * 512 + tid; e < 131072; e += gdim() * 512) {
        const int b = e >> 16, r = e & 65535, h = r >> 11, off = (r & 2047) * 4;
        float r0 = 0.f, r1 = 0.f, r2 = 0.f, r3 = 0.f;
        u32x2 nx = *(const u32x2*)(ST + ((size_t)(b * NCH) * 32 + h) * 8192 + off); float nd = acum[((size_t)(b * NCH) * 32 + h) * 128 + 127];
        for (int c = 0; c < NCH; ++c) {
            const size_t cbh = (size_t)(b * NCH + c) * 32 + h; u32x2* p = (u32x2*)(ST + cbh * 8192 + off);
            const u32x2 v = nx; const float dec = expf(nd); if (c + 1 < NCH) { nx = *(const u32x2*)(ST + (cbh + 32) * 8192 + off); nd = acum[(cbh + 32) * 128 + 127]; }
            u32x2 o; o.x = pk2(r0, r1); o.y = pk2(r2, r3); if (!dry) *p = o;
            r0 = r0 * dec + bflo(v.x); r1 = r1 * dec + bfhi(v.x); r2 = r2 * dec + bflo(v.y); r3 = r3 * dec + bfhi(v.y);
        }
    }
}
__device__ __forceinline__ void ssd_s3_phase(const P& a, LAS unsigned char* lds, int wave, int lane, bool dry) {
    LAS float* cbl = (LAS float*)lds;
    LAS float* ssum = (LAS float*)(lds + 69632);
    LAS float* sad = (LAS float*)(lds + 73728) + wave * 256;
    const int li = lane & 15, gq = lane >> 4;
    const bf16* XT = (const bf16*)(a.ws + WS_XT); const bf16* Bn = (const bf16*)(g_scratch + G_BNAT); const bf16* Cn = (const bf16*)(a.ws + WS_CNAT);
    const bf16* ST = (const bf16*)(g_scratch + G_ST); bf16* Y = (bf16*)(g_scratch + G_YMIX);
    const float* acum = (const float*)(a.ws + WS_ACUM); const float* dtv = (const float*)(a.ws + WS_DTV);
    for (int it = bidx(); it < NCB * 8; it += gdim()) {
        const int half = it < NCB * 4 ? 1 : 0, idx = it < NCB * 4 ? it : it - NCB * 4;
        const int cbi = idx >> 2, g = idx & 3, h = 8 * g + wave, b = cbi / NCH, c = cbi % NCH, row0 = b * LP + c * 128;
        const bf16* xth = XT + ((size_t)cbi * 32 + h) * 8192; const bf16* pv = ST + ((size_t)cbi * 32 + h) * 8192 + li * 128 + 8 * gq;
        const bf16* bn = Bn + (size_t)row0 * 512 + g * 128 + 8 * gq; const bf16* cn = Cn + (size_t)row0 * 512 + g * 128 + 8 * gq;
        const float Dh = a.in[15][h];
        { const float* ac = acum + ((size_t)cbi * 32 + h) * 128; const float* dtp = dtv + ((size_t)cbi * 32 + h) * 128;
          sad[lane] = ac[lane]; sad[64 + lane] = ac[64 + lane]; sad[128 + lane] = dtp[lane]; sad[192 + lane] = dtp[64 + lane]; }
        bf16x8 pf[4][4];
#pragma unroll
        for (int pt = 0; pt < 4; ++pt)
#pragma unroll
            for (int ks = 0; ks < 4; ++ks) pf[pt][ks] = *(const bf16x8*)(pv + pt * 2048 + 32 * ks);
        {
            const int lcol = 16 * (4 * half + (wave >> 1)) + li; bf16x8 cf[4];
#pragma unroll
            for (int ks = 0; ks < 4; ++ks) cf[ks] = *(const bf16x8*)(cn + (size_t)lcol * 512 + 32 * ks);
#pragma unroll
            for (int sq = 0; sq < 4; ++sq) { const int st = (wave & 1) * 4 + sq;
                f32x4 acc = (f32x4){0.f, 0.f, 0.f, 0.f};
#pragma unroll
                for (int ks = 0; ks < 4; ++ks) acc = mfma16(*(const bf16x8*)(bn + (size_t)(16 * st + li) * 512 + 32 * ks), cf[ks], acc);
                *(LAS f32x4*)(cbl + lcol * 132 + 16 * st + 4 * gq) = acc;
            }
        }
        __syncthreads();
#pragma unroll 1
        for (int lt = 4 * half; lt < 4 * half + 4; ++lt) {
            const int lcol = 16 * lt + li; const float al = sad[lcol];
            f32x4 yo[4], yd[4];
            {
                bf16x8 cf[4];
#pragma unroll
                for (int ks = 0; ks < 4; ++ks) cf[ks] = *(const bf16x8*)(cn + (size_t)lcol * 512 + 32 * ks);
#pragma unroll
                for (int pt = 0; pt < 4; ++pt) { yo[pt] = (f32x4){0.f, 0.f, 0.f, 0.f}; yd[pt] = (f32x4){0.f, 0.f, 0.f, 0.f};
#pragma unroll
                    for (int ks = 0; ks < 4; ++ks) yo[pt] = mfma16(pf[pt][ks], cf[ks], yo[pt]); }
            }
#pragma unroll 1
            for (int sp = 0; sp <= (lt >> 1); ++sp) {
                const int s0 = 32 * sp + 8 * gq;
                bf16x8 xa[4];
#pragma unroll
                for (int pt = 0; pt < 4; ++pt) xa[pt] = *(const bf16x8*)(xth + (size_t)(16 * pt + li) * 128 + s0);
                const f32x4 c0 = *(const LAS f32x4*)(cbl + lcol * 132 + s0), c1 = *(const LAS f32x4*)(cbl + lcol * 132 + s0 + 4);
                const f32x4 a0 = *(const LAS f32x4*)(sad + s0), a1 = *(const LAS f32x4*)(sad + s0 + 4), d0 = *(const LAS f32x4*)(sad + 128 + s0), d1 = *(const LAS f32x4*)(sad + 128 + s0 + 4);
                float mv[8];
#pragma unroll
                for (int r = 0; r < 4; ++r) { mv[r] = (s0 + r <= lcol) ? c0[r] * ex2((al - a0[r]) * LOG2E) * d0[r] : 0.f; mv[4 + r] = (s0 + 4 + r <= lcol) ? c1[r] * ex2((al - a1[r]) * LOG2E) * d1[r] : 0.f; }
                u32x4 bp; bp.x = pk2(mv[0], mv[1]); bp.y = pk2(mv[2], mv[3]); bp.z = pk2(mv[4], mv[5]); bp.w = pk2(mv[6], mv[7]);
#pragma unroll
                for (int pt = 0; pt < 4; ++pt) yd[pt] = mfma16(xa[pt], mk8(bp), yd[pt]);
            }
            const float eal = ex2(al * LOG2E); float ss = 0.f;
            bf16* yrow = Y + (size_t)(row0 + lcol) * 3072 + h * 64 + 4 * gq;
#pragma unroll
            for (int pt = 0; pt < 4; ++pt) {
                const u32x2 zw = *(const u32x2*)(yrow + 16 * pt); const float z[4] = {bflo(zw.x), bfhi(zw.x), bflo(zw.y), bfhi(zw.y)}; float yg[4];
#pragma unroll
                for (int r = 0; r < 4; ++r) { const float xs = bf2f(xth[(size_t)(16 * pt + 4 * gq + r) * 128 + lcol]);
                    yg[r] = (yd[pt][r] + eal * yo[pt][r] + Dh * xs) * siluf(z[r]); ss += yg[r] * yg[r]; }
                u32x2 w; w.x = pk2(yg[0], yg[1]); w.y = pk2(yg[2], yg[3]); if (!dry) *(u32x2*)(yrow + 16 * pt) = w;
            }
            ss += __shfl_xor(ss, 16); ss += __shfl_xor(ss, 32);
            if (gq == 0) ssum[wave * 128 + lcol] = ss;
        }
        __syncthreads();
#pragma unroll 1
        for (int lt = 4 * half; lt < 4 * half + 4; ++lt) {
            const int lcol = 16 * lt + li; float tot = 0.f;
#pragma unroll
            for (int w = 0; w < 8; ++w) tot += ssum[w * 128 + lcol];
            const float rstd = 1.0f / sqrtf(tot * (1.f / 512.f) + 1e-5f);
            bf16* yrow = Y + (size_t)(row0 + lcol) * 3072 + h * 64 + 4 * gq; const float* nw = a.in[16] + h * 64 + 4 * gq;
#pragma unroll
            for (int pt = 0; pt < 4; ++pt) { const u32x2 yw = *(const u32x2*)(yrow + 16 * pt); const f32x4 w4 = *(const f32x4*)(nw + 16 * pt); u32x2 w;
                w.x = pk2(bflo(yw.x) * rstd * w4[0], bfhi(yw.x) * rstd * w4[1]); w.y = pk2(bflo(yw.y) * rstd * w4[2], bfhi(yw.y) * rstd * w4[3]); if (!dry) *(u32x2*)(yrow + 16 * pt) = w; }
        }
        __syncthreads();
    }
}

template <class Epi> __device__ __forceinline__ void run_gemm(LAS unsigned char* lds, const bf16* A, const bf16* Bt, int N, int K, const Epi& E) {
    pg8::Gemm g{A, Bt, M, N, K, K}; pg8::StaticOrder S; S.init(M, N, gdim(), bidx());
    pg8::gemm_phase<Epi, pg8::StaticOrder, true, true>(lds, g, S, E);
}
__device__ __forceinline__ void thin_resid_tail(LAS unsigned char* lds, const bf16* A, const bf16* Bt, int K, bf16* mout, float scale) {
    int tid = threadIdx.x; asm volatile("" : "+v"(tid));
    const int lane = tid & 63, wave = __builtin_amdgcn_readfirstlane(tid >> 6), li = lane & 15, gq = lane >> 4;
    for (int c = bidx(); c < 256; c += gdim()) {
    const int rt = c >> 4, cgp = c & 15, kw = K >> 3;
    const bf16* xa = A + (size_t)(16 * rt + li) * K + wave * kw + 8 * gq;
    const bf16* wb = Bt + (size_t)(64 * cgp + li) * K + wave * kw + 8 * gq;
    f32x4 acc[4];
#pragma unroll
    for (int nt = 0; nt < 4; ++nt) acc[nt] = (f32x4){0.f, 0.f, 0.f, 0.f};
#pragma unroll 4
    for (int ks = 0; ks < kw; ks += 32) {
        const bf16x8 xf = *(const bf16x8*)(xa + ks);
#pragma unroll
        for (int nt = 0; nt < 4; ++nt) acc[nt] = mfma16(*(const bf16x8*)(wb + (size_t)(16 * nt) * K + ks), xf, acc[nt]);
    }
    LAS f32x4* red = (LAS f32x4*)lds;
#pragma unroll
    for (int nt = 0; nt < 4; ++nt) red[(wave * 4 + nt) * 64 + lane] = acc[nt];
    __syncthreads();
    if (wave < 4) {
        f32x4 sum = red[wave * 64 + lane];
#pragma unroll
        for (int w = 1; w < 8; ++w) sum = sum + red[(w * 4 + wave) * 64 + lane];
        u32x2 w; w.x = pk2(sum[0] * scale, sum[1] * scale); w.y = pk2(sum[2] * scale, sum[3] * scale);
        *(u32x2*)(mout + (size_t)(16384 + 16 * rt + li) * 1024 + 64 * cgp + 16 * wave + 4 * gq) = w;
    }
    __syncthreads();
    }
}
__device__ __forceinline__ void thin_qkv_tail(LAS unsigned char* lds, const bf16* A, const bf16* Bt, bf16* dq, bf16* dk, bf16* dvt) {
    int tid = threadIdx.x; asm volatile("" : "+v"(tid));
    const int lane = tid & 63, wave = __builtin_amdgcn_readfirstlane(tid >> 6), li = lane & 15, gq = lane >> 4;
    for (int c = bidx(); c < 256; c += gdim()) {
        const int rt = c >> 4, cgp = c & 15;
        const bf16* xa = A + (size_t)(16 * rt + li) * 1024 + wave * 128 + 8 * gq;
        const bf16* wb = Bt + (size_t)(192 * cgp + li) * 1024 + wave * 128 + 8 * gq;
        f32x4 acc[12];
#pragma unroll
        for (int nt = 0; nt < 12; ++nt) acc[nt] = (f32x4){0.f, 0.f, 0.f, 0.f};
#pragma unroll 2
        for (int ks = 0; ks < 128; ks += 32) {
            const bf16x8 xf = *(const bf16x8*)(xa + ks);
#pragma unroll
            for (int nt = 0; nt < 12; ++nt) acc[nt] = mfma16(*(const bf16x8*)(wb + (size_t)(16 * nt) * 1024 + ks), xf, acc[nt]);
        }
        LAS f32x4* red = (LAS f32x4*)lds;
#pragma unroll
        for (int nt = 0; nt < 12; ++nt) red[(wave * 12 + nt) * 64 + lane] = acc[nt];
        __syncthreads();
        const int row = 16384 + 16 * rt + li, p = row - LP;
        for (int nt = wave; nt < 12; nt += 8) {
            f32x4 sum = red[nt * 64 + lane];
#pragma unroll
            for (int w = 1; w < 8; ++w) sum = sum + red[(w * 12 + nt) * 64 + lane];
            const int col = 192 * cgp + 16 * nt + 4 * gq;
            if (col < 1024) { u32x2 o; o.x = pk2(sum[0] * QSCALE, sum[1] * QSCALE); o.y = pk2(sum[2] * QSCALE, sum[3] * QSCALE); *(u32x2*)(dq + (size_t)row * 1024 + col) = o; }
            else if (col < 2048) { u32x2 o; o.x = pk2(sum[0], sum[1]); o.y = pk2(sum[2], sum[3]); *(u32x2*)(dk + (size_t)row * 1024 + col - 1024) = o; }
            else { const int cv = col - 2048; bf16* vp = dvt + ((size_t)((8 + (cv >> 7)) * 128 + (cv & 127))) * LP + p;
#pragma unroll
                for (int i = 0; i < 4; ++i) vp[(size_t)i * LP] = (bf16)f2bf(sum[i]); }
        }
        __syncthreads();
    }
}
__device__ __forceinline__ void run_resid_gemm(LAS unsigned char* lds, const bf16* A, const bf16* Bt, int K, bf16* mout, float scale) {
    { EpiBranch E{mout, scale}; pg8::Gemm g{A, Bt, 16384, 1024, K, K}; pg8::StaticOrder S; S.init(16384, 1024, gdim(), bidx());
      pg8::gemm_phase<EpiBranch, pg8::StaticOrder, false, true>(lds, g, S, E); }
    thin_resid_tail(lds, A + (size_t)16384 * K, Bt, K, mout, scale);
}
#define PH_BEGIN(k) if (lo <= (k) && (k) < hi) { \
        const __attribute__((address_space(4))) P* ap_ = (const __attribute__((address_space(4))) P*)__builtin_amdgcn_kernarg_segment_ptr(); asm volatile("" : "+s"(ap_)); \
        const P& a = *(const P*)ap_; int tid = threadIdx.x; asm volatile("" : "+v"(tid)); \
        const int lane = tid & 63, wave = __builtin_amdgcn_readfirstlane(tid >> 6); (void)lane; (void)wave; \
        unsigned char* ws = a.ws; asm volatile("" : "+s"(ws)); unsigned char* gs = g_scratch; asm volatile("" : "+s"(gs)); \
        bf16* hb = (bf16*)(ws + WS_HB); bf16* act = (bf16*)(ws + WS_ACT); float* hs = (float*)(ws + WS_HS); bf16* ymix = (bf16*)(gs + G_YMIX); (void)hb; (void)act; (void)hs; (void)ymix;
#define PH_END(k) if ((k) + 1 < hi) { \
            if (USE_XB) { XcdBarrier xbar; xbar.bar = (unsigned*)ws; xbar.x = xb_xcc_id(); xbar.st = (volatile LAS unsigned*)(lds + 131072) + 8; xcd_barrier(xbar); } \
            else { cg::this_grid().sync(); } } }
#define FFN3(base, f, lnidx, fin) \
    PH_BEGIN(base) { EpiSwiGLU E{act}; run_gemm(lds, hb, (const bf16*)(ws + WS_GU + (f) * SZ_GU), 5632, 1024, E); } PH_END(base) \
    PH_BEGIN((base) + 1) run_resid_gemm(lds, act, (const bf16*)(ws + WS_DN + (f) * SZ_DN), DFF, hb, 0.5f); PH_END((base) + 1) \
    PH_BEGIN((base) + 2) ln_phase(a, a.in[2] + (lnidx) * 1024, a.in[3] + (lnidx) * 1024, fin, wave, lane, false); PH_END((base) + 2)
__global__ void __launch_bounds__(512, 2) mk_fwd(P a_) {
    extern __shared__ __attribute__((aligned(16))) unsigned char lds_raw[];
    LAS unsigned char* lds = (LAS unsigned char*)lds_raw;
    if (threadIdx.x < 64) ((LAS unsigned*)(lds + 131072))[threadIdx.x] = 0u;
    __syncthreads();
    (void)xcd_barrier_post((unsigned*)a_.ws, (volatile LAS unsigned*)(lds + 131072) + 8);
    const int lo = a_.ph_lo, hi = a_.ph_hi;
    if (lo < 0) cg::this_grid().sync();
    PH_BEGIN(0) prologue_phase(a, lds, wave, lane); PH_END(0)
    FFN3(1, 0, 0, false)
    PH_BEGIN(4) {
        EpiSplit E{}; E.A = ymix; E.lda = 3072; E.ca = 0; E.t_a = 8; E.B = (bf16*)(gs + G_XBC); E.ldb = 3072; E.cb = 0; E.t_b = 20;
        E.C = ymix; E.ldc = 3072; E.cc = 2048; E.t_c = 24; E.qs = QSCALE; E.Dd = (bf16*)(ws + WS_K); E.ldd = 1024; E.cd = 0; E.t_d = 28;
        E.VT = (bf16*)(ws + WS_VT); E.t_e = 32; E.hd_shift = 6; E.nheads = 16; E.dtf = (float*)(ws + WS_DTF);
        run_gemm(lds, hb, (const bf16*)(ws + WS_WIN), NIN_PAD, 1024, E); } PH_END(4)
    PH_BEGIN(5) c2_phase(a, lds, tid, wave, lane); PH_END(5)
    PH_BEGIN(6) fox_phase(a, lds, tid, wave, lane, false); PH_END(6)
    PH_BEGIN(7) ssd_prep_phase(a, lds, tid, wave, lane); PH_END(7)
    PH_BEGIN(8) ssd_s1_phase(a, wave, lane); PH_END(8)
    PH_BEGIN(9) ssd_scan_phase(a, tid, false); PH_END(9)
    PH_BEGIN(10) ssd_s3_phase(a, lds, wave, lane, false); PH_END(10)
    PH_BEGIN(11) run_resid_gemm(lds, ymix, (const bf16*)(ws + WS_WOUT), 3072, hb, 1.0f); PH_END(11)
    PH_BEGIN(12) ln_phase(a, a.in[2] + 1 * 1024, a.in[3] + 1 * 1024, false, wave, lane, false); PH_END(12)
    FFN3(13, 1, 2, false)
    FFN3(16, 2, 3, false)
    PH_BEGIN(19) {
        EpiSplit E{}; E.t_a = 0; E.t_b = 0; E.A = E.B = nullptr; E.lda = E.ldb = 0; E.ca = E.cb = 0;
        E.C = (bf16*)(gs + G_DQ); E.ldc = 1024; E.cc = 0; E.t_c = 4; E.qs = QSCALE; E.Dd = (bf16*)(gs + G_DK); E.ldd = 1024; E.cd = 0; E.t_d = 8;
        E.VT = (bf16*)(gs + G_DVT); E.t_e = 12; E.hd_shift = 7; E.nheads = 8; E.dtf = nullptr;
        { pg8::Gemm g{hb, (const bf16*)(ws + WS_WQKV), 16384, 3072, 1024, 1024}; pg8::StaticOrder S; S.init(16384, 3072, gdim(), bidx());
          pg8::gemm_phase<EpiSplit, pg8::StaticOrder, true, true>(lds, g, S, E); }
        thin_qkv_tail(lds, hb + (size_t)16384 * 1024, (const bf16*)(ws + WS_WQKV), (bf16*)(gs + G_DQ), (bf16*)(gs + G_DK), (bf16*)(gs + G_DVT)); } PH_END(19)
    PH_BEGIN(20) diff_phase(a, lds, tid, wave, lane, false); PH_END(20)
    PH_BEGIN(21) run_resid_gemm(lds, (const bf16*)(gs + G_DQ), (const bf16*)(ws + WS_WO), 1024, hb, 1.0f); PH_END(21)
    PH_BEGIN(22) ln_phase(a, a.in[2] + 4 * 1024, a.in[3] + 4 * 1024, false, wave, lane, false); PH_END(22)
    FFN3(23, 3, 5, true)
}
}

extern "C" void kernel_launch(void* const* d_in, const int* in_sizes, int n_in, void* d_out, int out_size, void* d_ws, size_t ws_size, hipStream_t stream) {
    static int grid = 0;
    if (grid == 0) {
        if (n_in != 27 || ws_size < mk::WS_END2) { fprintf(stderr, "kernel_launch: unexpected n_in %d / ws_size %zu (need %zu)\n", n_in, ws_size, (size_t)mk::WS_END2); grid = -1; return; }
        int dev = 0, cus = 0, per_cu = 0;
        hipGetDevice(&dev); hipDeviceGetAttribute(&cus, hipDeviceAttributeMultiprocessorCount, dev);
        if (hipFuncSetAttribute((const void*)mk::mk_fwd, hipFuncAttributeMaxDynamicSharedMemorySize, mk::LDS_BYTES) != hipSuccess) { fprintf(stderr, "kernel_launch: hipFuncSetAttribute failed\n"); grid = -1; return; }
        hipOccupancyMaxActiveBlocksPerMultiprocessor(&per_cu, (const void*)mk::mk_fwd, 512, mk::LDS_BYTES);
        (void)hipGetLastError();
        if (per_cu < 1) fprintf(stderr, "kernel_launch: occupancy query says %d blocks/CU\n", per_cu);
        grid = cus > 0 ? cus : 256;
    }
    if (grid < 0) return;
    if (hipMemsetAsync(d_ws, 0, 65536, stream) != hipSuccess) { fprintf(stderr, "kernel_launch: memset of barrier words failed\n"); return; }
    mk::P a{};
    for (int i = 0; i < 27; ++i) a.in[i] = (const float*)d_in[i];
    a.out = (float*)d_out; a.ws = (unsigned char*)d_ws;
#if MK_MULTI
    for (int ph = 0; ph < mk::NPH; ++ph) { a.ph_lo = ph; a.ph_hi = ph + 1; hipLaunchKernelGGL(mk::mk_fwd, dim3(grid), dim3(512), mk::LDS_BYTES, stream, a); }
#else
    a.ph_lo = 0; a.ph_hi = mk::NPH;
    void* args[] = {&a};
    hipError_t e = hipLaunchCooperativeKernel((const void*)mk::mk_fwd, dim3(grid), dim3(512), args, mk::LDS_BYTES, stream);
    if (e != hipSuccess) fprintf(stderr, "cooperative launch failed: %s (grid %d)\n", hipGetErrorString(e), grid);
#endif
}
```
